# Optimizing an MI355X kernel written in HIP

```python
import math
import jax, jax.numpy as jnp
from jax import lax
import numpy as np

D_MODEL = 1024
BATCH = 8
SEQ = 4096
DEPTH = 1

RET_HEADS = 4
RET_DK = D_MODEL // (2 * RET_HEADS)
RET_DV = D_MODEL // RET_HEADS
RET_CHUNK = 128
DIFF_HEADS = 8
DIFF_DH = D_MODEL // (2 * DIFF_HEADS)
DIFF_DV = 2 * DIFF_DH
Q_BLOCK = 128
N_EXPERTS = 32
TOP_K = 4
D_EXPERT = D_MODEL
SWIGLU_LIMIT = 7.0
SWIGLU_ALPHA = 1.702
MOE_BLOCK = 128
EPS = 1e-6
RET_QK_W = RET_HEADS * RET_DK
RET_V_W = RET_HEADS * RET_DV
DIFF_QK_W = DIFF_HEADS * 2 * DIFF_DH
DIFF_V_W = DIFF_HEADS * DIFF_DV
IN_SPLITS = (RET_QK_W, RET_QK_W, RET_V_W, RET_V_W, DIFF_QK_W, DIFF_QK_W, DIFF_V_W, 2 * D_MODEL)
IN_W = sum(IN_SPLITS)

kernel_name = "hybrid_retention_diffattn_moe_block"


def rms_norm(x, g):
    xf = x.astype(jnp.float32)
    y = xf * lax.rsqrt(jnp.mean(xf * xf, axis=-1, keepdims=True) + EPS)
    return (y * g.astype(jnp.float32)).astype(x.dtype)


def group_norm_heads(y, g, b):
    yf = y.astype(jnp.float32)
    mu = jnp.mean(yf, axis=-1, keepdims=True)
    var = jnp.mean(jnp.square(yf - mu), axis=-1, keepdims=True)
    yn = (yf - mu) * lax.rsqrt(var + EPS)
    Bn, Sn, H, dv = y.shape
    yn = yn.reshape(Bn, Sn, H * dv) * g.astype(jnp.float32) + b.astype(jnp.float32)
    return yn.astype(y.dtype)


def split_cols(t, sizes):
    idx = np.cumsum(np.array(sizes))[:-1].tolist()
    return jnp.split(t, idx, axis=-1)


def retention(q, k, v):
    Bn, Sn = q.shape[0], q.shape[1]
    C = RET_CHUNK
    n = Sn // C
    f32 = jnp.float32
    q = q.astype(f32)
    k = k.astype(f32) * (RET_DK ** -0.5)
    v = v.astype(f32)
    log_g = jnp.log(1.0 - 2.0 ** (-5.0 - jnp.arange(RET_HEADS, dtype=f32)))
    pos = jnp.arange(C, dtype=f32)
    rel = pos[:, None] - pos[None, :]
    decay_in = jnp.where(rel >= 0, jnp.exp(log_g[:, None, None] * jnp.maximum(rel, 0.0)), 0.0)
    xi = jnp.exp(log_g[:, None] * (pos + 1.0))
    zeta = jnp.exp(log_g[:, None] * (C - 1.0 - pos))
    g_chunk = jnp.exp(log_g * C)

    def to_chunks(t):
        return t.reshape(Bn, n, C, RET_HEADS, t.shape[-1]).transpose(1, 0, 3, 2, 4)

    def step(R, qkv):
        qc, kc, vc = qkv
        inner = jnp.einsum('bhnd,bhmd->bhnm', qc, kc) * decay_in
        y = jnp.einsum('bhnm,bhmv->bhnv', inner, vc) \
            + jnp.einsum('bhnd,bhdv->bhnv', qc, R) * xi[None, :, :, None]
        R = R * g_chunk[None, :, None, None] \
            + jnp.einsum('bhmd,bhmv->bhdv', kc, vc * zeta[None, :, :, None])
        return R, y

    R0 = jnp.zeros((Bn, RET_HEADS, RET_DK, RET_DV), f32)
    _, ys = lax.scan(step, R0, (to_chunks(q), to_chunks(k), to_chunks(v)))
    return ys.transpose(1, 0, 3, 2, 4).reshape(Bn, Sn, RET_HEADS, RET_DV)


def diff_attention(q, k, v, g_q, g_k, lq1, lk1, lq2, lk2, g_sub, lambda_init):
    Bn, Sn = q.shape[0], q.shape[1]
    f32 = jnp.float32
    q = rms_norm(q.reshape(Bn, Sn, DIFF_HEADS, 2, DIFF_DH), g_q).transpose(0, 2, 3, 1, 4)
    k = rms_norm(k.reshape(Bn, Sn, DIFF_HEADS, 2, DIFF_DH), g_k).transpose(0, 2, 3, 1, 4)
    v = v.reshape(Bn, Sn, DIFF_HEADS, DIFF_DV).transpose(0, 2, 1, 3)
    lam = jnp.exp(jnp.sum(lq1.astype(f32) * lk1.astype(f32))) \
        - jnp.exp(jnp.sum(lq2.astype(f32) * lk2.astype(f32))) + lambda_init
    slopes = 2.0 ** (-8.0 * (jnp.arange(DIFF_HEADS, dtype=f32) + 1.0) / DIFF_HEADS)
    key_pos = jnp.arange(Sn, dtype=f32)
    scale = DIFF_DH ** -0.5

    def block(i):
        qb = lax.dynamic_slice_in_dim(q, i * Q_BLOCK, Q_BLOCK, axis=3)
        s = jnp.einsum('bhcqd,bhckd->bhcqk', qb, k).astype(f32) * scale
        dist = (i * Q_BLOCK + jnp.arange(Q_BLOCK)).astype(f32)[:, None] - key_pos[None, :]
        s = jnp.where(dist >= 0, s - slopes[:, None, None, None] * dist, -jnp.inf)
        p = jax.nn.softmax(s, axis=-1)
        a = p[:, :, 0] - lam * p[:, :, 1]
        return jnp.einsum('bhqk,bhkv->bhqv', a.astype(v.dtype), v)

    o = lax.map(block, jnp.arange(Sn // Q_BLOCK))
    o = o.transpose(1, 0, 3, 2, 4).reshape(Bn, Sn, DIFF_HEADS, DIFF_DV)
    o = rms_norm(o, g_sub) * (1.0 - lambda_init)
    return o.reshape(Bn, Sn, DIFF_HEADS * DIFF_DV)


def moe_ffn(h, w_router, b_router, w1, b1, w2, b2):
    Bn, Sn, D = h.shape
    T = Bn * Sn
    ht = h.reshape(T, D)
    logits = (ht @ w_router + b_router).astype(jnp.float32)
    top_v, top_i = lax.top_k(logits, TOP_K)
    top_w = jax.nn.softmax(top_v, axis=-1)
    n_assign = T * TOP_K
    flat_e = top_i.reshape(-1)
    flat_tok = jnp.arange(n_assign, dtype=jnp.int32) // TOP_K
    flat_w = top_w.reshape(-1)
    order = jnp.argsort(flat_e)
    sorted_e = flat_e[order]
    counts = jnp.bincount(flat_e, length=N_EXPERTS)
    padded = ((counts + MOE_BLOCK - 1) // MOE_BLOCK) * MOE_BLOCK
    pad_end = jnp.cumsum(padded)
    pad_start = pad_end - padded
    start = jnp.cumsum(counts) - counts
    dest = pad_start[sorted_e] + (jnp.arange(n_assign, dtype=jnp.int32) - start[sorted_e])
    n_rows = ((n_assign + MOE_BLOCK - 1) // MOE_BLOCK) * MOE_BLOCK + N_EXPERTS * MOE_BLOCK
    n_blocks = n_rows // MOE_BLOCK
    row_tok = jnp.zeros((n_rows,), jnp.int32).at[dest].set(flat_tok[order])
    row_w = jnp.zeros((n_rows,), jnp.float32).at[dest].set(flat_w[order])
    blk_e = jnp.minimum(jnp.searchsorted(pad_end, jnp.arange(n_blocks, dtype=jnp.int32) * MOE_BLOCK,
                                         side='right'), N_EXPERTS - 1).astype(jnp.int32)

    def expert_block(args):
        tok, e = args
        xb = ht[tok]
        gu = xb @ w1[e] + b1[e]
        g, u = gu[:, :D_EXPERT], gu[:, D_EXPERT:]
        g = jnp.minimum(g, SWIGLU_LIMIT)
        u = jnp.clip(u, -SWIGLU_LIMIT, SWIGLU_LIMIT)
        a = g * jax.nn.sigmoid(SWIGLU_ALPHA * g) * (u + 1.0)
        return a @ w2[e] + b2[e]

    out = lax.map(expert_block, (row_tok.reshape(n_blocks, MOE_BLOCK), blk_e))
    out = out.reshape(n_rows, D) * row_w[:, None].astype(h.dtype)
    y = jnp.zeros((T, D), h.dtype).at[row_tok].add(out)
    return y.reshape(Bn, Sn, D)


def setup_inputs(seed: int = 0) -> dict:
    key = jax.random.key(seed)
    ks = jax.random.split(key, 24)
    L, D, E, F = DEPTH, D_MODEL, N_EXPERTS, D_EXPERT
    f32 = jnp.float32
    nrm = lambda k, s: jax.random.normal(k, s, f32)
    return {
        "x": nrm(ks[0], (BATCH, SEQ, D)),
        "c": nrm(ks[1], (BATCH, D)),
        "w_ada": nrm(ks[2], (L, D, 6 * D)) * D ** -0.5,
        "b_ada": nrm(ks[3], (L, 6 * D)) * 0.02,
        "g_norm1": 1.0 + 0.02 * nrm(ks[4], (L, D)),
        "w_in": nrm(ks[5], (L, D, IN_W)) * D ** -0.5,
        "g_ret_gn": 1.0 + 0.02 * nrm(ks[6], (L, RET_V_W)),
        "b_ret_gn": 0.02 * nrm(ks[7], (L, RET_V_W)),
        "g_qnorm": 1.0 + 0.02 * nrm(ks[8], (L, DIFF_DH)),
        "g_knorm": 1.0 + 0.02 * nrm(ks[9], (L, DIFF_DH)),
        "lambda_q1": 0.1 * nrm(ks[10], (L, DIFF_DH)),
        "lambda_k1": 0.1 * nrm(ks[11], (L, DIFF_DH)),
        "lambda_q2": 0.1 * nrm(ks[12], (L, DIFF_DH)),
        "lambda_k2": 0.1 * nrm(ks[13], (L, DIFF_DH)),
        "g_diff_subln": 1.0 + 0.02 * nrm(ks[14], (L, DIFF_DV)),
        "w_out": nrm(ks[15], (L, D, D)) * D ** -0.5,
        "g_norm2": 1.0 + 0.02 * nrm(ks[16], (L, D)),
        "w_router": nrm(ks[17], (L, D, E)) * D ** -0.5,
        "b_router": 0.01 * nrm(ks[18], (L, E)),
        "w_expert_in": nrm(ks[19], (L, E, D, 2 * F)) * D ** -0.5,
        "b_expert_in": 0.01 * nrm(ks[20], (L, E, 2 * F)),
        "w_expert_out": nrm(ks[21], (L, E, F, D)) * F ** -0.5,
        "b_expert_out": 0.01 * nrm(ks[22], (L, E, D)),
    }


def reference(x, c, w_ada, b_ada, g_norm1, w_in, g_ret_gn, b_ret_gn, g_qnorm, g_knorm,
              lambda_q1, lambda_k1, lambda_q2, lambda_k2, g_diff_subln, w_out, g_norm2,
              w_router, b_router, w_expert_in, b_expert_in, w_expert_out, b_expert_out):
    Bn, Sn, D = x.shape
    for l in range(DEPTH):
        lambda_init = 0.8 - 0.6 * math.exp(-0.3 * l)
        mod = jax.nn.silu(c) @ w_ada[l] + b_ada[l]
        sh1, sc1, gt1, sh2, sc2, gt2 = [m[:, None, :] for m in jnp.split(mod, 6, axis=-1)]

        h = rms_norm(x, g_norm1[l]) * (1.0 + sc1) + sh1
        proj = h @ w_in[l]
        rq, rk, rv, rg, dq, dk, dv, mg = split_cols(proj, IN_SPLITS)
        y_ret = retention(rq.reshape(Bn, Sn, RET_HEADS, RET_DK),
                          rk.reshape(Bn, Sn, RET_HEADS, RET_DK),
                          rv.reshape(Bn, Sn, RET_HEADS, RET_DV)).astype(x.dtype)
        o_ret = jax.nn.silu(rg) * group_norm_heads(y_ret, g_ret_gn[l], b_ret_gn[l])
        o_diff = diff_attention(dq, dk, dv, g_qnorm[l], g_knorm[l], lambda_q1[l], lambda_k1[l],
                                lambda_q2[l], lambda_k2[l], g_diff_subln[l], lambda_init)
        gate_ret, gate_diff = jnp.split(jax.nn.sigmoid(mg), 2, axis=-1)
        merged = gate_ret * o_ret + gate_diff * o_diff
        x = x + gt1 * (merged @ w_out[l])

        h2 = rms_norm(x, g_norm2[l]) * (1.0 + sc2) + sh2
        x = x + gt2 * moe_ffn(h2, w_router[l], b_router[l], w_expert_in[l], b_expert_in[l],
                              w_expert_out[l], b_expert_out[l])
    return x
```

```cpp
#include <hip/hip_runtime.h>
#include <cstdio>
#include <cstdint>

typedef unsigned short bf16;
typedef short bf16x8 __attribute__((ext_vector_type(8)));
typedef float f32x4 __attribute__((ext_vector_type(4)));
typedef float f32x16 __attribute__((ext_vector_type(16)));
typedef unsigned u32x4 __attribute__((ext_vector_type(4)));
typedef unsigned u32x2 __attribute__((ext_vector_type(2)));

constexpr int NB = 8, S = 4096, T = NB * S, D = 1024, INW = 8192;
constexpr int NE = 32, TOPK = 4, FF = 1024;
constexpr size_t PO_RQ = 0, PO_RK = (size_t)T * 512, PO_RV = (size_t)T * 1024, PO_RG = (size_t)T * 2048, PO_DQ = (size_t)T * 3072, PO_DK = (size_t)T * 4096, PO_DV = (size_t)T * 5120, PO_MG = (size_t)T * 6144;
constexpr float EPS = 1e-6f;
constexpr float LOG2E = 1.4426950408889634f;
constexpr float C2 = 0.125f * LOG2E;
constexpr float LAMBDA_INIT = 0.2f;
#ifndef FP8_MOE
#define FP8_MOE 1
#endif
#ifndef FP8_IN
#define FP8_IN 0
#endif
#ifndef FP8_OUT
#define FP8_OUT 0
#endif
constexpr int W_SH = 5, A_SH = 2, E_SH = 3;
constexpr int NRB_MAX = 544;
constexpr int NR_MAX = NRB_MAX * 256;

constexpr size_t MiB = 1u << 20;
constexpr size_t WS_CTL = 0;
constexpr size_t WS_MOD = 1 * MiB;
constexpr size_t WS_WRT = 1 * MiB + 512 * 1024;
constexpr size_t WS_ROUTE = 2 * MiB;
constexpr size_t WS_LIST = 4 * MiB;
constexpr size_t WS_WIN = 8 * MiB;
constexpr size_t WS_WOUT = 24 * MiB;
constexpr size_t WS_W1 = 26 * MiB;
constexpr size_t WS_W2 = 154 * MiB;
constexpr size_t WS_H = 218 * MiB;
constexpr size_t WS_PROJ = 282 * MiB;
constexpr size_t WS_YRET = 794 * MiB;
constexpr size_t WS_ODIFF = 858 * MiB;
constexpr size_t WS_MERGED = 922 * MiB;
constexpr size_t WS_ACT = WS_PROJ;
constexpr size_t WS_EO = WS_PROJ + 272 * MiB;
#define IN_GATE_F8 1
#define MOE_W_IN_QUEUE 1
#define FUSE_MERGE 1
constexpr size_t WS_H8 = 858 * MiB;
constexpr size_t WS_WIN8 = 146 * MiB;
constexpr size_t WS_X1B = FUSE_MERGE ? 858 * MiB : 794 * MiB;
constexpr size_t WS_MRG = FUSE_MERGE ? 794 * MiB : 922 * MiB;
constexpr size_t WS_END = 986 * MiB;
constexpr int CW_CNT = 64;
constexpr int CW_ROWOFF = 128;
constexpr int CW_NRB = 192;
constexpr int CW_Q = 512;
constexpr int CW_RB2E = 256;

__device__ __forceinline__ float bf2f(bf16 v) { return __builtin_bit_cast(float, (unsigned)v << 16); }
__device__ __forceinline__ float rowsum16(float x) {
    x += __builtin_bit_cast(float, __builtin_amdgcn_update_dpp(0, __builtin_bit_cast(int, x), 0x128, 0xf, 0xf, false));
    x += __builtin_bit_cast(float, __builtin_amdgcn_update_dpp(0, __builtin_bit_cast(int, x), 0x124, 0xf, 0xf, false));
    x += __builtin_bit_cast(float, __builtin_amdgcn_update_dpp(0, __builtin_bit_cast(int, x), 0x122, 0xf, 0xf, false));
    x += __builtin_bit_cast(float, __builtin_amdgcn_update_dpp(0, __builtin_bit_cast(int, x), 0x121, 0xf, 0xf, false));
    return x; }
__device__ __forceinline__ bf16 f2bf(float f) { unsigned u = __builtin_bit_cast(unsigned, f); return (bf16)((u + 0x7fffu + ((u >> 16) & 1u)) >> 16); }
__host__ __device__ __forceinline__ int crow(int r, int hi) { return (r & 3) + 8 * (r >> 2) + 4 * hi; }
__device__ __forceinline__ float sigmoidf_(float x) { return 1.f / (1.f + __expf(-x)); }

__host__ __device__ __forceinline__ int tile_new2old(int t) { return t < 12 ? t : (t < 16 ? t + 12 : (t < 28 ? t - 4 : t)); }
__host__ __device__ __forceinline__ int in_p2l(int p) { const int tp = p >> 8, t = tile_new2old(tp), q = p & 255, bj = q >> 7, wc = (q >> 5) & 3, j = q & 31;
    if (tp >= 8 && tp < 16) return (bj ? 6144 : 2048) + (tp - 8) * 128 + (q & 127);
    return t * 256 + 64 * wc + 32 * bj + j; }
__host__ __device__ __forceinline__ int w1_p2l(int p) { const int t = p >> 8, q = p & 255, bj = q >> 7; return bj * 1024 + t * 128 + (q & 127); }

#define LAS __attribute__((address_space(3)))
#define GAS __attribute__((address_space(1)))
namespace pg8 {
constexpr int BM = 256, BK = 64, HALF = 128, HTB = HALF * BK * 2  , STAGE_BYTES = 8 * HTB, NXCD = 8, WGM = 8;

__host__ __device__ __forceinline__ int lds_byte(int r, int c) { const int st = (r >> 4) * 2 + (c >> 5), rr = r & 15, cc = c & 31, ob = rr * 64 + cc * 2; return st * 1024 + (ob ^ (((ob >> 9) & 1) << 5)); }
__host__ __device__ __forceinline__ void stage_rc(int b, int& R, int& C) { const int st = b / 1024, sb = b % 1024, swz = sb ^ (((sb >> 9) & 1) << 5); R = (st >> 1) * 16 + swz / 64; C = (st & 1) * 32 + (swz % 64) / 2; }
__host__ __device__ __forceinline__ int perm32(int rho) { const int n = rho >> 4, i = rho & 15; return 8 * (i >> 2) + 4 * n + (i & 3); }
struct GUnit { int pm, pn, e, g, s; };

struct StaticOrder {
    int nM, nN, nwg, G, c; const LAS unsigned* rb2e; const LAS unsigned* rbfirst;
    __device__ void init(int nM_, int nN_, int G_, int c_, const LAS unsigned* t, const LAS unsigned* f) { nM = nM_; nN = nN_; nwg = nM * nN; G = G_; c = c_; rb2e = t; rbfirst = f; }
    __device__ bool next(int i, GUnit& u) const {
        const long L = (long)i * G + c; if (L >= nwg) return false;
        int wgid = (int)L; { const int q = nwg / NXCD, r = nwg % NXCD, xcd = wgid % NXCD, off = wgid / NXCD; wgid = (xcd < r ? xcd * (q + 1) : r * (q + 1) + (xcd - r) * q) + off; }
        const int nig = WGM * nN, gid = wgid / nig, fm = gid * WGM, gsz = (nM - fm) < WGM ? (nM - fm) : WGM;
        u.pm = fm + ((wgid % nig) % gsz); u.pn = (wgid % nig) / gsz; u.e = rb2e ? __builtin_amdgcn_readfirstlane((int)rb2e[u.pm]) : 0; u.g = rb2e ? u.e * T + (u.pm - __builtin_amdgcn_readfirstlane((int)rbfirst[u.e])) * 256 : 0; return true;
    }
};

__device__ __forceinline__ unsigned cvt_pk_bf16(float lo, float hi) { unsigned r; asm volatile("v_cvt_pk_bf16_f32 %0, %1, %2" : "=v"(r) : "v"(lo), "v"(hi)); return r; }

template <class Epi, class Sched, bool GATHER, bool FP8 = false, int BIAS = 0, int BP = 0>
__device__ __forceinline__ void gemm_phase(LAS unsigned char* lds, const void* Aglob, const void* Bglob, const size_t bstride, const int K, const Sched& S, const Epi& E,
                                           const int* rowtok, LAS unsigned* gtab, const int sA = 127, const int sB = 127, const float* bias = nullptr, LAS float* btab = nullptr) {
    typedef int v4i_t __attribute__((ext_vector_type(4))); typedef int v8i_t __attribute__((ext_vector_type(8)));
    const int KB = FP8 ? K : 2 * K;
    const int tid = threadIdx.x, wid = __builtin_amdgcn_readfirstlane(tid >> 6), lane = tid & 63, wr = wid >> 2, wc = wid & 3, fr = lane & 15, fq = lane >> 4;
    const int nt = KB / 128;
    unsigned voffA[2], voffB[2];
#pragma unroll
    for (int i = 0; i < 2; ++i) { int R, C; stage_rc(tid * 16 + i * 8192, R, C);
        const int Rb = BP ? 64 * (R >> 5) + 16 * ((R >> 2) & 3) + 4 * ((R >> 4) & 1) + (R & 3) : (R & ~31) + perm32(R & 31);
        voffA[i] = (unsigned)(R * KB + C * 2); voffB[i] = (unsigned)(Rb * KB + C * 2); }
    constexpr unsigned kstep = 128u;
    const unsigned hstep = (unsigned)(HALF * KB);
    const unsigned hstepB = BP ? (unsigned)(8 * KB) : hstep;
    const unsigned tstep = 2u * hstep;
    const unsigned ldsw = (unsigned)wid * 1024u;
    const int aoff = lds_byte(wr * 64 + fr, fq * 8), boff = lds_byte(wc * 32 + fr, fq * 8);
#define PG8_SA(b, h) (((b) * 2 + (h)) * HTB)
#define PG8_SB(b, h) ((4 + (b) * 2 + (h)) * HTB)
#define PG8_STAGE(bufoff, gbase, voff) do { _Pragma("unroll") for (int _i = 0; _i < 2; ++_i) \
        __builtin_amdgcn_global_load_lds((const unsigned*)((const char*)(gbase) + (voff)[_i]), (LAS unsigned*)(lds + (bufoff) + ldsw + _i * 8192), 16, 0, 0); } while (0)
#define PG8_STAGE_A(b, h, kptr, VO) do { if constexpr (GATHER) { PG8_STAGE(PG8_SA(b, h), kptr, VO[h]); } else { PG8_STAGE(PG8_SA(b, h), (kptr) + (h) * hstep, voffA); } } while (0)
#define PG8_STAGE_A2(b, h, kptr) do { if constexpr (GATHER) { _Pragma("unroll") for (int _i = 0; _i < 2; ++_i) \
        __builtin_amdgcn_global_load_lds((const unsigned*)((const char*)(kptr) + (usen ? vN[h][_i] : vC[h][_i])), (LAS unsigned*)(lds + PG8_SA(b, h) + ldsw + _i * 8192), 16, 0, 0); } \
        else { PG8_STAGE(PG8_SA(b, h), (kptr) + (h) * hstep, voffA); } } while (0)
#define PG8_LD8(p_) __builtin_shufflevector(*(const LAS v4i_t*)(p_), *(const LAS v4i_t*)((p_) + 1024), 0, 1, 2, 3, 4, 5, 6, 7)
#define PG8_LDA(dst, b, h) do { if constexpr (FP8) { _Pragma("unroll") for (int m = 0; m < 4; ++m) dst##8[m] = PG8_LD8(lds + PG8_SA(b, h) + aoff + m * 2048); } \
        else { _Pragma("unroll") for (int m = 0; m < 4; ++m) _Pragma("unroll") for (int k = 0; k < 2; ++k) dst[m][k] = *(const LAS bf16x8*)(lds + PG8_SA(b, h) + aoff + m * 2048 + k * 1024); } } while (0)
#define PG8_LDB(dst, b, h) do { if constexpr (FP8) { _Pragma("unroll") for (int n = 0; n < 2; ++n) dst##8[n] = PG8_LD8(lds + PG8_SB(b, h) + boff + n * 2048); } \
        else { _Pragma("unroll") for (int n = 0; n < 2; ++n) _Pragma("unroll") for (int k = 0; k < 2; ++k) dst[n][k] = *(const LAS bf16x8*)(lds + PG8_SB(b, h) + boff + n * 2048 + k * 1024); } } while (0)
#define PG8_MMA(ai, bj, At, Bt) do { __builtin_amdgcn_s_setprio(1); \
        if constexpr (FP8) { _Pragma("unroll") for (int m = 0; m < 4; ++m) _Pragma("unroll") for (int n = 0; n < 2; ++n)   \
            asm volatile("v_mfma_scale_f32_16x16x128_f8f6f4 %0, %1, %2, %0, %3, %4 op_sel_hi:[0,0,0]" : "+v"(acc[ai][bj][m][n]) : "v"(Bt##8[n]), "v"(At##8[m]), "v"(sB), "v"(sA)); } \
        else { _Pragma("unroll") for (int m = 0; m < 4; ++m) _Pragma("unroll") for (int n = 0; n < 2; ++n) _Pragma("unroll") for (int k = 0; k < 2; ++k) \
            asm volatile("v_mfma_f32_16x16x32_bf16 %0, %1, %2, %0" : "+v"(acc[ai][bj][m][n]) : "v"(Bt[n][k]), "v"(At[m][k])); } \
        __builtin_amdgcn_s_setprio(0); } while (0)
#define PG8_MMA0(ai, bj, At, Bt) do { __builtin_amdgcn_s_setprio(1); \
        if constexpr (FP8) { _Pragma("unroll") for (int m = 0; m < 4; ++m) _Pragma("unroll") for (int n = 0; n < 2; ++n) \
            asm volatile("v_mfma_scale_f32_16x16x128_f8f6f4 %0, %1, %2, 0, %3, %4 op_sel_hi:[0,0,0]" : "=&v"(acc[ai][bj][m][n]) : "v"(Bt##8[n]), "v"(At##8[m]), "v"(sB), "v"(sA)); } \
        else { _Pragma("unroll") for (int m = 0; m < 4; ++m) _Pragma("unroll") for (int n = 0; n < 2; ++n) { \
            asm volatile("v_mfma_f32_16x16x32_bf16 %0, %1, %2, 0" : "=&v"(acc[ai][bj][m][n]) : "v"(Bt[n][0]), "v"(At[m][0])); \
            asm volatile("v_mfma_f32_16x16x32_bf16 %0, %1, %2, %0" : "+v"(acc[ai][bj][m][n]) : "v"(Bt[n][1]), "v"(At[m][1])); } } \
        __builtin_amdgcn_s_setprio(0); } while (0)
#define PG8_WAIT_V(n) asm volatile("s_waitcnt vmcnt(" #n ")" ::: "memory")
#define PG8_WAIT_L(n) asm volatile("s_waitcnt lgkmcnt(" #n ")" ::: "memory")
#define PG8_BAR __builtin_amdgcn_s_barrier()
#define PG8_SCHED __builtin_amdgcn_sched_barrier(0)
#define PG8_GTAB_DMA(g_, slot_) do { if (wid < 4) __builtin_amdgcn_global_load_lds((const unsigned*)(rowtok + (size_t)(g_) + tid), (LAS unsigned*)(gtab + (slot_) * 256 + wid * 64), 4, 0, 0); } while (0)
#define PG8_GOFF(dst, slot_) do { _Pragma("unroll") for (int _i = 0; _i < 2; ++_i) { int _R, _C; stage_rc(tid * 16 + _i * 8192, _R, _C); \
        _Pragma("unroll") for (int _h = 0; _h < 2; ++_h) dst[_h][_i] = gtab[(slot_) * 256 + _h * 128 + _R] * (unsigned)KB + (unsigned)(_C * 2); } } while (0)
#define PG8_BTAB_DMA(u_, slot_) do { if constexpr (BIAS != 0) { if (wid >= 4) { const int _i = tid - 256; \
        const float* _src = BIAS == 1 ? bias + (size_t)(u_).e * 2048 + (_i < 128 ? 128 * (u_).pn + _i : 1024 + 128 * (u_).pn + (_i - 128)) : bias + (size_t)(u_).e * 1024 + 256 * (u_).pn + _i; \
        __builtin_amdgcn_global_load_lds((const unsigned*)_src, (LAS unsigned*)(btab + (slot_) * 256 + (wid - 4) * 64), 4, 0, 0); } } } while (0)
    GUnit cur, nxt; int ui = 0;
    if (!S.next(0, cur)) return;
    cur.s = 0; PG8_BTAB_DMA(cur, 0);
    f32x4 acc[2][2][4][2];
    bf16x8 At[4][2], B0[2][2], B1[2][2]; v8i_t At8[4], B08[2], B18[2];
    unsigned vC[2][2], vN[2][2];
    if constexpr (GATHER) { PG8_GTAB_DMA(cur.g, 0); PG8_WAIT_V(0); PG8_BAR; PG8_GOFF(vC, 0); PG8_WAIT_L(0);
#pragma unroll
        for (int h = 0; h < 2; ++h)
#pragma unroll
            for (int i = 0; i < 2; ++i) vN[h][i] = vC[h][i]; }
    const char* cA = GATHER ? (const char*)Aglob : (const char*)Aglob + (size_t)cur.pm * tstep;
    const char* cB = (const char*)Bglob + (size_t)cur.e * bstride + (size_t)cur.pn * tstep;
    PG8_STAGE(PG8_SB(0, 0), cB, voffB); PG8_STAGE(PG8_SB(0, 1), cB + hstepB, voffB); PG8_STAGE_A(0, 0, cA, vC); PG8_STAGE_A(0, 1, cA, vC);
    if (wr == 1) PG8_BAR;
    PG8_WAIT_V(2); PG8_BAR;
    PG8_STAGE(PG8_SB(1, 0), cB + kstep, voffB); PG8_STAGE_A(1, 0, cA + kstep, vC); PG8_STAGE(PG8_SB(1, 1), cB + hstepB + kstep, voffB);
    PG8_WAIT_V(6); PG8_BAR;
    int sprev = 0;
    for (;;) {
        const bool has_next = S.next(ui + 1, nxt);
        if constexpr (GATHER) { if (has_next) PG8_GTAB_DMA(nxt.g, (ui + 1) & 1); }
        const char* nA = has_next ? (GATHER ? (const char*)Aglob : (const char*)Aglob + (size_t)nxt.pm * tstep) : cA;
        const char* nB = has_next ? (const char*)Bglob + (size_t)nxt.e * bstride + (size_t)nxt.pn * tstep : cB;
#define PG8_STEP(t, WV1, WV2, LASTOK, MM) do { \
            const bool last = (LASTOK) && ((t) == nt - 2); \
            const char* a1 = cA + (size_t)((t) + 1) * kstep; \
            const char* a2 = last ? nA : cA + (size_t)((t) + 2) * kstep; const char* b2 = last ? nB : cB + (size_t)((t) + 2) * kstep; \
            const char* a3 = a2 + kstep; const char* b3 = b2 + kstep; \
            if constexpr (GATHER) { if (last && has_next) { PG8_GOFF(vN, (ui + 1) & 1); } } \
            const bool usen = last && has_next; \
              \
            PG8_LDB(B0, 0, 0); PG8_LDB(B1, 0, 1); PG8_SCHED; PG8_LDA(At, 0, 0); PG8_STAGE_A(1, 1, a1, vC); \
            WV1; PG8_WAIT_L(0); PG8_BAR; MM(0, 0, At, B0); MM(0, 1, At, B1); PG8_BAR; PG8_SCHED; \
              \
            PG8_LDA(At, 0, 1); PG8_STAGE(PG8_SB(0, 0), b2, voffB); PG8_STAGE(PG8_SB(0, 1), b2 + hstepB, voffB); PG8_STAGE_A2(0, 0, a2); \
            WV2; PG8_WAIT_L(0); PG8_BAR; MM(1, 0, At, B0); MM(1, 1, At, B1); PG8_BAR; PG8_SCHED; \
              \
            PG8_LDB(B0, 1, 0); PG8_LDB(B1, 1, 1); PG8_SCHED; PG8_LDA(At, 1, 0); PG8_STAGE_A2(0, 1, a2); \
            PG8_WAIT_V(8); PG8_WAIT_L(0); PG8_BAR; PG8_MMA(0, 0, At, B0); PG8_MMA(0, 1, At, B1); PG8_BAR; PG8_SCHED; \
              \
            PG8_LDA(At, 1, 1); PG8_STAGE(PG8_SB(1, 0), b3, voffB); PG8_STAGE(PG8_SB(1, 1), b3 + hstepB, voffB); PG8_STAGE_A2(1, 0, a3); \
            PG8_WAIT_V(8); PG8_WAIT_L(0); PG8_BAR; PG8_MMA(1, 0, At, B0); PG8_MMA(1, 1, At, B1); PG8_BAR; PG8_SCHED; } while (0)
#define PG8_WAIT_VR() do { if (sprev >= 16) PG8_WAIT_V(24); else if (sprev >= 8) PG8_WAIT_V(16); else PG8_WAIT_V(8); } while (0)
        if constexpr (FP8) {
            PG8_STEP(0, PG8_WAIT_VR(), PG8_WAIT_VR(), false, PG8_MMA0);
            for (int t = 2; t < nt; t += 2) PG8_STEP(t, PG8_WAIT_V(8), PG8_WAIT_V(8), true, PG8_MMA);
        } else {
#define PG8_WAIT_VR2() do { if (sprev >= 8) PG8_WAIT_V(16); else PG8_WAIT_V(8); } while (0)
            PG8_STEP(0, PG8_WAIT_VR2(), PG8_WAIT_VR2(), false, PG8_MMA0);
            for (int t = 2; t < nt; t += 2) PG8_STEP(t, PG8_WAIT_V(8), PG8_WAIT_V(8), true, PG8_MMA);
        }
        if (wr == 0) PG8_BAR;
        asm volatile("s_nop 15\n\ts_nop 15\n\ts_nop 7" ::: "memory");
        E(acc, cur, wr, wc, fr, fq);
        sprev = Epi::nstores(cur);
        if (!has_next) break;
        cur = nxt; cA = nA; cB = nB; ++ui; cur.s = ui & 1;
        if constexpr (GATHER) {
#pragma unroll
            for (int h = 0; h < 2; ++h)
#pragma unroll
                for (int i = 0; i < 2; ++i) vC[h][i] = vN[h][i]; }
        if (wr == 1) PG8_BAR;
        PG8_BTAB_DMA(cur, ui & 1);
    }
    PG8_WAIT_V(0);
    PG8_BAR;
#undef PG8_SA
#undef PG8_SB
#undef PG8_STAGE
#undef PG8_STAGE_A
#undef PG8_STAGE_A2
#undef PG8_LDA
#undef PG8_LDB
#undef PG8_MMA
#undef PG8_MMA0
#undef PG8_LD8
#undef PG8_WAIT_V
#undef PG8_WAIT_VR
#undef PG8_STEP
#undef PG8_WAIT_L
#undef PG8_BAR
#undef PG8_SCHED
#undef PG8_GTAB_DMA
#undef PG8_BTAB_DMA
#undef PG8_GOFF
}
}

#define XB_TMO      128
#define XB_XCNT(j)  (256  + 64 * (j))
#define XB_XSUB(j)  (1280 + 64 * (j))
#define XB_XGEN(j)  (2304 + 64 * (j))
#define XB_TOP      3328
#define XB_TOPGEN   3392
#define XCD_BAR_WORDS 3456
#define XB_SPIN_CAP (1u << 24)

__device__ __forceinline__ unsigned xb_ld(unsigned* p)              { return __hip_atomic_load(p, __ATOMIC_RELAXED, __HIP_MEMORY_SCOPE_AGENT); }
__device__ __forceinline__ unsigned xb_add(unsigned* p, unsigned v) { return __hip_atomic_fetch_add(p, v, __ATOMIC_RELAXED, __HIP_MEMORY_SCOPE_AGENT); }
__device__ __forceinline__ unsigned xb_xcc_id() { return (unsigned)__builtin_amdgcn_s_getreg((3 << 11) | 20) & 0xFu; }
#define XB_SPIN(cond, bar) do { unsigned _sp = 0; while (cond) { __builtin_amdgcn_s_sleep(1); \
    if ((++_sp & 255u) == 0u) { if (xb_ld(&(bar)[XB_TMO])) break; if (_sp > XB_SPIN_CAP) { atomicAdd(&(bar)[XB_TMO], 1u); break; } } } } while (0)

struct XcdBarrier {
    unsigned* bar; unsigned x;
    volatile LAS unsigned* st;
};

__device__ __forceinline__ XcdBarrier xcd_barrier_post(unsigned* bar, volatile LAS unsigned* st) {
    XcdBarrier b; b.bar = bar; b.x = xb_xcc_id(); b.st = st;
    if (threadIdx.x == 0) (void)xb_add(&bar[XB_XCNT(b.x)], 1u);
    return b;
}
__device__ __forceinline__ void xcd_barrier_complete(unsigned* bar, unsigned x, unsigned& nloc, unsigned& nx) {
    const unsigned G = gridDim.x * gridDim.y * gridDim.z;
    unsigned sum, cnt, mine, sp = 0u;
    for (;;) {
        sum = 0u; cnt = 0u; mine = 0u;
#pragma unroll
        for (unsigned j = 0; j < 16; ++j) { const unsigned c = xb_ld(&bar[XB_XCNT(j)]); sum += c; cnt += (c > 0u) ? 1u : 0u; mine = (j == x) ? c : mine; }
        if (sum == G) break;
        __builtin_amdgcn_s_sleep(1);
        if ((++sp & 255u) == 0u) { if (xb_ld(&bar[XB_TMO])) break; if (sp > XB_SPIN_CAP) { atomicAdd(&bar[XB_TMO], 1u); break; } }
    }
    nloc = mine > 0u ? mine : 1u; nx = cnt > 0u ? cnt : 1u;
}

__device__ __forceinline__ void xcd_barrier(const XcdBarrier& b) {
    asm volatile("s_waitcnt vmcnt(0)" ::: "memory");
    __syncthreads();
    if (threadIdx.x == 0) {
        unsigned* bar = b.bar;
        __builtin_amdgcn_s_waitcnt(0);
        unsigned nloc = b.st[0], nx = b.st[1];
        if (nloc == 0u) { xcd_barrier_complete(bar, b.x, nloc, nx); b.st[0] = nloc; b.st[1] = nx; }
        const unsigned old = xb_add(&bar[XB_XSUB(b.x)], 1u);
        const unsigned gen = old / nloc;
        if (old + 1u == (gen + 1u) * nloc) {
            __builtin_amdgcn_fence(__ATOMIC_RELEASE, "agent");
            asm volatile("s_waitcnt vmcnt(0)" ::: "memory");
            const unsigned og = xb_add(&bar[XB_TOP], 1u);
            const unsigned tg = og / nx;
            if (og + 1u == (tg + 1u) * nx) xb_add(&bar[XB_TOPGEN], 1u);
            else XB_SPIN(xb_ld(&bar[XB_TOPGEN]) == tg, bar);
            __builtin_amdgcn_fence(__ATOMIC_ACQUIRE, "agent");
            xb_add(&bar[XB_XGEN(b.x)], 1u);
            asm volatile("s_waitcnt vmcnt(0)" ::: "memory");
        } else {
            XB_SPIN(xb_ld(&bar[XB_XGEN(b.x)]) == gen, bar);
            __builtin_amdgcn_fence(__ATOMIC_ACQUIRE, "agent");
            asm volatile("s_waitcnt vmcnt(0)" ::: "memory");
        }
    }
    __syncthreads();
}

__device__ __forceinline__ float fast_sigmoid(float x) { return __builtin_amdgcn_rcpf(1.f + __builtin_amdgcn_exp2f(-LOG2E * x)); }
__device__ __forceinline__ u32x4 pack8(const f32x4 a, const f32x4 b) { u32x4 w; w.x = pg8::cvt_pk_bf16(a[0], a[1]); w.y = pg8::cvt_pk_bf16(a[2], a[3]); w.z = pg8::cvt_pk_bf16(b[0], b[1]); w.w = pg8::cvt_pk_bf16(b[2], b[3]); return w; }

__device__ __forceinline__ unsigned pk4_fp8(float a, float b, float c, float d, float sc) {
    a = __builtin_amdgcn_fmed3f(a * sc, -448.f, 448.f); b = __builtin_amdgcn_fmed3f(b * sc, -448.f, 448.f); c = __builtin_amdgcn_fmed3f(c * sc, -448.f, 448.f); d = __builtin_amdgcn_fmed3f(d * sc, -448.f, 448.f);
    int v = __builtin_amdgcn_cvt_pk_fp8_f32(a, b, 0, false); v = __builtin_amdgcn_cvt_pk_fp8_f32(c, d, v, true); return (unsigned)v; }
__device__ __forceinline__ unsigned pk4_fp8_nc(float a, float b, float c, float d) {
    int v = __builtin_amdgcn_cvt_pk_fp8_f32(a, b, 0, false); v = __builtin_amdgcn_cvt_pk_fp8_f32(c, d, v, true); return (unsigned)v; }
struct EpiIn {
    bf16* proj; const LAS float* gqk;
    static __device__ __forceinline__ int nstores(const pg8::GUnit& u) { return (u.pn >= 8 && u.pn < 16) ? 8 : 16; }
    __device__ __forceinline__ void operator()(const f32x4 (&acc)[2][2][4][2], const pg8::GUnit& u, int wr, int wc, int fr, int fq) const {
        const int pn = tile_new2old(u.pn); const int bb = u.pm >> 4, s0 = (u.pm & 15) * 256 + wr * 64 + fr; const size_t t0 = (size_t)u.pm * 256 + wr * 64 + fr;
        bf16* base; size_t INWp;
        if (u.pn >= 8 && u.pn < 16) {
            bf16* gb = proj + PO_RG + t0 * 1024 + (u.pn - 8) * 128 + wc * 32 + fq * 8;
#pragma unroll
            for (int ai = 0; ai < 2; ++ai)
#pragma unroll
                for (int m = 0; m < 4; ++m) { f32x4 v[2];
#pragma unroll
                    for (int n = 0; n < 2; ++n) {
                        const f32x4 x = acc[ai][0][m][n], a = x * (-LOG2E), b = acc[ai][1][m][n] * (-LOG2E); f32x4 ex, ey, r;
#pragma unroll
                        for (int e = 0; e < 4; ++e) { ex[e] = __builtin_amdgcn_exp2f(a[e]); ey[e] = __builtin_amdgcn_exp2f(b[e]); }
                        const f32x4 d = (ex + 1.f) * (ey + 1.f);
#pragma unroll
                        for (int e = 0; e < 4; ++e) r[e] = __builtin_amdgcn_rcpf(d[e]);
                        v[n] = x * r; }
                    *(u32x4*)(gb + (size_t)(ai * 128 + m * 16) * 1024) = pack8(v[0], v[1]); }
            return;
        }
        if (pn < 4)       { const int h = 2 * (pn & 1) + (wc >> 1); base = proj + (pn < 2 ? PO_RQ : PO_RK) + ((size_t)(bb * 4 + h) * S + s0) * 128 + (wc & 1) * 64 + fq * 8; INWp = 128; }
        else if (pn < 8)  { base = proj + PO_RV + ((size_t)(bb * 4 + (pn - 4)) * S + s0) * 256 + wc * 64 + fq * 8; INWp = 256; }
        else if (pn < 12) { base = proj + PO_RG + t0 * 1024 + (pn - 8) * 256 + wc * 64 + fq * 8; INWp = 1024; }
        else if (pn < 24) { const int rg3 = (pn - 12) >> 2, h = 2 * ((pn - 12) & 3) + (wc >> 1); base = proj + (rg3 == 0 ? PO_DQ : (rg3 == 1 ? PO_DK : PO_DV)) + ((size_t)(bb * 8 + h) * S + s0) * 128 + (wc & 1) * 64 + fq * 8; INWp = 128; }
        else              { base = proj + PO_MG + (pn >= 28 ? (size_t)T * 1024 : 0) + t0 * 1024 + ((pn - 24) & 3) * 256 + wc * 64 + fq * 8; INWp = 1024; }
        if (pn < 8 || (pn >= 20 && pn < 24)) {
            float f[4];
#pragma unroll
            for (int m = 0; m < 4; ++m) f[m] = 1.f;
            if (pn < 4) { const int h = 2 * (pn & 1) + (wc >> 1); const float lg = __builtin_amdgcn_logf(1.f - __builtin_amdgcn_exp2f(-5.f - (float)h));
#pragma unroll
                for (int m = 0; m < 4; ++m) { const float pos = (float)(wr * 64 + m * 16 + fr); f[m] = pn < 2 ? __builtin_amdgcn_exp2f(lg * pos) : 0.08838834764831845f * __builtin_amdgcn_exp2f(-lg * pos); } }
#pragma unroll
            for (int ai = 0; ai < 2; ++ai)
#pragma unroll
                for (int m = 0; m < 4; ++m)
#pragma unroll
                    for (int bj = 0; bj < 2; ++bj) *(u32x4*)(base + (size_t)(ai * 128 + m * 16) * INWp + bj * 32) = pack8(acc[ai][bj][m][0] * f[m], acc[ai][bj][m][1] * f[m]);
        } else if (pn < 12 || pn >= 24) {
            const bool silu = pn < 12;
#pragma unroll
            for (int ai = 0; ai < 2; ++ai)
#pragma unroll
                for (int m = 0; m < 4; ++m)
#pragma unroll
                    for (int bj = 0; bj < 2; ++bj) { f32x4 v[2];
#pragma unroll
                        for (int n = 0; n < 2; ++n)
#pragma unroll
                            for (int e = 0; e < 4; ++e) { const float x = acc[ai][bj][m][n][e], s = fast_sigmoid(x); v[n][e] = silu ? x * s : s; }
                        *(u32x4*)(base + (size_t)(ai * 128 + m * 16) * INWp + bj * 32) = pack8(v[0], v[1]); }
        } else {
            const LAS float* g = gqk + (pn < 16 ? 0 : 64) + fq * 8;
            f32x4 gv[2][2];
#pragma unroll
            for (int bj = 0; bj < 2; ++bj)
#pragma unroll
                for (int n = 0; n < 2; ++n) gv[bj][n] = *(const LAS f32x4*)(g + bj * 32 + n * 4);
#pragma unroll
            for (int ai = 0; ai < 2; ++ai)
#pragma unroll
                for (int m = 0; m < 4; ++m) { float ss = 0.f;
#pragma unroll
                    for (int bj = 0; bj < 2; ++bj)
#pragma unroll
                        for (int n = 0; n < 2; ++n) { const f32x4 x = acc[ai][bj][m][n]; ss += (x[0] * x[0] + x[1] * x[1]) + (x[2] * x[2] + x[3] * x[3]); }
                    ss += __shfl_xor(ss, 16); ss += __shfl_xor(ss, 32);
                    const float r = __builtin_amdgcn_rsqf(ss * (1.f / 64) + EPS);
#pragma unroll
                    for (int bj = 0; bj < 2; ++bj) *(u32x4*)(base + (size_t)(ai * 128 + m * 16) * INWp + bj * 32) = pack8(acc[ai][bj][m][0] * gv[bj][0] * r, acc[ai][bj][m][1] * gv[bj][1] * r); }
        }
    }
};
struct EpiOutF {
    const float* x; const float* mod; bf16* x1b;
    static __device__ __forceinline__ int nstores(const pg8::GUnit&) { return 16; }
    __device__ __forceinline__ void operator()(const f32x4 (&acc)[2][2][4][2], const pg8::GUnit& u, int wr, int wc, int fr, int fq) const {
        const int row0 = u.pm * 256 + wr * 64 + fr, col0 = u.pn * 256 + wc * 32 + fq * 8, b = (u.pm * 256) / S;
        f32x4 gt[2][2];
#pragma unroll
        for (int bj = 0; bj < 2; ++bj)
#pragma unroll
            for (int n = 0; n < 2; ++n) gt[bj][n] = *(const f32x4*)(mod + b * 6144 + 2048 + col0 + bj * 128 + n * 4);
#pragma unroll
        for (int ai = 0; ai < 2; ++ai)
#pragma unroll
            for (int m = 0; m < 4; ++m) { const size_t ro = (size_t)(row0 + ai * 128 + m * 16) * D + col0;
#pragma unroll
                for (int bj = 0; bj < 2; ++bj) { const f32x4 x0 = *(const f32x4*)(x + ro + bj * 128), x1 = *(const f32x4*)(x + ro + bj * 128 + 4);
                    *(u32x4*)(x1b + ro + bj * 128) = pack8(x0 + gt[bj][0] * acc[ai][bj][m][0], x1 + gt[bj][1] * acc[ai][bj][m][1]); } }
    }
};
struct EpiActF {
    static __device__ __forceinline__ int nstores(const pg8::GUnit&) { return 8; }
    const LAS float* btab; bf16* act;
    __device__ __forceinline__ void operator()(const f32x4 (&acc)[2][2][4][2], const pg8::GUnit& u, int wr, int wc, int fr, int fq) const {
        const int row0 = u.pm * 256 + wr * 64 + fr, c0 = u.pn * 128 + wc * 32 + fq * 8;
        const LAS float* bt = btab + u.s * 256 + wc * 32 + fq * 8;
        constexpr float ASC = (float)(1 << A_SH);
        f32x4 bg[2], bu[2];
#pragma unroll
        for (int n = 0; n < 2; ++n) { bg[n] = *(const LAS f32x4*)(bt + n * 4); bu[n] = (*(const LAS f32x4*)(bt + 128 + n * 4) + 1.f) * ASC; }
#pragma unroll
        for (int ai = 0; ai < 2; ++ai)
#pragma unroll
            for (int m = 0; m < 4; ++m) { f32x4 v[2];
#pragma unroll
                for (int n = 0; n < 2; ++n) {
                    f32x4 g = acc[ai][0][m][n] + bg[n], up = acc[ai][1][m][n] * ASC + bu[n], ex, rc;
#pragma unroll
                    for (int e = 0; e < 4; ++e) { g[e] = fminf(g[e], 7.f); up[e] = __builtin_amdgcn_fmed3f(up[e], -6.f * ASC, 8.f * ASC); }
                    const f32x4 a = g * (-1.702f * LOG2E);
#pragma unroll
                    for (int e = 0; e < 4; ++e) ex[e] = __builtin_amdgcn_exp2f(a[e]);
                    const f32x4 d = ex + 1.f;
#pragma unroll
                    for (int e = 0; e < 4; ++e) rc[e] = __builtin_amdgcn_rcpf(d[e]);
                    v[n] = (g * up) * rc; }
                if (FP8_MOE) { u32x2 o; o.x = pk4_fp8_nc(v[0][0], v[0][1], v[0][2], v[0][3]); o.y = pk4_fp8_nc(v[1][0], v[1][1], v[1][2], v[1][3]);
                    *(u32x2*)((unsigned char*)act + (size_t)(row0 + ai * 128 + m * 16) * FF + c0) = o; }
                else *(u32x4*)(act + (size_t)(row0 + ai * 128 + m * 16) * FF + c0) = pack8(v[0] * (1.f / ASC), v[1] * (1.f / ASC)); }
    }
};
struct EpiEOF {
    static __device__ __forceinline__ int nstores(const pg8::GUnit&) { return 8; }
    const LAS float* btab; bf16* eo;
    __device__ __forceinline__ void operator()(const f32x4 (&acc)[2][2][4][2], const pg8::GUnit& u, int wr, int wc, int fr, int fq) const {
        const int row0 = u.pm * 256 + wr * 64 + fr, col0 = u.pn * 256 + wc * 64 + fq * 16;
        const LAS float* bt = btab + u.s * 256 + wc * 64 + fq * 16;
        constexpr float ESC = (float)(1 << E_SH);
        f32x4 bv[2][2];
#pragma unroll
        for (int bj = 0; bj < 2; ++bj)
#pragma unroll
            for (int n = 0; n < 2; ++n) bv[bj][n] = *(const LAS f32x4*)(bt + bj * 8 + n * 4) * ESC;
#pragma unroll
        for (int ai = 0; ai < 2; ++ai)
#pragma unroll
            for (int m = 0; m < 4; ++m) { u32x4 o; f32x4 v;
                v = acc[ai][0][m][0] * ESC + bv[0][0]; o.x = pk4_fp8(v[0], v[1], v[2], v[3], 1.f);
                v = acc[ai][0][m][1] * ESC + bv[0][1]; o.y = pk4_fp8(v[0], v[1], v[2], v[3], 1.f);
                v = acc[ai][1][m][0] * ESC + bv[1][0]; o.z = pk4_fp8(v[0], v[1], v[2], v[3], 1.f);
                v = acc[ai][1][m][1] * ESC + bv[1][1]; o.w = pk4_fp8(v[0], v[1], v[2], v[3], 1.f);
                *(u32x4*)((unsigned char*)eo + (size_t)(row0 + ai * 128 + m * 16) * D + col0) = o; }
    }
};

constexpr int LDS_STAGE = 0, LDS_STAGE_BYTES = 131072;
constexpr int LDS_GTAB = 131072;
constexpr int LDS_RB2E = LDS_GTAB + 2048;
constexpr int LDS_GQK = LDS_RB2E + 2176;
constexpr int LDS_RBF = LDS_GQK + 512;
constexpr int LDS_MISC = LDS_RBF + 256;
constexpr int LDS_BTAB = LDS_MISC + 256;
constexpr int LDS_BYTES = 147456;
static_assert(LDS_BTAB + 2048 <= LDS_BYTES, "LDS map");

namespace att {
constexpr int SLOT = 32768, KOFF = 0, VOFF = 16384, NSLOT = 4;
constexpr int LDS_WS = LDS_GTAB;
constexpr int LDS_X = 0;
constexpr int LDS_Y = 65536;
constexpr int LDS_XS = LDS_BTAB;
constexpr int LDS_GSUB = LDS_GQK;
constexpr float THR = 8.f;
typedef short v4i16 __attribute__((ext_vector_type(4)));
template <int OFF> __device__ __forceinline__ bf16x8 rd128(unsigned a) { bf16x8 v; asm volatile("ds_read_b128 %0, %1 offset:%2" : "=v"(v) : "v"(a), "n"(OFF)); return v; }
template <int OFF> __device__ __forceinline__ v4i16 rdtr(unsigned a) { v4i16 v; asm volatile("ds_read_b64_tr_b16 %0, %1 offset:%2" : "=v"(v) : "v"(a), "n"(OFF)); return v; }
__device__ __forceinline__ float max3(float a, float b, float c) { float r; asm("v_max3_f32 %0, %1, %2, %3" : "=v"(r) : "v"(a), "v"(b), "v"(c)); return r; }
#define ATT_WAITV(n) asm volatile("s_waitcnt vmcnt(" #n ")" ::: "memory")
#define ATT_BAR() asm volatile("s_waitcnt lgkmcnt(0)\n\ts_barrier" ::: "memory")
#define ATT_WAIT_TILE(k_, last_) do { const int _y = ((last_) < NTu - 1 ? (last_) : NTu - 1) - (k_); if (_y >= 2) ATT_WAITV(8); else if (_y == 1) ATT_WAITV(4); else ATT_WAITV(0); } while (0)
__device__ __forceinline__ void unit(const int b, const int h, const int qb, const int t_lo, const bf16* __restrict__ proj, bf16* __restrict__ odiff, LAS unsigned char* lds, const float lam, const float* __restrict__ gsub,
                                     const bool pre, const bool nvalid, const int nb, const int nh, const int nqb, bf16x8& qn0, bf16x8& qn1, bf16x8& qn2, bf16x8& qn3) {
    int tid = threadIdx.x; asm volatile("" : "+v"(tid));
    const int lane = tid & 63, r = lane & 31, hi = lane >> 5; const int wid = __builtin_amdgcn_readfirstlane(tid >> 6), c = wid >> 2, sb = wid & 3;
    const size_t rowb = (size_t)b * S; const int q0 = 128 * qb + 32 * sb;
    const size_t hrow = (size_t)(b * 8 + h) * S;
    const bf16* Kg = proj + PO_DK + hrow * 128; const bf16* Vg = proj + PO_DV + hrow * 128;
    const bf16* Qg = proj + PO_DQ + (hrow + q0 + r) * 128 + c * 64 + hi * 8;
    bf16x8 qf[4];
    if (pre) { qf[0] = qn0; qf[1] = qn1; qf[2] = qn2; qf[3] = qn3; }
    else {
#pragma unroll
        for (int ks = 0; ks < 4; ++ks) qf[ks] = *(const bf16x8*)(Qg + 16 * ks);
    }
    const float slope2 = __builtin_amdgcn_exp2f(-(float)(h + 1)) * LOG2E;
    const int t_hi = 2 * qb + 1, NTu = t_hi + 1 - t_lo;
    LAS float* wsf = (LAS float*)(lds + LDS_WS) + wid * 64;
    const unsigned lds0 = (unsigned)(uintptr_t)lds;
    unsigned kof[2], vof[2];
#pragma unroll
    for (int j = 0; j < 2; ++j) { const int pc = wid + 8 * j, key = 4 * pc + (lane >> 4); kof[j] = (unsigned)(key * 256 + (((lane & 15) ^ (key & 7)) << 4));
        const int blk = wid + 8 * j, d0 = blk >> 2, kk = blk & 3; vof[j] = (unsigned)((16 * kk + (lane >> 2)) * 256 + (32 * d0 + 8 * (lane & 3)) * 2); }
#define ATT_DMA(it_) do { const int _t = t_hi - (it_); LAS unsigned char* _s = lds + (((it_) + 3) & 3) * SLOT; \
        const char* _kb = (const char*)Kg + (size_t)_t * 16384; const char* _vb = (const char*)Vg + (size_t)_t * 16384; \
        _Pragma("unroll") for (int _j = 0; _j < 2; ++_j) __builtin_amdgcn_global_load_lds((const unsigned*)(_kb + kof[_j]), (LAS unsigned*)(_s + KOFF + (wid + 8 * _j) * 1024), 16, 0, 0); \
        _Pragma("unroll") for (int _j = 0; _j < 2; ++_j) __builtin_amdgcn_global_load_lds((const unsigned*)(_vb + vof[_j]), (LAS unsigned*)(_s + VOFF + (wid + 8 * _j) * 1024), 16, 0, 0); } while (0)
    if (!pre) ATT_DMA(0);
    ATT_DMA(1); if (NTu > 2) ATT_DMA(2);
    f32x16 o[4], ol;
#pragma unroll
    for (int q = 0; q < 16; ++q) { ol[q] = 0.f;
#pragma unroll
        for (int d = 0; d < 4; ++d) o[d][q] = 0.f; }
    float m = 0.f;
    unsigned kl[4];
#pragma unroll
    for (int ks = 0; ks < 4; ++ks) kl[ks] = lds0 + KOFF + r * 256 + (((8 * c + 2 * ks + hi) ^ (r & 7)) << 4);
    const unsigned vl = lds0 + VOFF + ((lane >> 4) & 1) * 32 + (lane & 3) * 8 + (4 * hi + ((lane & 15) >> 2)) * 64;
    f32x16 p0, p1;
    const bf16x8 ones = (bf16x8){0x3F80, 0x3F80, 0x3F80, 0x3F80, 0x3F80, 0x3F80, 0x3F80, 0x3F80};
    bf16x8 A0c, A1c;
    { const float a0 = slope2 * (float)r, a1 = slope2 * (float)(r + 32);
        const unsigned h0 = pg8::cvt_pk_bf16(a0, 0.f), h1 = pg8::cvt_pk_bf16(a1, 0.f);
        const unsigned l0 = pg8::cvt_pk_bf16(a0 - __builtin_bit_cast(float, h0 << 16), 0.f), l1 = pg8::cvt_pk_bf16(a1 - __builtin_bit_cast(float, h1 << 16), 0.f);
        const unsigned mk = hi ? 0u : 0xffffffffu;
        A0c = __builtin_bit_cast(bf16x8, (u32x4){(h0 | (l0 << 16)) & mk, 0x3F803F80u & mk, 0x00003F80u & mk, 0u});
        A1c = __builtin_bit_cast(bf16x8, (u32x4){(h1 | (l1 << 16)) & mk, 0x3F803F80u & mk, 0x00003F80u & mk, 0u}); }
#define ATT_PINIT(it_) do { const int _t = t_hi - (it_); const float b_ = fmaf(slope2, (float)(64 * _t - (q0 + r)), -m); \
        const unsigned t1_ = pg8::cvt_pk_bf16(b_, 0.f); const float r1_ = b_ - __builtin_bit_cast(float, t1_ << 16); \
        const unsigned t2_ = pg8::cvt_pk_bf16(r1_, 0.f); const float r2_ = r1_ - __builtin_bit_cast(float, t2_ << 16); \
        const unsigned t3_ = pg8::cvt_pk_bf16(r2_, 0.f), mk_ = hi ? 0u : 0xffffffffu; \
        const bf16x8 Bt_ = __builtin_bit_cast(bf16x8, (u32x4){0x3F803F80u & mk_, (t1_ | (t2_ << 16)) & mk_, t3_ & mk_, 0u}); \
        const f32x16 z16_ = {0.f, 0.f, 0.f, 0.f, 0.f, 0.f, 0.f, 0.f, 0.f, 0.f, 0.f, 0.f, 0.f, 0.f, 0.f, 0.f}; \
        p0 = __builtin_amdgcn_mfma_f32_32x32x16_bf16(A0c, Bt_, z16_, 0, 0, 0); p1 = __builtin_amdgcn_mfma_f32_32x32x16_bf16(A1c, Bt_, z16_, 0, 0, 0); } while (0)
#define ATT_H1(it_, FIRST_) do { const int _t = t_hi - (it_); \
        if (64 * _t <= q0 + 31) { const unsigned so_ = (unsigned)(((it_) + 3) & 3) * SLOT; \
            bf16x8 k0 = rd128<0>(kl[0] + so_), k1 = rd128<0>(kl[1] + so_), k2 = rd128<0>(kl[2] + so_), k3 = rd128<0>(kl[3] + so_), k4 = rd128<8192>(kl[0] + so_), k5 = rd128<8192>(kl[1] + so_), k6 = rd128<8192>(kl[2] + so_), k7 = rd128<8192>(kl[3] + so_); \
            asm volatile("s_waitcnt lgkmcnt(0)" : "+v"(k0), "+v"(k1), "+v"(k2), "+v"(k3), "+v"(k4), "+v"(k5), "+v"(k6), "+v"(k7)); \
            p0 = __builtin_amdgcn_mfma_f32_32x32x16_bf16(k0, qf[0], p0, 0, 0, 0); p1 = __builtin_amdgcn_mfma_f32_32x32x16_bf16(k4, qf[0], p1, 0, 0, 0); \
            p0 = __builtin_amdgcn_mfma_f32_32x32x16_bf16(k1, qf[1], p0, 0, 0, 0); p1 = __builtin_amdgcn_mfma_f32_32x32x16_bf16(k5, qf[1], p1, 0, 0, 0); \
            p0 = __builtin_amdgcn_mfma_f32_32x32x16_bf16(k2, qf[2], p0, 0, 0, 0); p1 = __builtin_amdgcn_mfma_f32_32x32x16_bf16(k6, qf[2], p1, 0, 0, 0); \
            p0 = __builtin_amdgcn_mfma_f32_32x32x16_bf16(k3, qf[3], p0, 0, 0, 0); p1 = __builtin_amdgcn_mfma_f32_32x32x16_bf16(k7, qf[3], p1, 0, 0, 0); \
            if (64 * _t + 63 > q0) { \
                _Pragma("unroll") for (int q = 0; q < 16; ++q) { const int j = 64 * _t + crow(q, hi); if (j > q0 + r) p0[q] = -INFINITY; if (j + 32 > q0 + r) p1[q] = -INFINITY; } } \
            float rm = max3(p0[0], p0[1], p1[0]); rm = max3(rm, p1[1], p0[2]); rm = max3(rm, p0[3], p1[2]); rm = max3(rm, p1[3], p0[4]); \
            rm = max3(rm, p0[5], p1[4]); rm = max3(rm, p1[5], p0[6]); rm = max3(rm, p0[7], p1[6]); rm = max3(rm, p1[7], p0[8]); \
            rm = max3(rm, p0[9], p1[8]); rm = max3(rm, p1[9], p0[10]); rm = max3(rm, p0[11], p1[10]); rm = max3(rm, p1[11], p0[12]); \
            rm = max3(rm, p0[13], p1[12]); rm = max3(rm, p1[13], p0[14]); rm = max3(rm, p0[15], p1[14]); rm = max3(rm, p1[15], rm); \
            rm = fmaxf(rm, __shfl_xor(rm, 32)); \
            if (FIRST_) { m = rm;                                         \
                _Pragma("unroll") for (int q = 0; q < 16; ++q) { p0[q] -= rm; p1[q] -= rm; } } \
            else if (__any(rm > THR)) { \
                const float dl = fmaxf(rm, 0.f), alpha = __builtin_amdgcn_exp2f(-dl); m += dl; \
                _Pragma("unroll") for (int q = 0; q < 16; ++q) { p0[q] -= dl; p1[q] -= dl; } \
                if (hi == 0) wsf[r] = alpha; \
                asm volatile("s_waitcnt lgkmcnt(0)" ::: "memory"); \
                _Pragma("unroll") for (int g4 = 0; g4 < 4; ++g4) { const f32x4 a4 = *(const LAS f32x4*)(wsf + 8 * g4 + 4 * hi);     \
                    _Pragma("unroll") for (int e = 0; e < 4; ++e) { ol[4 * g4 + e] *= a4[e]; \
                        _Pragma("unroll") for (int d = 0; d < 4; ++d) o[d][4 * g4 + e] *= a4[e]; } \
                    __builtin_amdgcn_sched_barrier(0); } } \
            _Pragma("unroll") for (int q = 0; q < 16; ++q) { p0[q] = __builtin_amdgcn_exp2f(p0[q]); p1[q] = __builtin_amdgcn_exp2f(p1[q]); } } } while (0)
#define ATT_VRD(dst, s_) do { dst##0l = rdtr<(s_) * 2048>(va); dst##0h = rdtr<(s_) * 2048 + 512>(va); dst##1l = rdtr<(s_) * 2048 + 1024>(va); dst##1h = rdtr<(s_) * 2048 + 1536>(va); } while (0)
#define ATT_VWAIT(n, dst) asm volatile("s_waitcnt lgkmcnt(" #n ")" : "+v"(dst##0l), "+v"(dst##0h), "+v"(dst##1l), "+v"(dst##1h))
#define ATT_VF(dst, k) (bf16x8){dst##k##l[0], dst##k##l[1], dst##k##l[2], dst##k##l[3], dst##k##h[0], dst##k##h[1], dst##k##h[2], dst##k##h[3]}
#define ATT_PV(s_, dst, PA, PB) do { o[(s_) >> 1] = __builtin_amdgcn_mfma_f32_32x32x16_bf16(PA, ATT_VF(dst, 0), o[(s_) >> 1], 0, 0, 0); o[(s_) >> 1] = __builtin_amdgcn_mfma_f32_32x32x16_bf16(PB, ATT_VF(dst, 1), o[(s_) >> 1], 0, 0, 0); } while (0)
#define ATT_PACK(P, b8) __builtin_bit_cast(bf16x8, (u32x4){pg8::cvt_pk_bf16(P[b8 + 0], P[b8 + 1]), pg8::cvt_pk_bf16(P[b8 + 2], P[b8 + 3]), pg8::cvt_pk_bf16(P[b8 + 4], P[b8 + 5]), pg8::cvt_pk_bf16(P[b8 + 6], P[b8 + 7])})
#define ATT_H2(it_) do { const int _t = t_hi - (it_); \
        if (64 * _t <= q0 + 31) { const unsigned va = vl + (unsigned)(((it_) + 3) & 3) * SLOT; \
            v4i16 A0l, A0h, A1l, A1h, B0l, B0h, B1l, B1h; \
            ATT_VRD(A, 0); \
            const bf16x8 pa0 = ATT_PACK(p0, 0), pa1 = ATT_PACK(p0, 8), pa2 = ATT_PACK(p1, 0), pa3 = ATT_PACK(p1, 8); \
            ATT_VRD(B, 1); \
            ol = __builtin_amdgcn_mfma_f32_32x32x16_bf16(pa0, ones, ol, 0, 0, 0); ol = __builtin_amdgcn_mfma_f32_32x32x16_bf16(pa1, ones, ol, 0, 0, 0); \
            ol = __builtin_amdgcn_mfma_f32_32x32x16_bf16(pa2, ones, ol, 0, 0, 0); ol = __builtin_amdgcn_mfma_f32_32x32x16_bf16(pa3, ones, ol, 0, 0, 0); \
            ATT_VWAIT(4, A); ATT_PV(0, A, pa0, pa1); ATT_VRD(A, 2); ATT_VWAIT(4, B); ATT_PV(1, B, pa2, pa3); \
            ATT_VRD(B, 3); ATT_VWAIT(4, A); ATT_PV(2, A, pa0, pa1); ATT_VRD(A, 4); ATT_VWAIT(4, B); ATT_PV(3, B, pa2, pa3); \
            ATT_VRD(B, 5); ATT_VWAIT(4, A); ATT_PV(4, A, pa0, pa1); ATT_VRD(A, 6); ATT_VWAIT(4, B); ATT_PV(5, B, pa2, pa3); \
            ATT_VRD(B, 7); ATT_VWAIT(4, A); ATT_PV(6, A, pa0, pa1); ATT_VWAIT(0, B); ATT_PV(7, B, pa2, pa3); } \
        if ((it_) + 1 < NTu) ATT_PINIT((it_) + 1); } while (0)
    { const float m0 = m; (void)m0; ATT_PINIT(0); }
    if (c == 0) {
        ATT_WAIT_TILE(0, 2); ATT_BAR();
        ATT_H1(0, true);
        ATT_BAR();
        ATT_H2(0); if (3 < NTu) ATT_DMA(3);
        for (int it = 1; it < NTu; ++it) {
            ATT_WAIT_TILE(it, it + 2); ATT_BAR();
            ATT_H1(it, false);
            ATT_BAR();
            ATT_H2(it); if (it + 3 < NTu) ATT_DMA(it + 3);
        }
        ATT_BAR();
    } else {
        ATT_WAIT_TILE(0, 2); ATT_BAR();
        ATT_BAR();
        ATT_H1(0, true);
        ATT_WAIT_TILE(1, 2);
        ATT_BAR();
        ATT_H2(0); if (3 < NTu) ATT_DMA(3);
        for (int it = 1; it < NTu; ++it) {
            ATT_BAR();
            ATT_H1(it, false);
            if (it + 1 < NTu) ATT_WAIT_TILE(it + 1, it + 2);
            ATT_BAR();
            ATT_H2(it); if (it + 3 < NTu) ATT_DMA(it + 3);
        }
    }
    float rl[16];
#pragma unroll
    for (int q = 0; q < 16; ++q) rl[q] = (c == 1 ? lam : 1.f) * __builtin_amdgcn_rcpf(ol[q]);
#pragma unroll
    for (int d0 = 0; d0 < 4; ++d0)
#pragma unroll
        for (int q = 0; q < 16; ++q) o[d0][q] *= rl[q];
    ATT_BAR();
    if (nvalid) { const size_t nhrow = (size_t)(nb * 8 + nh) * S; LAS unsigned char* _s = lds + 3 * SLOT;
        const char* _kb = (const char*)(proj + PO_DK + nhrow * 128) + (size_t)(2 * nqb + 1) * 16384; const char* _vb = (const char*)(proj + PO_DV + nhrow * 128) + (size_t)(2 * nqb + 1) * 16384;
#pragma unroll
        for (int _j = 0; _j < 2; ++_j) __builtin_amdgcn_global_load_lds((const unsigned*)(_kb + kof[_j]), (LAS unsigned*)(_s + KOFF + (wid + 8 * _j) * 1024), 16, 0, 0);
#pragma unroll
        for (int _j = 0; _j < 2; ++_j) __builtin_amdgcn_global_load_lds((const unsigned*)(_vb + vof[_j]), (LAS unsigned*)(_s + VOFF + (wid + 8 * _j) * 1024), 16, 0, 0);
        const bf16* nQg = proj + PO_DQ + (nhrow + 128 * nqb + 32 * sb + r) * 128 + c * 64 + hi * 8;
        qn0 = *(const bf16x8*)(nQg); qn1 = *(const bf16x8*)(nQg + 16); qn2 = *(const bf16x8*)(nQg + 32); qn3 = *(const bf16x8*)(nQg + 48); }
    else { qn0 = (bf16x8){}; qn1 = (bf16x8){}; qn2 = (bf16x8){}; qn3 = (bf16x8){}; }
    { LAS f32x4* XE = (LAS f32x4*)(lds + LDS_X) + ((c * 4 + sb) * 8) * 64 + lane;
        if (c == 0) {
#pragma unroll
            for (int j = 0; j < 8; ++j) XE[j * 64] = (f32x4){o[2 + (j >> 2)][4 * (j & 3)], o[2 + (j >> 2)][4 * (j & 3) + 1], o[2 + (j >> 2)][4 * (j & 3) + 2], o[2 + (j >> 2)][4 * (j & 3) + 3]};
        } else {
#pragma unroll
            for (int j = 0; j < 8; ++j) XE[j * 64] = (f32x4){o[j >> 2][4 * (j & 3)], o[j >> 2][4 * (j & 3) + 1], o[j >> 2][4 * (j & 3) + 2], o[j >> 2][4 * (j & 3) + 3]};
        } }
    ATT_BAR();
    float v[2][16], ss[16];
    { const LAS f32x4* XR = (const LAS f32x4*)(lds + LDS_X) + (((c ^ 1) * 4 + sb) * 8) * 64 + lane;
        f32x4 pr[8];
#pragma unroll
        for (int j = 0; j < 8; ++j) pr[j] = XR[j * 64];
        if (c == 0) {
#pragma unroll
            for (int k = 0; k < 2; ++k)
#pragma unroll
                for (int q = 0; q < 16; ++q) v[k][q] = o[k][q] - pr[4 * k + (q >> 2)][q & 3];
        } else {
#pragma unroll
            for (int k = 0; k < 2; ++k)
#pragma unroll
                for (int q = 0; q < 16; ++q) v[k][q] = pr[4 * k + (q >> 2)][q & 3] - o[2 + k][q];
        } }
#pragma unroll
    for (int q = 0; q < 16; ++q) { ss[q] = rowsum16(v[0][q] * v[0][q] + v[1][q] * v[1][q]); ss[q] += __shfl_xor(ss[q], 16); }
    LAS f32x4* XS = (LAS f32x4*)(lds + LDS_XS);
    if (r == 0) {
#pragma unroll
        for (int j = 0; j < 4; ++j) XS[((c * 4 + sb) * 2 + hi) * 4 + j] = (f32x4){ss[4 * j], ss[4 * j + 1], ss[4 * j + 2], ss[4 * j + 3]}; }
    ATT_BAR();
    {
#pragma unroll
        for (int j = 0; j < 4; ++j) { const f32x4 ps = XS[(((c ^ 1) * 4 + sb) * 2 + hi) * 4 + j];
#pragma unroll
            for (int e = 0; e < 4; ++e) ss[4 * j + e] = __builtin_amdgcn_rsqf((ss[4 * j + e] + ps[e]) * (1.f / 128) + EPS) * (1.f - LAMBDA_INIT); } }
    LAS bf16* Y = (LAS bf16*)(lds + LDS_Y) + sb * 32 * 128;
    { const int dA = 2 * c; const LAS float* gL = (const LAS float*)(lds + LDS_GSUB);
#pragma unroll
        for (int k = 0; k < 2; ++k) { const float g = gL[32 * (dA + k) + r];
#pragma unroll
            for (int q = 0; q < 16; ++q) Y[crow(q, hi) * 128 + 32 * (dA + k) + r] = f2bf(v[k][q] * ss[q] * g); } }
    ATT_BAR();
    { bf16* Og = odiff + (rowb + q0) * D + h * 128;
#pragma unroll
        for (int i = 0; i < 4; ++i) { const int row = 16 * c + 4 * i + (lane >> 4), ch = lane & 15; *(u32x4*)(Og + (size_t)row * D + ch * 8) = *(const LAS u32x4*)(Y + row * 128 + ch * 8); } }
    ATT_BAR();
#undef ATT_DMA
#undef ATT_H1
#undef ATT_H2
#undef ATT_PINIT
}
}

namespace ret {
typedef short v4i16 __attribute__((ext_vector_type(4)));
constexpr int STG = 98304;
#define RET_BAR() do { asm volatile("s_waitcnt lgkmcnt(0)" ::: "memory"); __builtin_amdgcn_s_barrier(); asm volatile("" ::: "memory"); } while (0)
__device__ __forceinline__ bf16x8 trfrag(LAS unsigned char* p, int second_off) {
    const v4i16 lo = __builtin_amdgcn_ds_read_tr16_b64_v4i16((LAS v4i16*)p), hh = __builtin_amdgcn_ds_read_tr16_b64_v4i16((LAS v4i16*)(p + second_off));
    return (bf16x8){lo[0], lo[1], lo[2], lo[3], hh[0], hh[1], hh[2], hh[3]};
}
__device__ __forceinline__ void store_tile64(const f32x16& t0, const f32x16& t1, LAS unsigned char* stg, bf16* __restrict__ gdst, const size_t gpitch, const int lane) {
    const int r = lane & 31, hi = lane >> 5;
#pragma unroll
    for (int q = 0; q < 16; ++q) { const int row = crow(q, hi); *(LAS bf16*)(stg + row * 128 + r * 2) = f2bf(t0[q]); *(LAS bf16*)(stg + row * 128 + 64 + r * 2) = f2bf(t1[q]); }
    asm volatile("s_waitcnt lgkmcnt(0)" ::: "memory");
#pragma unroll
    for (int i = 0; i < 4; ++i) { const int row = 8 * i + (lane >> 3), ch = lane & 7; *(u32x4*)(gdst + (size_t)row * gpitch + ch * 8) = *(const LAS u32x4*)(stg + row * 128 + ch * 16); }
    asm volatile("s_waitcnt lgkmcnt(0)" ::: "memory");
}
__device__ __forceinline__ void r1_unit(const int b, const int h, const int j, const bf16* __restrict__ proj, bf16* __restrict__ ubuf, LAS unsigned char* lds) {
    constexpr int KV = 0, VV = 32768;
    int tid = threadIdx.x; asm volatile("" : "+v"(tid));
    const int lane = tid & 63, hi = lane >> 5; const int wid = __builtin_amdgcn_readfirstlane(tid >> 6), db = wid & 3, cg = wid >> 2;
    const size_t hrow = (size_t)(b * 4 + h) * S + (size_t)j * 128;
    const bf16* Kg = proj + PO_RK + hrow * 128; const bf16* Vg = proj + PO_RV + hrow * 256;
#pragma unroll
    for (int i = 0; i < 4; ++i) { const int blk = wid * 4 + i, d_b = blk >> 3, mg = blk & 7;
        __builtin_amdgcn_global_load_lds((const unsigned*)(Kg + (size_t)(16 * mg + (lane >> 2)) * 128 + 32 * d_b + 8 * (lane & 3)), (LAS unsigned*)(lds + KV + blk * 1024), 16, 0, 0); }
#pragma unroll
    for (int i = 0; i < 8; ++i) { const int blk = wid * 8 + i, cb = blk >> 3, mg = blk & 7;
        __builtin_amdgcn_global_load_lds((const unsigned*)(Vg + (size_t)(16 * mg + (lane >> 2)) * 256 + 32 * cb + 8 * (lane & 3)), (LAS unsigned*)(lds + VV + blk * 1024), 16, 0, 0); }
    const int vperm = ((lane >> 4) & 1) * 32 + (lane & 3) * 8 + (4 * hi + ((lane & 15) >> 2)) * 64;
    f32x16 u[4];
#pragma unroll
    for (int t = 0; t < 4; ++t)
#pragma unroll
        for (int q = 0; q < 16; ++q) u[t][q] = 0.f;
    asm volatile("s_waitcnt vmcnt(0)" ::: "memory");
    RET_BAR();
#pragma unroll
    for (int m2 = 0; m2 < 4; ++m2) {
        bf16x8 a[2], bv[2][4];
#pragma unroll
        for (int s = 0; s < 2; ++s) { const int mg = 2 * m2 + s; a[s] = trfrag(lds + KV + (db * 8 + mg) * 1024 + vperm, 512);
#pragma unroll
            for (int t = 0; t < 4; ++t) bv[s][t] = trfrag(lds + VV + ((4 * cg + t) * 8 + mg) * 1024 + vperm, 512); }
#pragma unroll
        for (int s = 0; s < 2; ++s)
#pragma unroll
            for (int t = 0; t < 4; ++t) u[t] = __builtin_amdgcn_mfma_f32_32x32x16_bf16(a[s], bv[s][t], u[t], 0, 0, 0);
    }
    bf16* Ug = ubuf + (((size_t)b * 4 + h) * 32 + j) * 32768 + (size_t)(32 * db) * 256 + 128 * cg;
    LAS unsigned char* stg = lds + STG + wid * 4096;
    store_tile64(u[0], u[1], stg, Ug, 256, lane);
    store_tile64(u[2], u[3], stg, Ug + 64, 256, lane);
    RET_BAR();
}
__device__ __forceinline__ void r3_unit(const int b, const int h, const int j, const int half, const bf16* __restrict__ proj, const bf16* __restrict__ rbbuf, bf16* __restrict__ yret, LAS unsigned char* lds) {
    constexpr int KK = 0, VV = 32768, RB = 65536;
    int tid = threadIdx.x; asm volatile("" : "+v"(tid));
    const int lane = tid & 63, r = lane & 31, hi = lane >> 5; const int wid = __builtin_amdgcn_readfirstlane(tid >> 6), sb = wid & 3, ch = wid >> 2;
    const size_t row0 = (size_t)b * S + (size_t)j * 128, hrow = (size_t)(b * 4 + h) * S + (size_t)j * 128;
    const bf16* Qg = proj + PO_RQ + hrow * 128; const bf16* Kg = proj + PO_RK + hrow * 128; const bf16* Vg = proj + PO_RV + hrow * 256 + half * 128;
    const bf16* Rg = rbbuf + (((size_t)b * 4 + h) * 32 + j) * 32768 + half * 128;
#pragma unroll
    for (int i = 0; i < 4; ++i) { const int pc = wid * 4 + i, cidx = pc >> 1, mh = pc & 1;
        __builtin_amdgcn_global_load_lds((const unsigned*)(Kg + (size_t)(64 * mh + lane) * 128 + cidx * 8), (LAS unsigned*)(lds + KK + cidx * 2048 + mh * 1024), 16, 0, 0); }
#pragma unroll
    for (int i = 0; i < 4; ++i) { const int blk = wid * 4 + i, cb = blk >> 3, mg = blk & 7;
        __builtin_amdgcn_global_load_lds((const unsigned*)(Vg + (size_t)(16 * mg + (lane >> 2)) * 256 + 32 * cb + 8 * (lane & 3)), (LAS unsigned*)(lds + VV + blk * 1024), 16, 0, 0);
        __builtin_amdgcn_global_load_lds((const unsigned*)(Rg + (size_t)(16 * mg + (lane >> 2)) * 256 + 32 * cb + 8 * (lane & 3)), (LAS unsigned*)(lds + RB + blk * 1024), 16, 0, 0); }
    bf16x8 qf[8];
#pragma unroll
    for (int ks = 0; ks < 8; ++ks) qf[ks] = *(const bf16x8*)(Qg + (size_t)(32 * sb + r) * 128 + 16 * ks + 8 * hi);
    const int vperm = ((lane >> 4) & 1) * 32 + (lane & 3) * 8 + (4 * hi + ((lane & 15) >> 2)) * 64;
    const int vnat  = ((lane >> 4) & 1) * 32 + (lane & 3) * 8 + (8 * hi + ((lane & 15) >> 2)) * 64;
    asm volatile("s_waitcnt vmcnt(0)" ::: "memory");
    RET_BAR();
    bf16x8 pa[8];
#pragma unroll
    for (int kb = 0; kb < 4; ++kb) {
        if (kb <= sb) {
            bf16x8 kf[8];
#pragma unroll
            for (int ks = 0; ks < 8; ++ks) kf[ks] = *(const LAS bf16x8*)(lds + KK + (2 * ks + hi) * 2048 + (32 * kb + r) * 16);
            f32x16 p;
#pragma unroll
            for (int q = 0; q < 16; ++q) p[q] = 0.f;
#pragma unroll
            for (int ks = 0; ks < 8; ++ks) p = __builtin_amdgcn_mfma_f32_32x32x16_bf16(kf[ks], qf[ks], p, 0, 0, 0);
            if (kb == sb) {
#pragma unroll
                for (int q = 0; q < 16; ++q) if (crow(q, hi) > r) p[q] = 0.f;
            }
#pragma unroll
            for (int b8 = 0; b8 < 2; ++b8) { u32x4 w;
                w.x = pg8::cvt_pk_bf16(p[8 * b8 + 0], p[8 * b8 + 1]); w.y = pg8::cvt_pk_bf16(p[8 * b8 + 2], p[8 * b8 + 3]); w.z = pg8::cvt_pk_bf16(p[8 * b8 + 4], p[8 * b8 + 5]); w.w = pg8::cvt_pk_bf16(p[8 * b8 + 6], p[8 * b8 + 7]);
                pa[2 * kb + b8] = __builtin_bit_cast(bf16x8, w); }
        }
    }
    f32x16 y[2];
#pragma unroll
    for (int d0 = 0; d0 < 2; ++d0) {
#pragma unroll
        for (int q = 0; q < 16; ++q) y[d0][q] = 0.f;
        const int cb = 2 * ch + d0;
        bf16x8 vf[8];
#pragma unroll
        for (int kk = 0; kk < 8; ++kk) if ((kk >> 1) <= sb) vf[kk] = trfrag(lds + VV + (cb * 8 + kk) * 1024 + vperm, 512);
#pragma unroll
        for (int kk = 0; kk < 8; ++kk) if ((kk >> 1) <= sb) y[d0] = __builtin_amdgcn_mfma_f32_32x32x16_bf16(pa[kk], vf[kk], y[d0], 0, 0, 0);
        bf16x8 rf[8];
#pragma unroll
        for (int ks = 0; ks < 8; ++ks) rf[ks] = trfrag(lds + RB + (cb * 8 + ks) * 1024 + vnat, 256);
#pragma unroll
        for (int ks = 0; ks < 8; ++ks) y[d0] = __builtin_amdgcn_mfma_f32_32x32x16_bf16(qf[ks], rf[ks], y[d0], 0, 0, 0);
    }
    bf16* Yg = yret + (row0 + 32 * sb) * D + h * 256 + half * 128 + 64 * ch;
    store_tile64(y[0], y[1], lds + STG + wid * 4096, Yg, D, lane);
    RET_BAR();
}
__device__ __forceinline__ float rbflo(unsigned u) { return __builtin_bit_cast(float, u << 16); }
__device__ __forceinline__ float rbfhi(unsigned u) { return __builtin_bit_cast(float, u & 0xffff0000u); }
__device__ __forceinline__ void r3m_unit(const int b, const int h, const int j, const bf16* __restrict__ proj, const bf16* __restrict__ rbbuf, const bf16* __restrict__ odiff, bf16* __restrict__ merged,
                                         const float* __restrict__ ggn, const float* __restrict__ bgn, LAS unsigned char* lds) {
    constexpr int KK = 0, VV = 32768, RB = 65536, XS = 98304;
    int tid = threadIdx.x; asm volatile("" : "+v"(tid));
    const int lane = tid & 63, r = lane & 31, hi = lane >> 5; const int wid = __builtin_amdgcn_readfirstlane(tid >> 6), sb = wid & 3, ch = wid >> 2;
    const size_t row0 = (size_t)b * S + (size_t)j * 128, hrow = (size_t)(b * 4 + h) * S + (size_t)j * 128;
    const bf16* Qg = proj + PO_RQ + hrow * 128; const bf16* Kg = proj + PO_RK + hrow * 128; const bf16* Vg = proj + PO_RV + hrow * 256;
    const bf16* Rg = rbbuf + (((size_t)b * 4 + h) * 32 + j) * 32768;
#pragma unroll
    for (int i = 0; i < 4; ++i) { const int pc = wid * 4 + i, cidx = pc >> 1, mh = pc & 1;
        __builtin_amdgcn_global_load_lds((const unsigned*)(Kg + (size_t)(64 * mh + lane) * 128 + cidx * 8), (LAS unsigned*)(lds + KK + cidx * 2048 + mh * 1024), 16, 0, 0); }
#define R3M_DMA_VR(half_) do { _Pragma("unroll") for (int i = 0; i < 4; ++i) { const int blk = wid * 4 + i, cb = blk >> 3, mg = blk & 7; \
        __builtin_amdgcn_global_load_lds((const unsigned*)(Vg + (half_) * 128 + (size_t)(16 * mg + (lane >> 2)) * 256 + 32 * cb + 8 * (lane & 3)), (LAS unsigned*)(lds + VV + blk * 1024), 16, 0, 0); \
        __builtin_amdgcn_global_load_lds((const unsigned*)(Rg + (half_) * 128 + (size_t)(16 * mg + (lane >> 2)) * 256 + 32 * cb + 8 * (lane & 3)), (LAS unsigned*)(lds + RB + blk * 1024), 16, 0, 0); } } while (0)
    R3M_DMA_VR(0);
    bf16x8 qf[8];
#pragma unroll
    for (int ks = 0; ks < 8; ++ks) qf[ks] = *(const bf16x8*)(Qg + (size_t)(32 * sb + r) * 128 + 16 * ks + 8 * hi);
    const int vperm = ((lane >> 4) & 1) * 32 + (lane & 3) * 8 + (4 * hi + ((lane & 15) >> 2)) * 64;
    const int vnat  = ((lane >> 4) & 1) * 32 + (lane & 3) * 8 + (8 * hi + ((lane & 15) >> 2)) * 64;
    asm volatile("s_waitcnt vmcnt(0)" ::: "memory");
    RET_BAR();
    bf16x8 pa[8];
#pragma unroll
    for (int kb = 0; kb < 4; ++kb) {
        if (kb <= sb) {
            bf16x8 kf[8];
#pragma unroll
            for (int ks = 0; ks < 8; ++ks) kf[ks] = *(const LAS bf16x8*)(lds + KK + (2 * ks + hi) * 2048 + (32 * kb + r) * 16);
            f32x16 p;
#pragma unroll
            for (int q = 0; q < 16; ++q) p[q] = 0.f;
#pragma unroll
            for (int ks = 0; ks < 8; ++ks) p = __builtin_amdgcn_mfma_f32_32x32x16_bf16(kf[ks], qf[ks], p, 0, 0, 0);
            if (kb == sb) {
#pragma unroll
                for (int q = 0; q < 16; ++q) if (crow(q, hi) > r) p[q] = 0.f;
            }
#pragma unroll
            for (int b8 = 0; b8 < 2; ++b8) { u32x4 w;
                w.x = pg8::cvt_pk_bf16(p[8 * b8 + 0], p[8 * b8 + 1]); w.y = pg8::cvt_pk_bf16(p[8 * b8 + 2], p[8 * b8 + 3]); w.z = pg8::cvt_pk_bf16(p[8 * b8 + 4], p[8 * b8 + 5]); w.w = pg8::cvt_pk_bf16(p[8 * b8 + 6], p[8 * b8 + 7]);
                pa[2 * kb + b8] = __builtin_bit_cast(bf16x8, w); }
        }
    }
    f32x16 y[2][2];
#define R3M_HALF(hf_) do { _Pragma("unroll") for (int d0 = 0; d0 < 2; ++d0) { \
        _Pragma("unroll") for (int q = 0; q < 16; ++q) y[hf_][d0][q] = 0.f; \
        const int cb = 2 * ch + d0; \
        bf16x8 vf[8]; \
        _Pragma("unroll") for (int kk = 0; kk < 8; ++kk) if ((kk >> 1) <= sb) vf[kk] = trfrag(lds + VV + (cb * 8 + kk) * 1024 + vperm, 512); \
        _Pragma("unroll") for (int kk = 0; kk < 8; ++kk) if ((kk >> 1) <= sb) y[hf_][d0] = __builtin_amdgcn_mfma_f32_32x32x16_bf16(pa[kk], vf[kk], y[hf_][d0], 0, 0, 0); \
        bf16x8 rf[8]; \
        _Pragma("unroll") for (int ks = 0; ks < 8; ++ks) rf[ks] = trfrag(lds + RB + (cb * 8 + ks) * 1024 + vnat, 256); \
        _Pragma("unroll") for (int ks = 0; ks < 8; ++ks) y[hf_][d0] = __builtin_amdgcn_mfma_f32_32x32x16_bf16(qf[ks], rf[ks], y[hf_][d0], 0, 0, 0); } } while (0)
    R3M_HALF(0);
    RET_BAR();
    R3M_DMA_VR(1);
    asm volatile("s_waitcnt vmcnt(0)" ::: "memory");
    RET_BAR();
    R3M_HALF(1);
    RET_BAR();
#undef R3M_DMA_VR
#undef R3M_HALF
    LAS unsigned char* stg = lds + wid * 8192;
#pragma unroll
    for (int hf = 0; hf < 2; ++hf)
#pragma unroll
        for (int d0 = 0; d0 < 2; ++d0)
#pragma unroll
            for (int q = 0; q < 16; ++q) *(LAS bf16*)(stg + crow(q, hi) * 256 + (hf * 64 + d0 * 32 + r) * 2) = f2bf(y[hf][d0][q]);
    asm volatile("s_waitcnt lgkmcnt(0)" ::: "memory");
    const int rs4 = lane >> 4, seg = lane & 15;
    u32x4 yv[8]; float sm[8], sq[8];
#pragma unroll
    for (int i = 0; i < 8; ++i) { yv[i] = *(const LAS u32x4*)(stg + (4 * i + rs4) * 256 + seg * 16);
        const float v0 = rbflo(yv[i].x), v1 = rbfhi(yv[i].x), v2 = rbflo(yv[i].y), v3 = rbfhi(yv[i].y), v4 = rbflo(yv[i].z), v5 = rbfhi(yv[i].z), v6 = rbflo(yv[i].w), v7 = rbfhi(yv[i].w);
        sm[i] = ((v0 + v1) + (v2 + v3)) + ((v4 + v5) + (v6 + v7)); sq[i] = ((v0 * v0 + v1 * v1) + (v2 * v2 + v3 * v3)) + ((v4 * v4 + v5 * v5) + (v6 * v6 + v7 * v7)); }
#pragma unroll
    for (int i = 0; i < 8; ++i) { sm[i] = rowsum16(sm[i]); sq[i] = rowsum16(sq[i]); }
    LAS float* xs = (LAS float*)(lds + XS);
    if (seg == 0) {
#pragma unroll
        for (int i = 0; i < 8; ++i) { xs[(wid * 32 + 4 * i + rs4) * 2] = sm[i]; xs[(wid * 32 + 4 * i + rs4) * 2 + 1] = sq[i]; } }
    RET_BAR();
    const int col = 256 * h + (seg < 8 ? 64 * ch + 8 * seg : 128 + 64 * ch + 8 * (seg - 8));
    const f32x4 g0 = *(const f32x4*)(ggn + col), g1 = *(const f32x4*)(ggn + col + 4), b0 = *(const f32x4*)(bgn + col), b1 = *(const f32x4*)(bgn + col + 4);
#pragma unroll
    for (int ib = 0; ib < 8; ib += 4) {
        u32x4 G1[4], G2[4], OD[4];
#pragma unroll
        for (int i = 0; i < 4; ++i) { const size_t tok = row0 + 32 * sb + 4 * (ib + i) + rs4;
            G1[i] = *(const u32x4*)(proj + PO_RG + tok * 1024 + col); G2[i] = *(const u32x4*)(proj + PO_MG + (size_t)T * 1024 + tok * 1024 + col); OD[i] = *(const u32x4*)(odiff + tok * D + col); }
#pragma unroll
        for (int i = 0; i < 4; ++i) { const int rw = 4 * (ib + i) + rs4; const size_t tok = row0 + 32 * sb + rw;
            const float ts = sm[ib + i] + xs[((wid ^ 4) * 32 + rw) * 2], tq = sq[ib + i] + xs[((wid ^ 4) * 32 + rw) * 2 + 1];
            const float mu = ts * (1.f / 256), rs = __builtin_amdgcn_rsqf(fmaxf(tq * (1.f / 256) - mu * mu, 0.f) + EPS);
            const unsigned yw[4] = {yv[ib + i].x, yv[ib + i].y, yv[ib + i].z, yv[ib + i].w}, g1w[4] = {G1[i].x, G1[i].y, G1[i].z, G1[i].w}, g2w[4] = {G2[i].x, G2[i].y, G2[i].z, G2[i].w}, odw[4] = {OD[i].x, OD[i].y, OD[i].z, OD[i].w};
            unsigned ow[4];
#pragma unroll
            for (int e = 0; e < 4; ++e) { const float gA = e < 2 ? g0[2 * e] : g1[2 * e - 4], gB = e < 2 ? g0[2 * e + 1] : g1[2 * e - 3], bA = e < 2 ? b0[2 * e] : b1[2 * e - 4], bB = e < 2 ? b0[2 * e + 1] : b1[2 * e - 3];
                const float mA = rbflo(g1w[e]) * ((rbflo(yw[e]) - mu) * rs * gA + bA) + rbflo(g2w[e]) * rbflo(odw[e]);
                const float mB = rbfhi(g1w[e]) * ((rbfhi(yw[e]) - mu) * rs * gB + bB) + rbfhi(g2w[e]) * rbfhi(odw[e]);
                ow[e] = pg8::cvt_pk_bf16(mA, mB); }
            *(u32x4*)(merged + tok * D + col) = (u32x4){ow[0], ow[1], ow[2], ow[3]}; }
    }
    RET_BAR();
}
}

struct Args { const float* in[23]; float* out; unsigned char* ws; int ph_lo, ph_hi; };
#define LDS_WAIT() asm volatile("s_waitcnt lgkmcnt(0)" ::: "memory")
__device__ __forceinline__ float wsum(float v) {
#pragma unroll
    for (int o = 1; o < 64; o <<= 1) v += __shfl_xor(v, o);
    return v;
}
__device__ __forceinline__ unsigned pk2(float lo, float hi) { return pg8::cvt_pk_bf16(lo, hi); }
__device__ __forceinline__ float bflo(unsigned u) { return __builtin_bit_cast(float, u << 16); }
__device__ __forceinline__ float bfhi(unsigned u) { return __builtin_bit_cast(float, u & 0xffff0000u); }

template <bool F8>
__device__ __forceinline__ void transpose_item(const float* __restrict__ W, int K, int N, bf16* __restrict__ WT, LAS float* scr, int k0, int n0, int l0, int lane) {
    float wv[32];
#pragma unroll
    for (int i = 0; i < 32; ++i) wv[i] = __builtin_nontemporal_load(W + (size_t)(k0 + 2 * i + (lane >> 5)) * N + l0 + (lane & 31));
#pragma unroll
    for (int i = 0; i < 32; ++i) scr[(2 * i + (lane >> 5)) * 33 + (lane & 31)] = wv[i];
    LDS_WAIT(); asm volatile("" ::: "memory");
    const int c = lane & 7;
#pragma unroll
    for (int j = 0; j < 4; ++j) { const int n = (lane >> 3) + 8 * j; const LAS float* s = scr + (8 * c) * 33 + n;
        if constexpr (F8) { u32x2 o; o.x = pk4_fp8(s[0 * 33], s[1 * 33], s[2 * 33], s[3 * 33], (float)(1 << W_SH)); o.y = pk4_fp8(s[4 * 33], s[5 * 33], s[6 * 33], s[7 * 33], (float)(1 << W_SH));
            *(u32x2*)((unsigned char*)WT + (size_t)(n0 + n) * K + k0 + 8 * c) = o; }
        else { u32x4 o; o.x = pk2(s[0 * 33], s[1 * 33]); o.y = pk2(s[2 * 33], s[3 * 33]); o.z = pk2(s[4 * 33], s[5 * 33]); o.w = pk2(s[6 * 33], s[7 * 33]);
            *(u32x4*)(WT + (size_t)(n0 + n) * K + k0 + 8 * c) = o; } }
    LDS_WAIT(); asm volatile("" ::: "memory");
}

__device__ __forceinline__ void transpose_pair_f8(const float* __restrict__ Wa, const float* __restrict__ Wb, int K, int N, unsigned char* __restrict__ WTa, unsigned char* __restrict__ WTb, LAS float* scr,
                                                  int k0a, int n0a, int l0a, int k0b, int n0b, int l0b, int lane) {
    float wa[32], wb[32];
#pragma unroll
    for (int i = 0; i < 32; ++i) wa[i] = __builtin_nontemporal_load(Wa + (size_t)(k0a + 2 * i + (lane >> 5)) * N + l0a + (lane & 31));
#pragma unroll
    for (int i = 0; i < 32; ++i) wb[i] = __builtin_nontemporal_load(Wb + (size_t)(k0b + 2 * i + (lane >> 5)) * N + l0b + (lane & 31));
    const int c = lane & 7;
#pragma unroll
    for (int p = 0; p < 2; ++p) {
#pragma unroll
        for (int i = 0; i < 32; ++i) scr[(2 * i + (lane >> 5)) * 33 + (lane & 31)] = p ? wb[i] : wa[i];
        LDS_WAIT(); asm volatile("" ::: "memory");
        unsigned char* WT = p ? WTb : WTa; const int k0 = p ? k0b : k0a, n0 = p ? n0b : n0a;
#pragma unroll
        for (int j = 0; j < 4; ++j) { const int n = (lane >> 3) + 8 * j; const LAS float* s = scr + (8 * c) * 33 + n;
            u32x2 o; o.x = pk4_fp8(s[0 * 33], s[1 * 33], s[2 * 33], s[3 * 33], (float)(1 << W_SH)); o.y = pk4_fp8(s[4 * 33], s[5 * 33], s[6 * 33], s[7 * 33], (float)(1 << W_SH));
            *(u32x2*)(WT + (size_t)(n0 + n) * K + k0 + 8 * c) = o; }
        LDS_WAIT(); asm volatile("" ::: "memory");
    }
}

__device__ __forceinline__ void phase_prologue(const Args& args, unsigned char* ws, LAS unsigned char* lds, int vcu, int G) {
    const int tid = threadIdx.x, lane = tid & 63, wave = __builtin_amdgcn_readfirstlane(tid >> 6);
    const float* c = args.in[1]; const float* w_ada = args.in[2]; const float* b_ada = args.in[3]; float* mod = (float*)(ws + WS_MOD);
    for (int blk = vcu; blk < 96; blk += G) {
        LAS float* sc = (LAS float*)lds;
        LAS float* part = (LAS float*)(lds + 32768);
        for (int i = tid; i < NB * D; i += 512) { const float v = c[i]; sc[i] = v * fast_sigmoid(v); }
        __syncthreads();
        float acc[NB];
#pragma unroll
        for (int b = 0; b < NB; ++b) acc[b] = 0.f;
        const float* wp = w_ada + (size_t)(wave * 128) * 6144 + blk * 64 + lane;
        for (int k0 = 0; k0 < 128; k0 += 32) { float wv[32];
#pragma unroll
            for (int k = 0; k < 32; ++k) wv[k] = __builtin_nontemporal_load(wp + (size_t)(k0 + k) * 6144);
#pragma unroll
            for (int k = 0; k < 32; ++k)
#pragma unroll
                for (int b = 0; b < NB; ++b) acc[b] += sc[b * D + wave * 128 + k0 + k] * wv[k]; }
#pragma unroll
        for (int b = 0; b < NB; ++b) part[(wave * NB + b) * 64 + lane] = acc[b];
        __syncthreads();
        { const int b = tid >> 6; float s = b_ada[blk * 64 + lane];
#pragma unroll
            for (int w = 0; w < 8; ++w) s += part[(w * NB + b) * 64 + lane];
            mod[b * 6144 + blk * 64 + lane] = s; }
        __syncthreads();
    }
    if (vcu == (96 % G)) {
        bf16* wrt = (bf16*)(ws + WS_WRT); const float* wr = args.in[17];
        for (int i = tid; i < NE * D; i += 512) { const int e = i >> 10, k = i & 1023; const float w = wr[(size_t)k * NE + e]; const bf16 hb_ = f2bf(w); wrt[i] = hb_; wrt[NE * D + i] = f2bf(w - bf2f(hb_)); }
    }
    LAS float* scr = (LAS float*)(lds + wave * 16384);
    const int gw = vcu * 8 + wave, NGW = G * 8;
    constexpr int I_IN = (D / 64) * (INW / 32), I_OUT = (D / 64) * (D / 32), I_W1 = (D / 64) * (2048 / 32), I_W2 = (FF / 64) * (D / 32);
    constexpr int I_IN8 = IN_GATE_F8 ? (D / 64) * (12 * 8) : 0;
    for (int it = gw; it < I_IN8; it += NGW) { const int kb = it / 96, q = it % 96, tl = q >> 3, n0 = 256 * (tl < 8 ? 8 + tl : 20 + tl) + 32 * (q & 7);
        transpose_item<true>(args.in[5], D, INW, (bf16*)(ws + WS_WIN8), scr, 64 * kb, n0, in_p2l(n0), lane); }
    constexpr int NITEMS = I_IN + I_OUT + (MOE_W_IN_QUEUE ? 0 : NE * I_W1 + NE * I_W2);
    for (int it = gw; it < NITEMS; it += NGW) {
        int rr = it;
        if (rr < I_IN) { const int nblk = INW / 32, kb = rr / nblk, nb = rr % nblk; transpose_item<FP8_IN != 0>(args.in[5], D, INW, (bf16*)(ws + WS_WIN), scr, 64 * kb, 32 * nb, in_p2l(32 * nb), lane); continue; } rr -= I_IN;
        if (rr < I_OUT) { const int nblk = D / 32, kb = rr / nblk, nb = rr % nblk; transpose_item<FP8_OUT != 0>(args.in[15], D, D, (bf16*)(ws + WS_WOUT), scr, 64 * kb, 32 * nb, 32 * nb, lane); continue; } rr -= I_OUT;
        if (rr < NE * I_W1) { const int e = rr / I_W1, q = rr % I_W1, nblk = 2048 / 32, kb = q / nblk, nb = q % nblk;
            transpose_item<FP8_MOE != 0>(args.in[19] + (size_t)e * D * 2048, D, 2048, (bf16*)(ws + WS_W1 + (size_t)e * 2048 * D * (FP8_MOE ? 1 : 2)), scr, 64 * kb, 32 * nb, w1_p2l(32 * nb), lane); continue; } rr -= NE * I_W1;
        { const int e = rr / I_W2, q = rr % I_W2, nblk = D / 32, kb = q / nblk, nb = q % nblk;
            transpose_item<FP8_MOE != 0>(args.in[21] + (size_t)e * FF * D, FF, D, (bf16*)(ws + WS_W2 + (size_t)e * D * FF * (FP8_MOE ? 1 : 2)), scr, 64 * kb, 32 * nb, 32 * nb, lane); }
    }
}

__device__ __forceinline__ void moe_w_item(const Args& args, unsigned char* ws, LAS float* scr, int rr, int lane) {
    constexpr int I_W1 = (D / 64) * (2048 / 32), I_W2 = (FF / 64) * (D / 32);
    if (rr < NE * I_W1) { const int e = rr / I_W1, q = rr % I_W1, nblk = 2048 / 32, kb = q / nblk, nb = q % nblk;
        transpose_item<FP8_MOE != 0>(args.in[19] + (size_t)e * D * 2048, D, 2048, (bf16*)(ws + WS_W1 + (size_t)e * 2048 * D * (FP8_MOE ? 1 : 2)), scr, 64 * kb, 32 * nb, w1_p2l(32 * nb), lane); return; }
    rr -= NE * I_W1;
    { const int e = rr / I_W2, q = rr % I_W2, nblk = D / 32, kb = q / nblk, nb = q % nblk;
        transpose_item<FP8_MOE != 0>(args.in[21] + (size_t)e * FF * D, FF, D, (bf16*)(ws + WS_W2 + (size_t)e * D * FF * (FP8_MOE ? 1 : 2)), scr, 64 * kb, 32 * nb, 32 * nb, lane); }
}

__device__ __forceinline__ void moe_w_pair(const Args& args, unsigned char* ws, LAS float* scr, int pr, int lane) {
    constexpr int I_W1 = (D / 64) * (2048 / 32), I_W2 = (FF / 64) * (D / 32);
    int rr = 2 * pr;
    if (rr < NE * I_W1) { const int e = rr / I_W1, q = rr % I_W1, nblk = 2048 / 32, kb = q / nblk, nb = q % nblk; const float* W = args.in[19] + (size_t)e * D * 2048; unsigned char* WT = ws + WS_W1 + (size_t)e * 2048 * D;
        transpose_pair_f8(W, W, D, 2048, WT, WT, scr, 64 * kb, 32 * nb, w1_p2l(32 * nb), 64 * kb, 32 * (nb + 1), w1_p2l(32 * (nb + 1)), lane); return; }
    rr -= NE * I_W1;
    { const int e = rr / I_W2, q = rr % I_W2, nblk = D / 32, kb = q / nblk, nb = q % nblk; const float* W = args.in[21] + (size_t)e * FF * D; unsigned char* WT = ws + WS_W2 + (size_t)e * D * FF;
        transpose_pair_f8(W, W, FF, D, WT, WT, scr, 64 * kb, 32 * nb, 32 * nb, 64 * kb, 32 * (nb + 1), 32 * (nb + 1), lane); }
}

__device__ __forceinline__ void modnorm_row(const float* __restrict__ xrow, const float* __restrict__ g, const float* __restrict__ sc, const float* __restrict__ sh, bf16* __restrict__ orow, int lane, f32x4 (&v)[4]) {
    float ss = 0.f;
#pragma unroll
    for (int i = 0; i < 4; ++i) { v[i] = *(const f32x4*)(xrow + 4 * lane + 256 * i); ss += (v[i][0] * v[i][0] + v[i][1] * v[i][1]) + (v[i][2] * v[i][2] + v[i][3] * v[i][3]); }
    const float rs = __builtin_amdgcn_rsqf(wsum(ss) * (1.f / D) + EPS);
#pragma unroll
    for (int i = 0; i < 4; ++i) { const int cc = 4 * lane + 256 * i; const f32x4 gg = *(const f32x4*)(g + cc), s1 = *(const f32x4*)(sc + cc), s0 = *(const f32x4*)(sh + cc);
        v[i] = v[i] * rs * gg * (s1 + 1.f) + s0;
        u32x2 o; o.x = pk2(v[i][0], v[i][1]); o.y = pk2(v[i][2], v[i][3]); *(u32x2*)(orow + cc) = o; }
}
template <bool TILE, bool F8, bool XBF = false>
__device__ __forceinline__ void modnorm4(const float* __restrict__ xr, const float* __restrict__ g, const float* __restrict__ sc, const float* __restrict__ sh, bf16* __restrict__ orow, LAS unsigned char* tile, int rtp, int lane, unsigned char* __restrict__ orow8 = nullptr) {
    f32x4 v[4][4];
#pragma unroll
    for (int j = 0; j < 4; ++j)
#pragma unroll
        for (int i = 0; i < 4; ++i) { if constexpr (XBF) { const u32x2 w = *(const u32x2*)((const bf16*)xr + (size_t)j * D + 4 * lane + 256 * i); v[j][i] = (f32x4){bflo(w.x), bfhi(w.x), bflo(w.y), bfhi(w.y)}; }
            else v[j][i] = *(const f32x4*)(xr + (size_t)j * D + 4 * lane + 256 * i); }
    f32x4 gg[4], s1[4], s0[4];
#pragma unroll
    for (int i = 0; i < 4; ++i) { const int cc = 4 * lane + 256 * i; gg[i] = *(const f32x4*)(g + cc); s1[i] = *(const f32x4*)(sc + cc) + 1.f; s0[i] = *(const f32x4*)(sh + cc); gg[i] = gg[i] * s1[i]; }
#pragma unroll
    for (int j = 0; j < 4; ++j) { float ss = 0.f;
#pragma unroll
        for (int i = 0; i < 4; ++i) ss += (v[j][i][0] * v[j][i][0] + v[j][i][1] * v[j][i][1]) + (v[j][i][2] * v[j][i][2] + v[j][i][3] * v[j][i][3]);
        const float rs = __builtin_amdgcn_rsqf(wsum(ss) * (1.f / D) + EPS);
#pragma unroll
        for (int i = 0; i < 4; ++i) { const int cc = 4 * lane + 256 * i; const f32x4 o = v[j][i] * rs * gg[i] + s0[i];
            u32x2 pk; pk.x = pk2(o[0], o[1]); pk.y = pk2(o[2], o[3]);
            if constexpr (F8) *(unsigned*)((unsigned char*)orow + (size_t)j * D + cc) = pk4_fp8(o[0], o[1], o[2], o[3], (float)(1 << A_SH));
            else *(u32x2*)(orow + (size_t)j * D + cc) = pk;
            if (orow8) *(unsigned*)(orow8 + (size_t)j * D + cc) = pk4_fp8(o[0], o[1], o[2], o[3], (float)(1 << A_SH));
            if constexpr (TILE) *(LAS u32x2*)(tile + j * rtp + cc * 2) = pk; } }
}
__device__ __forceinline__ void phase_h1(const Args& args, unsigned char* ws, int vcu, int G) {
    const int lane = threadIdx.x & 63, wave = __builtin_amdgcn_readfirstlane(threadIdx.x >> 6); const float* mod = (const float*)(ws + WS_MOD); bf16* hb = (bf16*)(ws + WS_H);
    for (int t = (vcu * 8 + wave) * 4; t < T; t += G * 32) { const int b = t / S;
        modnorm4<false, FP8_IN != 0>(args.in[0] + (size_t)t * D, args.in[4], mod + b * 6144 + 1024, mod + b * 6144, (bf16*)((unsigned char*)hb + (size_t)t * D * (FP8_IN ? 1 : 2)), nullptr, 0, lane, IN_GATE_F8 ? ws + WS_H8 + (size_t)t * D : nullptr); }
}

__device__ __forceinline__ void phase_merge(const Args& args, unsigned char* ws, int vcu, int G) {
    const int lane = threadIdx.x & 63, wave = __builtin_amdgcn_readfirstlane(threadIdx.x >> 6);
    const bf16* proj = (const bf16*)(ws + WS_PROJ); const bf16* yret = (const bf16*)(ws + WS_YRET); const bf16* odiff = (const bf16*)(ws + WS_ODIFF); bf16* merged = (bf16*)(ws + WS_MRG);
    const float* ggn = args.in[6]; const float* bgn = args.in[7];
    f32x4 gg[4], bb[4];
#pragma unroll
    for (int i = 0; i < 4; ++i) { gg[i] = *(const f32x4*)(ggn + 4 * lane + 256 * i); bb[i] = *(const f32x4*)(bgn + 4 * lane + 256 * i); }
    constexpr int TB = 2;
    for (int t = (vcu * 8 + wave) * TB; t < T; t += G * 8 * TB) {
        u32x2 yy[TB][4], rg[TB][4], md[TB][4], od[TB][4];
#pragma unroll
        for (int j = 0; j < TB; ++j) { const bf16* prg = proj + PO_RG + (size_t)(t + j) * 1024; const bf16* pmg = proj + PO_MG + (size_t)(t + j) * 1024;
#pragma unroll
            for (int i = 0; i < 4; ++i) { const int cc = 4 * lane + 256 * i;
                yy[j][i] = *(const u32x2*)(yret + (size_t)(t + j) * D + cc); od[j][i] = *(const u32x2*)(odiff + (size_t)(t + j) * D + cc);
                rg[j][i] = *(const u32x2*)(prg + cc); md[j][i] = *(const u32x2*)(pmg + (size_t)T * 1024 + cc); } }
#pragma unroll
        for (int j = 0; j < TB; ++j)
#pragma unroll
            for (int i = 0; i < 4; ++i) { const int cc = 4 * lane + 256 * i;
                float y[4] = {bflo(yy[j][i].x), bfhi(yy[j][i].x), bflo(yy[j][i].y), bfhi(yy[j][i].y)};
                const float mu = wsum((y[0] + y[1]) + (y[2] + y[3])) * (1.f / 256);
                float vv = 0.f;
#pragma unroll
                for (int e = 0; e < 4; ++e) { y[e] -= mu; vv += y[e] * y[e]; }
                const float rs = __builtin_amdgcn_rsqf(wsum(vv) * (1.f / 256) + EPS);
                const float rgv[4] = {bflo(rg[j][i].x), bfhi(rg[j][i].x), bflo(rg[j][i].y), bfhi(rg[j][i].y)};
                const float mdv[4] = {bflo(md[j][i].x), bfhi(md[j][i].x), bflo(md[j][i].y), bfhi(md[j][i].y)}, odv[4] = {bflo(od[j][i].x), bfhi(od[j][i].x), bflo(od[j][i].y), bfhi(od[j][i].y)};
                float m[4];
#pragma unroll
                for (int e = 0; e < 4; ++e) m[e] = rgv[e] * (y[e] * rs * gg[i][e] + bb[i][e]) + mdv[e] * odv[e];
                if (FP8_OUT) *(unsigned*)((unsigned char*)merged + (size_t)(t + j) * D + cc) = pk4_fp8(m[0], m[1], m[2], m[3], (float)(1 << A_SH));
                else { u32x2 o; o.x = pk2(m[0], m[1]); o.y = pk2(m[2], m[3]); *(u32x2*)(merged + (size_t)(t + j) * D + cc) = o; } }
    }
}

constexpr int RT_PITCH = 2064;
constexpr int RT_H = 0, RT_P = 32 * RT_PITCH, RT_L = RT_P + 8 * 32 * 32 * 4, RT_CNT = RT_L + 128 * 33 * 4, RT_SEL = RT_CNT + 128;
static_assert(RT_SEL + 2048 <= LDS_STAGE_BYTES, "route LDS map");
__device__ __forceinline__ void phase_route(const Args& args, unsigned char* ws, LAS unsigned char* lds, int vcu, int G) {
    const int tid = threadIdx.x, lane = tid & 63, r = lane & 31, hi = lane >> 5, wave = __builtin_amdgcn_readfirstlane(tid >> 6);
    const float* mod = (const float*)(ws + WS_MOD); bf16* h2 = (bf16*)(ws + WS_H); unsigned* ctl = (unsigned*)(ws + WS_CTL);
    int* tok_e = (int*)(ws + WS_ROUTE); int* tok_pos = tok_e + T * 4; float* tok_w = (float*)(tok_pos + T * 4); int* list = (int*)(ws + WS_LIST);
    const bf16* wrt = (const bf16*)(ws + WS_WRT); const float* br = args.in[18];
    LAS unsigned* lcnt = (LAS unsigned*)(lds + RT_CNT); LAS unsigned* lsel = (LAS unsigned*)(lds + RT_SEL); LAS float* P = (LAS float*)(lds + RT_P); LAS float* L = (LAS float*)(lds + RT_L);
    bf16x8 bh[8], bl[8];
#pragma unroll
    for (int ks = 0; ks < 8; ++ks) { bh[ks] = *(const bf16x8*)(wrt + (size_t)r * D + 128 * wave + 16 * ks + 8 * hi); bl[ks] = *(const bf16x8*)(wrt + (size_t)(NE + r) * D + 128 * wave + 16 * ks + 8 * hi); }
    for (int t0 = vcu * 128; t0 < T; t0 += G * 128) {
        const int b = t0 / S;
        if (tid < NE) lcnt[tid] = 0u;
        const bf16* x1b = (const bf16*)(ws + WS_X1B); const float* sc2 = mod + b * 6144 + 4096; const float* sh2 = mod + b * 6144 + 3072;
        f32x4 gg[4], s0[4];
#pragma unroll
        for (int i = 0; i < 4; ++i) { const int cc = 4 * lane + 256 * i; gg[i] = *(const f32x4*)(args.in[16] + cc) * (*(const f32x4*)(sc2 + cc) + 1.f); s0[i] = *(const f32x4*)(sh2 + cc); }
        u32x2 xr[4][4];
#define RT_LOADX(sbi_) do { const size_t tr_ = (size_t)(t0 + 32 * (sbi_) + 4 * wave); _Pragma("unroll") for (int j = 0; j < 4; ++j) _Pragma("unroll") for (int i = 0; i < 4; ++i) \
            xr[j][i] = *(const u32x2*)(x1b + (tr_ + j) * D + 4 * lane + 256 * i); } while (0)
        RT_LOADX(0);
        for (int sbi = 0; sbi < 4; ++sbi) {
            { const int tl = 4 * wave; const size_t tr = (size_t)(t0 + 32 * sbi + tl);
#pragma unroll
                for (int j = 0; j < 4; ++j) { f32x4 v[4]; float ss = 0.f;
#pragma unroll
                    for (int i = 0; i < 4; ++i) { v[i] = (f32x4){bflo(xr[j][i].x), bfhi(xr[j][i].x), bflo(xr[j][i].y), bfhi(xr[j][i].y)};
                        ss += (v[i][0] * v[i][0] + v[i][1] * v[i][1]) + (v[i][2] * v[i][2] + v[i][3] * v[i][3]); }
                    const float rs = __builtin_amdgcn_rsqf(wsum(ss) * (1.f / D) + EPS);
#pragma unroll
                    for (int i = 0; i < 4; ++i) { const int cc = 4 * lane + 256 * i; const f32x4 o = v[i] * rs * gg[i] + s0[i];
                        u32x2 pk; pk.x = pk2(o[0], o[1]); pk.y = pk2(o[2], o[3]);
                        if (FP8_MOE) *(unsigned*)((unsigned char*)h2 + (tr + j) * D + cc) = pk4_fp8(o[0], o[1], o[2], o[3], (float)(1 << A_SH));
                        else *(u32x2*)(h2 + (tr + j) * D + cc) = pk;
                        *(LAS u32x2*)(lds + RT_H + (tl + j) * RT_PITCH + cc * 2) = pk; } } }
            if (sbi < 3) RT_LOADX(sbi + 1);
            __syncthreads();
            { f32x16 acc;
#pragma unroll
                for (int q = 0; q < 16; ++q) acc[q] = 0.f;
#pragma unroll
                for (int ks = 0; ks < 8; ++ks) { const bf16x8 a = *(const LAS bf16x8*)(lds + RT_H + r * RT_PITCH + (128 * wave + 16 * ks + 8 * hi) * 2);
                    acc = __builtin_amdgcn_mfma_f32_32x32x16_bf16(a, bh[ks], acc, 0, 0, 0); acc = __builtin_amdgcn_mfma_f32_32x32x16_bf16(a, bl[ks], acc, 0, 0, 0); }
#pragma unroll
                for (int q = 0; q < 16; ++q) P[(wave * 32 + crow(q, hi)) * 32 + r] = acc[q]; }
            __syncthreads();
#pragma unroll
            for (int u = 0; u < 2; ++u) { const int idx = tid + 512 * u, tk = idx >> 5, e = idx & 31; float s = br[e];
#pragma unroll
                for (int w = 0; w < 8; ++w) s += P[(w * 32 + tk) * 32 + e];
                L[(32 * sbi + tk) * 33 + e] = s; }
        }
#undef RT_LOADX
        __syncthreads();
        if (tid < 128) { const int t = t0 + tid;
            float lg[NE];
#pragma unroll
            for (int e = 0; e < NE; ++e) lg[e] = L[tid * 33 + e];
            unsigned used = 0u; float tv0 = 0.f, den = 0.f; float wv[TOPK]; int ev[TOPK];
#pragma unroll
            for (int k = 0; k < TOPK; ++k) { float best = -INFINITY; int bi = 0;
#pragma unroll
                for (int e = 0; e < NE; ++e) { const bool ok = !((used >> e) & 1u) && lg[e] > best; best = ok ? lg[e] : best; bi = ok ? e : bi; }
                used |= 1u << bi; if (k == 0) tv0 = best; wv[k] = __expf(best - tv0); den += wv[k]; ev[k] = bi; }
            const float rden = 1.f / den;
#pragma unroll
            for (int k = 0; k < TOPK; ++k) { const unsigned lp = atomicAdd((unsigned*)&lcnt[ev[k]], 1u);
                lsel[tid * 4 + k] = ((unsigned)ev[k] << 16) | lp; tok_e[t * 4 + k] = ev[k]; tok_w[t * 4 + k] = wv[k] * rden; } }
        __syncthreads();
        if (tid < NE) { const unsigned n = lcnt[tid]; lcnt[tid] = n ? atomicAdd(&ctl[CW_CNT + tid], n) : 0u; }
        __syncthreads();
        { const unsigned s = lsel[tid]; const int e = (int)(s >> 16); const int pos = (int)(lcnt[e] + (s & 0xffffu)); const int t = t0 + (tid >> 2);
            tok_pos[t * 4 + (tid & 3)] = pos; list[(size_t)e * T + pos] = t; }
        __syncthreads();
    }
}

__device__ __forceinline__ void phase_scan(unsigned char* ws, int vcu, int G) {
    const bf16* ubuf = (const bf16*)(ws + WS_H); bf16* rbbuf = (bf16*)(ws + WS_MERGED);
    for (int task = vcu * 512 + (int)threadIdx.x; task < 32 * 4096; task += G * 512) {
        const int bh = task >> 12, e8 = task & 4095, h = bh & 3;
        const float lg = __builtin_amdgcn_logf(1.f - __builtin_amdgcn_exp2f(-5.f - (float)h));
        const float gam = __builtin_amdgcn_exp2f(lg), gC = __builtin_amdgcn_exp2f(lg * 128.f), gC1 = __builtin_amdgcn_exp2f(lg * 127.f);
        const bf16* up = ubuf + (size_t)bh * 32 * 32768 + e8 * 8; bf16* rp = rbbuf + (size_t)bh * 32 * 32768 + e8 * 8;
        float R[8];
#pragma unroll
        for (int i = 0; i < 8; ++i) R[i] = 0.f;
        for (int j0 = 0; j0 < 32; j0 += 8) {
            u32x4 uv[8];
#pragma unroll
            for (int jj = 0; jj < 8; ++jj) uv[jj] = *(const u32x4*)(up + (size_t)(j0 + jj) * 32768);
#pragma unroll
            for (int jj = 0; jj < 8; ++jj) {
                u32x4 o; o.x = pk2(R[0] * gam, R[1] * gam); o.y = pk2(R[2] * gam, R[3] * gam); o.z = pk2(R[4] * gam, R[5] * gam); o.w = pk2(R[6] * gam, R[7] * gam);
                *(u32x4*)(rp + (size_t)(j0 + jj) * 32768) = o;
#pragma unroll
                for (int q = 0; q < 4; ++q) { R[2 * q] = gC * R[2 * q] + gC1 * bflo(uv[jj][q]); R[2 * q + 1] = gC * R[2 * q + 1] + gC1 * bfhi(uv[jj][q]); } }
        }
    }
}

__device__ __forceinline__ int build_expert_tables(const unsigned* ctl, LAS unsigned* rbtab, LAS unsigned* rbfirst) {
    if (threadIdx.x == 0) { unsigned rb = 0;
        for (int e = 0; e < NE; ++e) { const unsigned c = __hip_atomic_load(&ctl[CW_CNT + e], __ATOMIC_RELAXED, __HIP_MEMORY_SCOPE_AGENT), nb = (c + 255u) >> 8; rbfirst[e] = rb; for (unsigned i = 0; i < nb; ++i) rbtab[rb + i] = (unsigned)e; rb += nb; }
        rbfirst[NE] = rb; }
    __syncthreads();
    return __builtin_amdgcn_readfirstlane((int)rbfirst[NE]);
}

__device__ __forceinline__ void phase_combine(const Args& args, unsigned char* ws, const LAS unsigned* rbfirst, int vcu, int G) {
    const int lane = threadIdx.x & 63, wave = __builtin_amdgcn_readfirstlane(threadIdx.x >> 6);
    const float* mod = (const float*)(ws + WS_MOD); const unsigned char* eo = ws + WS_EO; const bf16* x1b = (const bf16*)(ws + WS_X1B);
    const int* tok_e = (const int*)(ws + WS_ROUTE); const int* tok_pos = tok_e + T * 4; const float* tok_w = (const float*)(tok_pos + T * 4);
    constexpr int TB = 2; constexpr float ESC = 1.f / (float)(1 << E_SH);
    typedef float f32x2_t __attribute__((ext_vector_type(2)));
    for (int t = (vcu * 8 + wave) * TB; t < T; t += G * 8 * TB) { const int b = t / S;
        const unsigned char* rp[TB][TOPK]; float w[TB][TOPK];
#pragma unroll
        for (int j = 0; j < TB; ++j)
#pragma unroll
            for (int k = 0; k < TOPK; ++k) { const int e = tok_e[(t + j) * 4 + k]; rp[j][k] = eo + ((size_t)rbfirst[e] * 256 + tok_pos[(t + j) * 4 + k]) * D; w[j][k] = tok_w[(t + j) * 4 + k] * ESC; }
        unsigned ev[TB][TOPK][4]; u32x2 xv[TB][4];
#pragma unroll
        for (int j = 0; j < TB; ++j)
#pragma unroll
            for (int i = 0; i < 4; ++i) { const int cc = 4 * lane + 256 * i; xv[j][i] = *(const u32x2*)(x1b + (size_t)(t + j) * D + cc);
#pragma unroll
                for (int k = 0; k < TOPK; ++k) ev[j][k][i] = *(const unsigned*)(rp[j][k] + cc); }
#pragma unroll
        for (int i = 0; i < 4; ++i) { const int cc = 4 * lane + 256 * i; const f32x4 gt = *(const f32x4*)(mod + b * 6144 + 5120 + cc);
#pragma unroll
            for (int j = 0; j < TB; ++j) { f32x4 y = {0.f, 0.f, 0.f, 0.f};
#pragma unroll
                for (int k = 0; k < TOPK; ++k) { const f32x2_t lo = __builtin_amdgcn_cvt_pk_f32_fp8((int)ev[j][k][i], false), hi2 = __builtin_amdgcn_cvt_pk_f32_fp8((int)ev[j][k][i], true);
                    y[0] += w[j][k] * lo[0]; y[1] += w[j][k] * lo[1]; y[2] += w[j][k] * hi2[0]; y[3] += w[j][k] * hi2[1]; }
                const f32x4 x1 = (f32x4){bflo(xv[j][i].x), bfhi(xv[j][i].x), bflo(xv[j][i].y), bfhi(xv[j][i].y)};
                *(f32x4*)(args.out + (size_t)(t + j) * D + cc) = x1 + gt * y; } }
    }
}

enum Phase { PH_PRO = 0, PH_H1 = 1, PH_INPROJ = 2, PH_MIX = 3, PH_MERGE = 4, PH_OUTPROJ = 5, PH_ROUTE = 6, PH_MOE1 = 7, PH_MOE2 = 8, PH_COMB = 9, PH_END = 10 };
constexpr int CW_BAR = 4096;
__global__ void __launch_bounds__(512, 2) mk_fwd(Args args) {
    extern __shared__ __attribute__((aligned(16))) unsigned char lds_raw[];
    LAS unsigned char* lds = (LAS unsigned char*)lds_raw;
    volatile LAS unsigned* MISC = (volatile LAS unsigned*)(lds + LDS_MISC);
    const int tid = threadIdx.x, G = gridDim.x;
    const int vcu = (G % 8 == 0) ? ((int)blockIdx.x % 8) * (G / 8) + (int)blockIdx.x / 8 : (int)blockIdx.x;
    unsigned char* ws = args.ws; unsigned* ctl = (unsigned*)(ws + WS_CTL);
    const float* mod = (const float*)(ws + WS_MOD);
    bf16* hb = (bf16*)(ws + WS_H); bf16* proj = (bf16*)(ws + WS_PROJ); bf16* merged = (bf16*)(ws + WS_MRG);
    bf16* win_t = (bf16*)(ws + WS_WIN); bf16* wout_t = (bf16*)(ws + WS_WOUT); bf16* w1t = (bf16*)(ws + WS_W1); bf16* w2t = (bf16*)(ws + WS_W2);
    bf16* act = (bf16*)(ws + WS_ACT); bf16* eo = (bf16*)(ws + WS_EO); const int* list = (const int*)(ws + WS_LIST);
    for (int u = tid; u < 64; u += 512) MISC[u] = 0u;
    __syncthreads();
    const int lo = args.ph_lo, hi = args.ph_hi;
    XcdBarrier bar = xcd_barrier_post(ctl + CW_BAR, MISC + 8);
#define IN(k) (lo <= (k) && (k) < hi)
#define SEAM(k) do { if (IN(k) && IN((k) + 1)) xcd_barrier(bar); } while (0)
    LAS unsigned* gtab = (LAS unsigned*)(lds + LDS_GTAB); LAS unsigned* rbtab = (LAS unsigned*)(lds + LDS_RB2E); LAS float* gqk = (LAS float*)(lds + LDS_GQK); LAS unsigned* rbfirst = (LAS unsigned*)(lds + LDS_RBF);

    if (IN(PH_PRO)) { phase_prologue(args, ws, lds, vcu, G); __syncthreads(); }
    SEAM(PH_PRO);
    if (IN(PH_H1)) phase_h1(args, ws, vcu, G);
    SEAM(PH_H1);
    if (IN(PH_INPROJ)) {
        if (tid < 64) gqk[tid] = args.in[8][tid] * C2; else if (tid < 128) gqk[tid] = args.in[9][tid - 64];
        __syncthreads();
        EpiIn E{proj, gqk};
        if (IN_GATE_F8) {
            struct MapOrder { pg8::StaticOrder s; int split, add0, add1;
                __device__ bool next(int i, pg8::GUnit& u) const { const bool r = s.next(i, u); u.pn += u.pn < split ? add0 : add1; return r; } };
            MapOrder Sa; Sa.s.init(T / 256, 20, G, (int)blockIdx.x, nullptr, nullptr); Sa.split = 8; Sa.add0 = 0; Sa.add1 = 8;
            pg8::gemm_phase<EpiIn, MapOrder, false, false>(lds + LDS_STAGE, hb, win_t, 0, D, Sa, E, nullptr, gtab, 127 - A_SH, 127 - W_SH);
            MapOrder Sb; Sb.s.init(T / 256, 12, G, (int)blockIdx.x, nullptr, nullptr); Sb.split = 8; Sb.add0 = 8; Sb.add1 = 20;
            pg8::gemm_phase<EpiIn, MapOrder, false, true>(lds + LDS_STAGE, ws + WS_H8, ws + WS_WIN8, 0, D, Sb, E, nullptr, gtab, 127 - A_SH, 127 - W_SH);
        } else {
        pg8::StaticOrder So; So.init(T / 256, INW / 256, G, (int)blockIdx.x, nullptr, nullptr);
        pg8::gemm_phase<EpiIn, pg8::StaticOrder, false, FP8_IN != 0>(lds + LDS_STAGE, hb, win_t, 0, D, So, E, nullptr, gtab, 127 - A_SH, 127 - W_SH);
        }
    }
    SEAM(PH_INPROJ);
    if (IN(PH_MIX)) {
        float a1 = 0.f, a2 = 0.f, gm = 0.f;
        for (int d = 0; d < 64; ++d) { a1 += args.in[10][d] * args.in[11][d]; a2 += args.in[12][d] * args.in[13][d]; gm = fmaxf(gm, fabsf(args.in[8][d] * args.in[9][d])); }
        const float lam = __expf(a1) - __expf(a2) + LAMBDA_INIT;
        bf16* odiff = (bf16*)(ws + WS_ODIFF);
        const float w2 = 2.f * 8.f * gm * LOG2E * 1.03f + 32.f;
        LAS unsigned* cost = (LAS unsigned*)(lds + LDS_RB2E); LAS unsigned* order = cost + 256;
        if (tid >= 256 && tid < 384) ((LAS float*)(lds + att::LDS_GSUB))[tid - 256] = args.in[14][tid - 256];
        if (tid < 256) { const int h = tid >> 5, qb = tid & 31; const float slope2 = __builtin_amdgcn_exp2f(-(float)(h + 1)) * LOG2E;
            const float x = (float)(128 * qb - 63) - w2 / slope2; const int t_lo = x <= 0.f ? 0 : (int)ceilf(x * (1.f / 64.f));
            cost[tid] = (unsigned)(2 * qb + 2 - t_lo) | ((unsigned)t_lo << 16); }
        __syncthreads();
        if (tid < 256) { const unsigned mine = cost[tid] & 0xffffu; int rank = 0;
            for (int k = 0; k < 256; ++k) { const unsigned ck = cost[k] & 0xffffu; rank += (ck > mine || (ck == mine && k < tid)) ? 1 : 0; }
            order[rank] = (unsigned)tid | (cost[tid] & 0xffff0000u); }
        __syncthreads();
        static_assert(MOE_W_IN_QUEUE == 1, "the mixer queue carries the expert-weight items");
        constexpr unsigned NR1 = 1024u, NITEMS = NR1 + 2048u;
#ifndef MIX_REPS
#define MIX_REPS 1
#endif
        for (int rep = 0; rep < MIX_REPS; ++rep) {
        if (rep) xcd_barrier(bar);
        unsigned* qhead = &ctl[CW_Q + 64 * rep];
        unsigned n1 = 0u, n2 = 0u; bool prev_att = false; bf16x8 qn0 = {}, qn1 = {}, qn2 = {}, qn3 = {};
        if (tid == 0) { n1 = atomicAdd(qhead, 1u); n2 = atomicAdd(qhead, 1u); }
        for (;;) {
            if (tid == 0) { MISC[16] = n1; MISC[17] = n2; }
            __syncthreads();
            const unsigned item = MISC[16], nitem = MISC[17];
            if (item >= NITEMS) break;
            if (tid == 0) { n1 = n2; n2 = atomicAdd(qhead, 1u); }
            if (item < NR1) { ret::r1_unit((int)(item >> 7), (int)((item >> 5) & 3u), (int)(item & 31u), proj, (bf16*)(ws + WS_H), lds); prev_att = false; qn0 = (bf16x8){}; qn1 = (bf16x8){}; qn2 = (bf16x8){}; qn3 = (bf16x8){}; }
            else { const unsigned u = item - NR1, c0 = 3u * (u >> 1) + (u & 1u), nc = 1u + (u & 1u);
                for (unsigned k = 0; k < nc; ++k) moe_w_pair(args, ws, (LAS float*)(lds + (tid >> 6) * 12288), (int)((c0 + k) * 8u + (unsigned)(tid >> 6)), tid & 63);
                __syncthreads();
                const unsigned oc = order[u >> 3]; const int cls = (int)(oc & 0xffffu);
                const bool nvalid = nitem >= NR1 && nitem < NITEMS; const unsigned nu = nvalid ? nitem - NR1 : 0u; const int ncls = (int)(order[nu >> 3] & 0xffffu);
                att::unit((int)(u & 7u), cls >> 5, cls & 31, (int)(oc >> 16), proj, odiff, lds, lam, args.in[14], prev_att, nvalid, (int)(nu & 7u), ncls >> 5, ncls & 31, qn0, qn1, qn2, qn3);
                prev_att = nvalid; }
        }
        __syncthreads();
        xcd_barrier(bar);
        phase_scan(ws, vcu, G);
        xcd_barrier(bar);
        if (FUSE_MERGE) {
            for (int u = vcu * 4; u < 1024; u += G * 4)
                for (int k = 0; k < 4; ++k) { const int id = u + k; ret::r3m_unit(id >> 7, (id >> 5) & 3, id & 31, proj, (const bf16*)(ws + WS_MERGED), odiff, (bf16*)(ws + WS_MRG), args.in[6], args.in[7], lds); }
        } else
        for (int u = vcu * 8; u < 2048; u += G * 8)
            for (int k = 0; k < 8; ++k) { const int id = u + k; ret::r3_unit(id >> 8, (id >> 6) & 3, (id >> 1) & 31, id & 1, proj, (const bf16*)(ws + WS_MERGED), (bf16*)(ws + WS_YRET), lds); }
        }
    }
    SEAM(PH_MIX);
    if (!FUSE_MERGE) { if (IN(PH_MERGE)) phase_merge(args, ws, vcu, G);
        SEAM(PH_MERGE); }
    if (IN(PH_OUTPROJ)) {
        pg8::StaticOrder So; So.init(T / 256, D / 256, G, (int)blockIdx.x, nullptr, nullptr);
        EpiOutF E{args.in[0], mod, (bf16*)(ws + WS_X1B)};
        pg8::gemm_phase<EpiOutF, pg8::StaticOrder, false, FP8_OUT != 0>(lds + LDS_STAGE, merged, wout_t, 0, D, So, E, nullptr, gtab, 127 - A_SH, 127 - W_SH);
    }
    SEAM(PH_OUTPROJ);
    if (IN(PH_ROUTE)) { phase_route(args, ws, lds, vcu, G); }
    SEAM(PH_ROUTE);
    if (IN(PH_MOE1)) {
        const int nrb = build_expert_tables(ctl, rbtab, rbfirst);
        pg8::StaticOrder So; So.init(nrb, 2048 / 256, G, (int)blockIdx.x, rbtab, rbfirst);
        LAS float* btab = (LAS float*)(lds + LDS_BTAB);
        EpiActF E{btab, act};
        pg8::gemm_phase<EpiActF, pg8::StaticOrder, true, FP8_MOE != 0, 1>(lds + LDS_STAGE, hb, w1t, (size_t)2048 * D * (FP8_MOE ? 1 : 2), D, So, E, list, gtab, 127 - A_SH, 127 - W_SH, args.in[20], btab);
    }
    SEAM(PH_MOE1);
    if (IN(PH_MOE2)) {
        const int nrb = build_expert_tables(ctl, rbtab, rbfirst);
        pg8::StaticOrder So; So.init(nrb, D / 256, G, (int)blockIdx.x, rbtab, rbfirst);
        LAS float* btab = (LAS float*)(lds + LDS_BTAB);
        EpiEOF E{btab, eo};
        pg8::gemm_phase<EpiEOF, pg8::StaticOrder, false, FP8_MOE != 0, 2, 1>(lds + LDS_STAGE, act, w2t, (size_t)D * FF * (FP8_MOE ? 1 : 2), FF, So, E, nullptr, gtab, 127 - A_SH, 127 - W_SH, args.in[22], btab);
    }
    SEAM(PH_MOE2);
    if (IN(PH_COMB)) { (void)build_expert_tables(ctl, rbtab, rbfirst); phase_combine(args, ws, rbfirst, vcu, G); }
#undef IN
#undef SEAM
}

static int g_grid = 0;
static void launch_phases(Args a, int lo, int hi, hipStream_t stream) {
    a.ph_lo = lo; a.ph_hi = hi;
    hipLaunchKernelGGL(mk_fwd, dim3(g_grid), dim3(512), LDS_BYTES, stream, a);
}
extern "C" void kernel_launch(void* const* d_in, const int* in_sizes, int n_in, void* d_out, int out_size, void* d_ws, size_t ws_size, hipStream_t stream) {
    if (n_in != 23 || ws_size < WS_END) { fprintf(stderr, "kernel_launch: unexpected inputs/workspace (%d, %zu)\n", n_in, ws_size); }
    unsigned char* ws = (unsigned char*)d_ws; float* out = (float*)d_out;

    if (g_grid == 0) {
        int dev = 0, cus = 0;
        if (hipGetDevice(&dev) != hipSuccess || hipDeviceGetAttribute(&cus, hipDeviceAttributeMultiprocessorCount, dev) != hipSuccess) { fprintf(stderr, "kernel_launch: device query failed\n"); g_grid = -1; return; }
        if (hipFuncSetAttribute((const void*)mk_fwd, hipFuncAttributeMaxDynamicSharedMemorySize, LDS_BYTES) != hipSuccess) { fprintf(stderr, "kernel_launch: hipFuncSetAttribute failed\n"); g_grid = -1; return; }
        g_grid = cus;
    }
    if (g_grid < 0) return;
    Args a{};
    for (int i = 0; i < 23; ++i) a.in[i] = (const float*)d_in[i];
    a.out = out; a.ws = ws;
    (void)hipMemsetAsync(ws, 0, 8 * MiB, stream);
    launch_phases(a, 0, PH_END, stream);
}
```

```cpp
#include <hip/hip_runtime.h>
#include <cstdio>
#include <cstdint>

typedef unsigned short bf16;
typedef short bf16x8 __attribute__((ext_vector_type(8)));
typedef float f32x4 __attribute__((ext_vector_type(4)));
typedef float f32x16 __attribute__((ext_vector_type(16)));
typedef unsigned u32x4 __attribute__((ext_vector_type(4)));
typedef unsigned u32x2 __attribute__((ext_vector_type(2)));

constexpr int NB = 8, S = 4096, T = NB * S, D = 1024, INW = 8192;
constexpr int NE = 32, TOPK = 4, FF = 1024;
constexpr size_t PO_RQ = 0, PO_RK = (size_t)T * 512, PO_RV = (size_t)T * 1024, PO_RG = (size_t)T * 2048, PO_DQ = (size_t)T * 3072, PO_DK = (size_t)T * 4096, PO_DV = (size_t)T * 5120, PO_MG = (size_t)T * 6144;
constexpr float EPS = 1e-6f;
constexpr float LOG2E = 1.4426950408889634f;
constexpr float C2 = 0.125f * LOG2E;
constexpr float LAMBDA_INIT = 0.2f;
#ifndef FP8_MOE
#define FP8_MOE 1
#endif
#ifndef FP8_IN
#define FP8_IN 0
#endif
#ifndef FP8_OUT
#define FP8_OUT 0
#endif
constexpr int W_SH = 5, A_SH = 2, E_SH = 3;
constexpr int NRB_MAX = 544;
constexpr int NR_MAX = NRB_MAX * 256;

constexpr size_t MiB = 1u << 20;
constexpr size_t WS_CTL = 0;
constexpr size_t WS_MOD = 1 * MiB;
constexpr size_t WS_WRT = 1 * MiB + 512 * 1024;
constexpr size_t WS_ROUTE = 2 * MiB;
constexpr size_t WS_LIST = 4 * MiB;
constexpr size_t WS_WIN = 8 * MiB;
constexpr size_t WS_WOUT = 24 * MiB;
constexpr size_t WS_W1 = 26 * MiB;
constexpr size_t WS_W2 = 154 * MiB;
constexpr size_t WS_H = 218 * MiB;
constexpr size_t WS_PROJ = 282 * MiB;
constexpr size_t WS_YRET = 794 * MiB;
constexpr size_t WS_ODIFF = 858 * MiB;
constexpr size_t WS_MERGED = 922 * MiB;
constexpr size_t WS_ACT = WS_PROJ;
constexpr size_t WS_EO = WS_PROJ + 272 * MiB;
#define IN_GATE_F8 1
#define MOE_W_IN_QUEUE 1
#define FUSE_MERGE 1
constexpr size_t WS_H8 = 858 * MiB;
constexpr size_t WS_WIN8 = 146 * MiB;
constexpr size_t WS_X1B = FUSE_MERGE ? 858 * MiB : 794 * MiB;
constexpr size_t WS_MRG = FUSE_MERGE ? 794 * MiB : 922 * MiB;
constexpr size_t WS_END = 986 * MiB;
constexpr int CW_CNT = 64;
constexpr int CW_ROWOFF = 128;
constexpr int CW_NRB = 192;
constexpr int CW_Q = 512;
constexpr int CW_RB2E = 256;

__device__ __forceinline__ float bf2f(bf16 v) { return __builtin_bit_cast(float, (unsigned)v << 16); }
__device__ __forceinline__ float rowsum16(float x) {
    x += __builtin_bit_cast(float, __builtin_amdgcn_update_dpp(0, __builtin_bit_cast(int, x), 0x128, 0xf, 0xf, false));
    x += __builtin_bit_cast(float, __builtin_amdgcn_update_dpp(0, __builtin_bit_cast(int, x), 0x124, 0xf, 0xf, false));
    x += __builtin_bit_cast(float, __builtin_amdgcn_update_dpp(0, __builtin_bit_cast(int, x), 0x122, 0xf, 0xf, false));
    x += __builtin_bit_cast(float, __builtin_amdgcn_update_dpp(0, __builtin_bit_cast(int, x), 0x121, 0xf, 0xf, false));
    return x; }
__device__ __forceinline__ bf16 f2bf(float f) { unsigned u = __builtin_bit_cast(unsigned, f); return (bf16)((u + 0x7fffu + ((u >> 16) & 1u)) >> 16); }
__host__ __device__ __forceinline__ int crow(int r, int hi) { return (r & 3) + 8 * (r >> 2) + 4 * hi; }
__device__ __forceinline__ float sigmoidf_(float x) { return 1.f / (1.f + __expf(-x)); }

__host__ __device__ __forceinline__ int tile_new2old(int t) { return t < 12 ? t : (t < 16 ? t + 12 : (t < 28 ? t - 4 : t)); }
__host__ __device__ __forceinline__ int in_p2l(int p) { const int tp = p >> 8, t = tile_new2old(tp), q = p & 255, bj = q >> 7, wc = (q >> 5) & 3, j = q & 31;
    if (tp >= 8 && tp < 16) return (bj ? 6144 : 2048) + (tp - 8) * 128 + (q & 127);
    return t * 256 + 64 * wc + 32 * bj + j; }
__host__ __device__ __forceinline__ int w1_p2l(int p) { const int t = p >> 8, q = p & 255, bj = q >> 7; return bj * 1024 + t * 128 + (q & 127); }

#define LAS __attribute__((address_space(3)))
#define GAS __attribute__((address_space(1)))
namespace pg8 {
constexpr int BM = 256, BK = 64, HALF = 128, HTB = HALF * BK * 2  , STAGE_BYTES = 8 * HTB, NXCD = 8, WGM = 8;

__host__ __device__ __forceinline__ int lds_byte(int r, int c) { const int st = (r >> 4) * 2 + (c >> 5), rr = r & 15, cc = c & 31, ob = rr * 64 + cc * 2; return st * 1024 + (ob ^ (((ob >> 9) & 1) << 5)); }
__host__ __device__ __forceinline__ void stage_rc(int b, int& R, int& C) { const int st = b / 1024, sb = b % 1024, swz = sb ^ (((sb >> 9) & 1) << 5); R = (st >> 1) * 16 + swz / 64; C = (st & 1) * 32 + (swz % 64) / 2; }
__host__ __device__ __forceinline__ int perm32(int rho) { const int n = rho >> 4, i = rho & 15; return 8 * (i >> 2) + 4 * n + (i & 3); }
struct GUnit { int pm, pn, e, g, s; };

struct StaticOrder {
    int nM, nN, nwg, G, c; const LAS unsigned* rb2e; const LAS unsigned* rbfirst;
    __device__ void init(int nM_, int nN_, int G_, int c_, const LAS unsigned* t, const LAS unsigned* f) { nM = nM_; nN = nN_; nwg = nM * nN; G = G_; c = c_; rb2e = t; rbfirst = f; }
    __device__ bool next(int i, GUnit& u) const {
        const long L = (long)i * G + c; if (L >= nwg) return false;
        int wgid = (int)L; { const int q = nwg / NXCD, r = nwg % NXCD, xcd = wgid % NXCD, off = wgid / NXCD; wgid = (xcd < r ? xcd * (q + 1) : r * (q + 1) + (xcd - r) * q) + off; }
        const int nig = WGM * nN, gid = wgid / nig, fm = gid * WGM, gsz = (nM - fm) < WGM ? (nM - fm) : WGM;
        u.pm = fm + ((wgid % nig) % gsz); u.pn = (wgid % nig) / gsz; u.e = rb2e ? __builtin_amdgcn_readfirstlane((int)rb2e[u.pm]) : 0; u.g = rb2e ? u.e * T + (u.pm - __builtin_amdgcn_readfirstlane((int)rbfirst[u.e])) * 256 : 0; return true;
    }
};

__device__ __forceinline__ unsigned cvt_pk_bf16(float lo, float hi) { unsigned r; asm volatile("v_cvt_pk_bf16_f32 %0, %1, %2" : "=v"(r) : "v"(lo), "v"(hi)); return r; }

template <class Epi, class Sched, bool GATHER, bool FP8 = false, int BIAS = 0, int BP = 0>
__device__ __forceinline__ void gemm_phase(LAS unsigned char* lds, const void* Aglob, const void* Bglob, const size_t bstride, const int K, const Sched& S, const Epi& E,
                                           const int* rowtok, LAS unsigned* gtab, const int sA = 127, const int sB = 127, const float* bias = nullptr, LAS float* btab = nullptr) {
    typedef int v4i_t __attribute__((ext_vector_type(4))); typedef int v8i_t __attribute__((ext_vector_type(8)));
    const int KB = FP8 ? K : 2 * K;
    const int tid = threadIdx.x, wid = __builtin_amdgcn_readfirstlane(tid >> 6), lane = tid & 63, wr = wid >> 2, wc = wid & 3, fr = lane & 15, fq = lane >> 4;
    const int nt = KB / 128;
    unsigned voffA[2], voffB[2];
#pragma unroll
    for (int i = 0; i < 2; ++i) { int R, C; stage_rc(tid * 16 + i * 8192, R, C);
        const int Rb = BP ? 64 * (R >> 5) + 16 * ((R >> 2) & 3) + 4 * ((R >> 4) & 1) + (R & 3) : (R & ~31) + perm32(R & 31);
        voffA[i] = (unsigned)(R * KB + C * 2); voffB[i] = (unsigned)(Rb * KB + C * 2); }
    constexpr unsigned kstep = 128u;
    const unsigned hstep = (unsigned)(HALF * KB);
    const unsigned hstepB = BP ? (unsigned)(8 * KB) : hstep;
    const unsigned tstep = 2u * hstep;
    const unsigned ldsw = (unsigned)wid * 1024u;
    const int aoff = lds_byte(wr * 64 + fr, fq * 8), boff = lds_byte(wc * 32 + fr, fq * 8);
#define PG8_SA(b, h) (((b) * 2 + (h)) * HTB)
#define PG8_SB(b, h) ((4 + (b) * 2 + (h)) * HTB)
#define PG8_STAGE(bufoff, gbase, voff) do { _Pragma("unroll") for (int _i = 0; _i < 2; ++_i) \
        __builtin_amdgcn_global_load_lds((const unsigned*)((const char*)(gbase) + (voff)[_i]), (LAS unsigned*)(lds + (bufoff) + ldsw + _i * 8192), 16, 0, 0); } while (0)
#define PG8_STAGE_A(b, h, kptr, VO) do { if constexpr (GATHER) { PG8_STAGE(PG8_SA(b, h), kptr, VO[h]); } else { PG8_STAGE(PG8_SA(b, h), (kptr) + (h) * hstep, voffA); } } while (0)
#define PG8_STAGE_A2(b, h, kptr) do { if constexpr (GATHER) { _Pragma("unroll") for (int _i = 0; _i < 2; ++_i) \
        __builtin_amdgcn_global_load_lds((const unsigned*)((const char*)(kptr) + (usen ? vN[h][_i] : vC[h][_i])), (LAS unsigned*)(lds + PG8_SA(b, h) + ldsw + _i * 8192), 16, 0, 0); } \
        else { PG8_STAGE(PG8_SA(b, h), (kptr) + (h) * hstep, voffA); } } while (0)
#define PG8_LD8(p_) __builtin_shufflevector(*(const LAS v4i_t*)(p_), *(const LAS v4i_t*)((p_) + 1024), 0, 1, 2, 3, 4, 5, 6, 7)
#define PG8_LDA(dst, b, h) do { if constexpr (FP8) { _Pragma("unroll") for (int m = 0; m < 4; ++m) dst##8[m] = PG8_LD8(lds + PG8_SA(b, h) + aoff + m * 2048); } \
        else { _Pragma("unroll") for (int m = 0; m < 4; ++m) _Pragma("unroll") for (int k = 0; k < 2; ++k) dst[m][k] = *(const LAS bf16x8*)(lds + PG8_SA(b, h) + aoff + m * 2048 + k * 1024); } } while (0)
#define PG8_LDB(dst, b, h) do { if constexpr (FP8) { _Pragma("unroll") for (int n = 0; n < 2; ++n) dst##8[n] = PG8_LD8(lds + PG8_SB(b, h) + boff + n * 2048); } \
        else { _Pragma("unroll") for (int n = 0; n < 2; ++n) _Pragma("unroll") for (int k = 0; k < 2; ++k) dst[n][k] = *(const LAS bf16x8*)(lds + PG8_SB(b, h) + boff + n * 2048 + k * 1024); } } while (0)
#define PG8_MMA(ai, bj, At, Bt) do { __builtin_amdgcn_s_setprio(1); \
        if constexpr (FP8) { _Pragma("unroll") for (int m = 0; m < 4; ++m) _Pragma("unroll") for (int n = 0; n < 2; ++n)   \
            asm volatile("v_mfma_scale_f32_16x16x128_f8f6f4 %0, %1, %2, %0, %3, %4 op_sel_hi:[0,0,0]" : "+v"(acc[ai][bj][m][n]) : "v"(Bt##8[n]), "v"(At##8[m]), "v"(sB), "v"(sA)); } \
        else { _Pragma("unroll") for (int m = 0; m < 4; ++m) _Pragma("unroll") for (int n = 0; n < 2; ++n) _Pragma("unroll") for (int k = 0; k < 2; ++k) \
            asm volatile("v_mfma_f32_16x16x32_bf16 %0, %1, %2, %0" : "+v"(acc[ai][bj][m][n]) : "v"(Bt[n][k]), "v"(At[m][k])); } \
        __builtin_amdgcn_s_setprio(0); } while (0)
#define PG8_MMA0(ai, bj, At, Bt) do { __builtin_amdgcn_s_setprio(1); \
        if constexpr (FP8) { _Pragma("unroll") for (int m = 0; m < 4; ++m) _Pragma("unroll") for (int n = 0; n < 2; ++n) \
            asm volatile("v_mfma_scale_f32_16x16x128_f8f6f4 %0, %1, %2, 0, %3, %4 op_sel_hi:[0,0,0]" : "=&v"(acc[ai][bj][m][n]) : "v"(Bt##8[n]), "v"(At##8[m]), "v"(sB), "v"(sA)); } \
        else { _Pragma("unroll") for (int m = 0; m < 4; ++m) _Pragma("unroll") for (int n = 0; n < 2; ++n) { \
            asm volatile("v_mfma_f32_16x16x32_bf16 %0, %1, %2, 0" : "=&v"(acc[ai][bj][m][n]) : "v"(Bt[n][0]), "v"(At[m][0])); \
            asm volatile("v_mfma_f32_16x16x32_bf16 %0, %1, %2, %0" : "+v"(acc[ai][bj][m][n]) : "v"(Bt[n][1]), "v"(At[m][1])); } } \
        __builtin_amdgcn_s_setprio(0); } while (0)
#define PG8_WAIT_V(n) asm volatile("s_waitcnt vmcnt(" #n ")" ::: "memory")
#define PG8_WAIT_L(n) asm volatile("s_waitcnt lgkmcnt(" #n ")" ::: "memory")
#define PG8_BAR __builtin_amdgcn_s_barrier()
#define PG8_SCHED __builtin_amdgcn_sched_barrier(0)
#define PG8_GTAB_DMA(g_, slot_) do { if (wid < 4) __builtin_amdgcn_global_load_lds((const unsigned*)(rowtok + (size_t)(g_) + tid), (LAS unsigned*)(gtab + (slot_) * 256 + wid * 64), 4, 0, 0); } while (0)
#define PG8_GOFF(dst, slot_) do { _Pragma("unroll") for (int _i = 0; _i < 2; ++_i) { int _R, _C; stage_rc(tid * 16 + _i * 8192, _R, _C); \
        _Pragma("unroll") for (int _h = 0; _h < 2; ++_h) dst[_h][_i] = gtab[(slot_) * 256 + _h * 128 + _R] * (unsigned)KB + (unsigned)(_C * 2); } } while (0)
#define PG8_BTAB_DMA(u_, slot_) do { if constexpr (BIAS != 0) { if (wid >= 4) { const int _i = tid - 256; \
        const float* _src = BIAS == 1 ? bias + (size_t)(u_).e * 2048 + (_i < 128 ? 128 * (u_).pn + _i : 1024 + 128 * (u_).pn + (_i - 128)) : bias + (size_t)(u_).e * 1024 + 256 * (u_).pn + _i; \
        __builtin_amdgcn_global_load_lds((const unsigned*)_src, (LAS unsigned*)(btab + (slot_) * 256 + (wid - 4) * 64), 4, 0, 0); } } } while (0)
    GUnit cur, nxt; int ui = 0;
    if (!S.next(0, cur)) return;
    cur.s = 0; PG8_BTAB_DMA(cur, 0);
    f32x4 acc[2][2][4][2];
    bf16x8 At[4][2], B0[2][2], B1[2][2]; v8i_t At8[4], B08[2], B18[2];
    unsigned vC[2][2], vN[2][2];
    if constexpr (GATHER) { PG8_GTAB_DMA(cur.g, 0); PG8_WAIT_V(0); PG8_BAR; PG8_GOFF(vC, 0); PG8_WAIT_L(0);
#pragma unroll
        for (int h = 0; h < 2; ++h)
#pragma unroll
            for (int i = 0; i < 2; ++i) vN[h][i] = vC[h][i]; }
    const char* cA = GATHER ? (const char*)Aglob : (const char*)Aglob + (size_t)cur.pm * tstep;
    const char* cB = (const char*)Bglob + (size_t)cur.e * bstride + (size_t)cur.pn * tstep;
    PG8_STAGE(PG8_SB(0, 0), cB, voffB); PG8_STAGE(PG8_SB(0, 1), cB + hstepB, voffB); PG8_STAGE_A(0, 0, cA, vC); PG8_STAGE_A(0, 1, cA, vC);
    if (wr == 1) PG8_BAR;
    PG8_WAIT_V(2); PG8_BAR;
    PG8_STAGE(PG8_SB(1, 0), cB + kstep, voffB); PG8_STAGE_A(1, 0, cA + kstep, vC); PG8_STAGE(PG8_SB(1, 1), cB + hstepB + kstep, voffB);
    PG8_WAIT_V(6); PG8_BAR;
    int sprev = 0;
    for (;;) {
        const bool has_next = S.next(ui + 1, nxt);
        if constexpr (GATHER) { if (has_next) PG8_GTAB_DMA(nxt.g, (ui + 1) & 1); }
        const char* nA = has_next ? (GATHER ? (const char*)Aglob : (const char*)Aglob + (size_t)nxt.pm * tstep) : cA;
        const char* nB = has_next ? (const char*)Bglob + (size_t)nxt.e * bstride + (size_t)nxt.pn * tstep : cB;
#define PG8_STEP(t, WV1, WV2, LASTOK, MM) do { \
            const bool last = (LASTOK) && ((t) == nt - 2); \
            const char* a1 = cA + (size_t)((t) + 1) * kstep; \
            const char* a2 = last ? nA : cA + (size_t)((t) + 2) * kstep; const char* b2 = last ? nB : cB + (size_t)((t) + 2) * kstep; \
            const char* a3 = a2 + kstep; const char* b3 = b2 + kstep; \
            if constexpr (GATHER) { if (last && has_next) { PG8_GOFF(vN, (ui + 1) & 1); } } \
            const bool usen = last && has_next; \
              \
            PG8_LDB(B0, 0, 0); PG8_LDB(B1, 0, 1); PG8_SCHED; PG8_LDA(At, 0, 0); PG8_STAGE_A(1, 1, a1, vC); \
            WV1; PG8_WAIT_L(0); PG8_BAR; MM(0, 0, At, B0); MM(0, 1, At, B1); PG8_BAR; PG8_SCHED; \
              \
            PG8_LDA(At, 0, 1); PG8_STAGE(PG8_SB(0, 0), b2, voffB); PG8_STAGE(PG8_SB(0, 1), b2 + hstepB, voffB); PG8_STAGE_A2(0, 0, a2); \
            WV2; PG8_WAIT_L(0); PG8_BAR; MM(1, 0, At, B0); MM(1, 1, At, B1); PG8_BAR; PG8_SCHED; \
              \
            PG8_LDB(B0, 1, 0); PG8_LDB(B1, 1, 1); PG8_SCHED; PG8_LDA(At, 1, 0); PG8_STAGE_A2(0, 1, a2); \
            PG8_WAIT_V(8); PG8_WAIT_L(0); PG8_BAR; PG8_MMA(0, 0, At, B0); PG8_MMA(0, 1, At, B1); PG8_BAR; PG8_SCHED; \
              \
            PG8_LDA(At, 1, 1); PG8_STAGE(PG8_SB(1, 0), b3, voffB); PG8_STAGE(PG8_SB(1, 1), b3 + hstepB, voffB); PG8_STAGE_A2(1, 0, a3); \
            PG8_WAIT_V(8); PG8_WAIT_L(0); PG8_BAR; PG8_MMA(1, 0, At, B0); PG8_MMA(1, 1, At, B1); PG8_BAR; PG8_SCHED; } while (0)
#define PG8_WAIT_VR() do { if (sprev >= 16) PG8_WAIT_V(24); else if (sprev >= 8) PG8_WAIT_V(16); else PG8_WAIT_V(8); } while (0)
        if constexpr (FP8) {
            PG8_STEP(0, PG8_WAIT_VR(), PG8_WAIT_VR(), false, PG8_MMA0);
            for (int t = 2; t < nt; t += 2) PG8_STEP(t, PG8_WAIT_V(8), PG8_WAIT_V(8), true, PG8_MMA);
        } else {
#define PG8_WAIT_VR2() do { if (sprev >= 8) PG8_WAIT_V(16); else PG8_WAIT_V(8); } while (0)
            PG8_STEP(0, PG8_WAIT_VR2(), PG8_WAIT_VR2(), false, PG8_MMA0);
            for (int t = 2; t < nt; t += 2) PG8_STEP(t, PG8_WAIT_V(8), PG8_WAIT_V(8), true, PG8_MMA);
        }
        if (wr == 0) PG8_BAR;
        asm volatile("s_nop 15\n\ts_nop 15\n\ts_nop 7" ::: "memory");
        E(acc, cur, wr, wc, fr, fq);
        sprev = Epi::nstores(cur);
        if (!has_next) break;
        cur = nxt; cA = nA; cB = nB; ++ui; cur.s = ui & 1;
        if constexpr (GATHER) {
#pragma unroll
            for (int h = 0; h < 2; ++h)
#pragma unroll
                for (int i = 0; i < 2; ++i) vC[h][i] = vN[h][i]; }
        if (wr == 1) PG8_BAR;
        PG8_BTAB_DMA(cur, ui & 1);
    }
    PG8_WAIT_V(0);
    PG8_BAR;
#undef PG8_SA
#undef PG8_SB
#undef PG8_STAGE
#undef PG8_STAGE_A
#undef PG8_STAGE_A2
#undef PG8_LDA
#undef PG8_LDB
#undef PG8_MMA
#undef PG8_MMA0
#undef PG8_LD8
#undef PG8_WAIT_V
#undef PG8_WAIT_VR
#undef PG8_STEP
#undef PG8_WAIT_L
#undef PG8_BAR
#undef PG8_SCHED
#undef PG8_GTAB_DMA
#undef PG8_BTAB_DMA
#undef PG8_GOFF
}
}

#define XB_TMO      128
#define XB_XCNT(j)  (256  + 64 * (j))
#define XB_XSUB(j)  (1280 + 64 * (j))
#define XB_XGEN(j)  (2304 + 64 * (j))
#define XB_TOP      3328
#define XB_TOPGEN   3392
#define XCD_BAR_WORDS 3456
#define XB_SPIN_CAP (1u << 24)

__device__ __forceinline__ unsigned xb_ld(unsigned* p)              { return __hip_atomic_load(p, __ATOMIC_RELAXED, __HIP_MEMORY_SCOPE_AGENT); }
__device__ __forceinline__ unsigned xb_add(unsigned* p, unsigned v) { return __hip_atomic_fetch_add(p, v, __ATOMIC_RELAXED, __HIP_MEMORY_SCOPE_AGENT); }
__device__ __forceinline__ unsigned xb_xcc_id() { return (unsigned)__builtin_amdgcn_s_getreg((3 << 11) | 20) & 0xFu; }
#define XB_SPIN(cond, bar) do { unsigned _sp = 0; while (cond) { __builtin_amdgcn_s_sleep(1); \
    if ((++_sp & 255u) == 0u) { if (xb_ld(&(bar)[XB_TMO])) break; if (_sp > XB_SPIN_CAP) { atomicAdd(&(bar)[XB_TMO], 1u); break; } } } } while (0)

struct XcdBarrier {
    unsigned* bar; unsigned x;
    volatile LAS unsigned* st;
};

__device__ __forceinline__ XcdBarrier xcd_barrier_post(unsigned* bar, volatile LAS unsigned* st) {
    XcdBarrier b; b.bar = bar; b.x = xb_xcc_id(); b.st = st;
    if (threadIdx.x == 0) (void)xb_add(&bar[XB_XCNT(b.x)], 1u);
    return b;
}
__device__ __forceinline__ void xcd_barrier_complete(unsigned* bar, unsigned x, unsigned& nloc, unsigned& nx) {
    const unsigned G = gridDim.x * gridDim.y * gridDim.z;
    unsigned sum, cnt, mine, sp = 0u;
    for (;;) {
        sum = 0u; cnt = 0u; mine = 0u;
#pragma unroll
        for (unsigned j = 0; j < 16; ++j) { const unsigned c = xb_ld(&bar[XB_XCNT(j)]); sum += c; cnt += (c > 0u) ? 1u : 0u; mine = (j == x) ? c : mine; }
        if (sum == G) break;
        __builtin_amdgcn_s_sleep(1);
        if ((++sp & 255u) == 0u) { if (xb_ld(&bar[XB_TMO])) break; if (sp > XB_SPIN_CAP) { atomicAdd(&bar[XB_TMO], 1u); break; } }
    }
    nloc = mine > 0u ? mine : 1u; nx = cnt > 0u ? cnt : 1u;
}

__device__ __forceinline__ void xcd_barrier(const XcdBarrier& b) {
    asm volatile("s_waitcnt vmcnt(0)" ::: "memory");
    __syncthreads();
    if (threadIdx.x == 0) {
        unsigned* bar = b.bar;
        __builtin_amdgcn_s_waitcnt(0);
        unsigned nloc = b.st[0], nx = b.st[1];
        if (nloc == 0u) { xcd_barrier_complete(bar, b.x, nloc, nx); b.st[0] = nloc; b.st[1] = nx; }
        const unsigned old = xb_add(&bar[XB_XSUB(b.x)], 1u);
        const unsigned gen = old / nloc;
        if (old + 1u == (gen + 1u) * nloc) {
            __builtin_amdgcn_fence(__ATOMIC_RELEASE, "agent");
            asm volatile("s_waitcnt vmcnt(0)" ::: "memory");
            const unsigned og = xb_add(&bar[XB_TOP], 1u);
            const unsigned tg = og / nx;
            if (og + 1u == (tg + 1u) * nx) xb_add(&bar[XB_TOPGEN], 1u);
            else XB_SPIN(xb_ld(&bar[XB_TOPGEN]) == tg, bar);
            __builtin_amdgcn_fence(__ATOMIC_ACQUIRE, "agent");
            xb_add(&bar[XB_XGEN(b.x)], 1u);
            asm volatile("s_waitcnt vmcnt(0)" ::: "memory");
        } else {
            XB_SPIN(xb_ld(&bar[XB_XGEN(b.x)]) == gen, bar);
            __builtin_amdgcn_fence(__ATOMIC_ACQUIRE, "agent");
            asm volatile("s_waitcnt vmcnt(0)" ::: "memory");
        }
    }
    __syncthreads();
}

__device__ __forceinline__ float fast_sigmoid(float x) { return __builtin_amdgcn_rcpf(1.f + __builtin_amdgcn_exp2f(-LOG2E * x)); }
__device__ __forceinline__ u32x4 pack8(const f32x4 a, const f32x4 b) { u32x4 w; w.x = pg8::cvt_pk_bf16(a[0], a[1]); w.y = pg8::cvt_pk_bf16(a[2], a[3]); w.z = pg8::cvt_pk_bf16(b[0], b[1]); w.w = pg8::cvt_pk_bf16(b[2], b[3]); return w; }

__device__ __forceinline__ unsigned pk4_fp8(float a, float b, float c, float d, float sc) {
    a = __builtin_amdgcn_fmed3f(a * sc, -448.f, 448.f); b = __builtin_amdgcn_fmed3f(b * sc, -448.f, 448.f); c = __builtin_amdgcn_fmed3f(c * sc, -448.f, 448.f); d = __builtin_amdgcn_fmed3f(d * sc, -448.f, 448.f);
    int v = __builtin_amdgcn_cvt_pk_fp8_f32(a, b, 0, false); v = __builtin_amdgcn_cvt_pk_fp8_f32(c, d, v, true); return (unsigned)v; }
__device__ __forceinline__ unsigned pk4_fp8_nc(float a, float b, float c, float d) {
    int v = __builtin_amdgcn_cvt_pk_fp8_f32(a, b, 0, false); v = __builtin_amdgcn_cvt_pk_fp8_f32(c, d, v, true); return (unsigned)v; }
struct EpiIn {
    bf16* proj; const LAS float* gqk;
    static __device__ __forceinline__ int nstores(const pg8::GUnit& u) { return (u.pn >= 8 && u.pn < 16) ? 8 : 16; }
    __device__ __forceinline__ void operator()(const f32x4 (&acc)[2][2][4][2], const pg8::GUnit& u, int wr, int wc, int fr, int fq) const {
        const int pn = tile_new2old(u.pn); const int bb = u.pm >> 4, s0 = (u.pm & 15) * 256 + wr * 64 + fr; const size_t t0 = (size_t)u.pm * 256 + wr * 64 + fr;
        bf16* base; size_t INWp;
        if (u.pn >= 8 && u.pn < 16) {
            bf16* gb = proj + PO_RG + t0 * 1024 + (u.pn - 8) * 128 + wc * 32 + fq * 8;
#pragma unroll
            for (int ai = 0; ai < 2; ++ai)
#pragma unroll
                for (int m = 0; m < 4; ++m) { f32x4 v[2];
#pragma unroll
                    for (int n = 0; n < 2; ++n) {
                        const f32x4 x = acc[ai][0][m][n], a = x * (-LOG2E), b = acc[ai][1][m][n] * (-LOG2E); f32x4 ex, ey, r;
#pragma unroll
                        for (int e = 0; e < 4; ++e) { ex[e] = __builtin_amdgcn_exp2f(a[e]); ey[e] = __builtin_amdgcn_exp2f(b[e]); }
                        const f32x4 d = (ex + 1.f) * (ey + 1.f);
#pragma unroll
                        for (int e = 0; e < 4; ++e) r[e] = __builtin_amdgcn_rcpf(d[e]);
                        v[n] = x * r; }
                    *(u32x4*)(gb + (size_t)(ai * 128 + m * 16) * 1024) = pack8(v[0], v[1]); }
            return;
        }
        if (pn < 4)       { const int h = 2 * (pn & 1) + (wc >> 1); base = proj + (pn < 2 ? PO_RQ : PO_RK) + ((size_t)(bb * 4 + h) * S + s0) * 128 + (wc & 1) * 64 + fq * 8; INWp = 128; }
        else if (pn < 8)  { base = proj + PO_RV + ((size_t)(bb * 4 + (pn - 4)) * S + s0) * 256 + wc * 64 + fq * 8; INWp = 256; }
        else if (pn < 12) { base = proj + PO_RG + t0 * 1024 + (pn - 8) * 256 + wc * 64 + fq * 8; INWp = 1024; }
        else if (pn < 24) { const int rg3 = (pn - 12) >> 2, h = 2 * ((pn - 12) & 3) + (wc >> 1); base = proj + (rg3 == 0 ? PO_DQ : (rg3 == 1 ? PO_DK : PO_DV)) + ((size_t)(bb * 8 + h) * S + s0) * 128 + (wc & 1) * 64 + fq * 8; INWp = 128; }
        else              { base = proj + PO_MG + (pn >= 28 ? (size_t)T * 1024 : 0) + t0 * 1024 + ((pn - 24) & 3) * 256 + wc * 64 + fq * 8; INWp = 1024; }
        if (pn < 8 || (pn >= 20 && pn < 24)) {
            float f[4];
#pragma unroll
            for (int m = 0; m < 4; ++m) f[m] = 1.f;
            if (pn < 4) { const int h = 2 * (pn & 1) + (wc >> 1); const float lg = __builtin_amdgcn_logf(1.f - __builtin_amdgcn_exp2f(-5.f - (float)h));
#pragma unroll
                for (int m = 0; m < 4; ++m) { const float pos = (float)(wr * 64 + m * 16 + fr); f[m] = pn < 2 ? __builtin_amdgcn_exp2f(lg * pos) : 0.08838834764831845f * __builtin_amdgcn_exp2f(-lg * pos); } }
#pragma unroll
            for (int ai = 0; ai < 2; ++ai)
#pragma unroll
                for (int m = 0; m < 4; ++m)
#pragma unroll
                    for (int bj = 0; bj < 2; ++bj) *(u32x4*)(base + (size_t)(ai * 128 + m * 16) * INWp + bj * 32) = pack8(acc[ai][bj][m][0] * f[m], acc[ai][bj][m][1] * f[m]);
        } else if (pn < 12 || pn >= 24) {
            const bool silu = pn < 12;
#pragma unroll
            for (int ai = 0; ai < 2; ++ai)
#pragma unroll
                for (int m = 0; m < 4; ++m)
#pragma unroll
                    for (int bj = 0; bj < 2; ++bj) { f32x4 v[2];
#pragma unroll
                        for (int n = 0; n < 2; ++n)
#pragma unroll
                            for (int e = 0; e < 4; ++e) { const float x = acc[ai][bj][m][n][e], s = fast_sigmoid(x); v[n][e] = silu ? x * s : s; }
                        *(u32x4*)(base + (size_t)(ai * 128 + m * 16) * INWp + bj * 32) = pack8(v[0], v[1]); }
        } else {
            const LAS float* g = gqk + (pn < 16 ? 0 : 64) + fq * 8;
            f32x4 gv[2][2];
#pragma unroll
            for (int bj = 0; bj < 2; ++bj)
#pragma unroll
                for (int n = 0; n < 2; ++n) gv[bj][n] = *(const LAS f32x4*)(g + bj * 32 + n * 4);
#pragma unroll
            for (int ai = 0; ai < 2; ++ai)
#pragma unroll
                for (int m = 0; m < 4; ++m) { float ss = 0.f;
#pragma unroll
                    for (int bj = 0; bj < 2; ++bj)
#pragma unroll
                        for (int n = 0; n < 2; ++n) { const f32x4 x = acc[ai][bj][m][n]; ss += (x[0] * x[0] + x[1] * x[1]) + (x[2] * x[2] + x[3] * x[3]); }
                    ss += __shfl_xor(ss, 16); ss += __shfl_xor(ss, 32);
                    const float r = __builtin_amdgcn_rsqf(ss * (1.f / 64) + EPS);
#pragma unroll
                    for (int bj = 0; bj < 2; ++bj) *(u32x4*)(base + (size_t)(ai * 128 + m * 16) * INWp + bj * 32) = pack8(acc[ai][bj][m][0] * gv[bj][0] * r, acc[ai][bj][m][1] * gv[bj][1] * r); }
        }
    }
};
struct EpiOutF {
    const float* x; const float* mod; bf16* x1b;
    static __device__ __forceinline__ int nstores(const pg8::GUnit&) { return 16; }
    __device__ __forceinline__ void operator()(const f32x4 (&acc)[2][2][4][2], const pg8::GUnit& u, int wr, int wc, int fr, int fq) const {
        const int row0 = u.pm * 256 + wr * 64 + fr, col0 = u.pn * 256 + wc * 32 + fq * 8, b = (u.pm * 256) / S;
        f32x4 gt[2][2];
#pragma unroll
        for (int bj = 0; bj < 2; ++bj)
#pragma unroll
            for (int n = 0; n < 2; ++n) gt[bj][n] = *(const f32x4*)(mod + b * 6144 + 2048 + col0 + bj * 128 + n * 4);
#pragma unroll
        for (int ai = 0; ai < 2; ++ai)
#pragma unroll
            for (int m = 0; m < 4; ++m) { const size_t ro = (size_t)(row0 + ai * 128 + m * 16) * D + col0;
#pragma unroll
                for (int bj = 0; bj < 2; ++bj) { const f32x4 x0 = *(const f32x4*)(x + ro + bj * 128), x1 = *(const f32x4*)(x + ro + bj * 128 + 4);
                    *(u32x4*)(x1b + ro + bj * 128) = pack8(x0 + gt[bj][0] * acc[ai][bj][m][0], x1 + gt[bj][1] * acc[ai][bj][m][1]); } }
    }
};
struct EpiActF {
    static __device__ __forceinline__ int nstores(const pg8::GUnit&) { return 8; }
    const LAS float* btab; bf16* act;
    __device__ __forceinline__ void operator()(const f32x4 (&acc)[2][2][4][2], const pg8::GUnit& u, int wr, int wc, int fr, int fq) const {
        const int row0 = u.pm * 256 + wr * 64 + fr, c0 = u.pn * 128 + wc * 32 + fq * 8;
        const LAS float* bt = btab + u.s * 256 + wc * 32 + fq * 8;
        constexpr float ASC = (float)(1 << A_SH);
        f32x4 bg[2], bu[2];
#pragma unroll
        for (int n = 0; n < 2; ++n) { bg[n] = *(const LAS f32x4*)(bt + n * 4); bu[n] = (*(const LAS f32x4*)(bt + 128 + n * 4) + 1.f) * ASC; }
#pragma unroll
        for (int ai = 0; ai < 2; ++ai)
#pragma unroll
            for (int m = 0; m < 4; ++m) { f32x4 v[2];
#pragma unroll
                for (int n = 0; n < 2; ++n) {
                    f32x4 g = acc[ai][0][m][n] + bg[n], up = acc[ai][1][m][n] * ASC + bu[n], ex, rc;
#pragma unroll
                    for (int e = 0; e < 4; ++e) { g[e] = fminf(g[e], 7.f); up[e] = __builtin_amdgcn_fmed3f(up[e], -6.f * ASC, 8.f * ASC); }
                    const f32x4 a = g * (-1.702f * LOG2E);
#pragma unroll
                    for (int e = 0; e < 4; ++e) ex[e] = __builtin_amdgcn_exp2f(a[e]);
                    const f32x4 d = ex + 1.f;
#pragma unroll
                    for (int e = 0; e < 4; ++e) rc[e] = __builtin_amdgcn_rcpf(d[e]);
                    v[n] = (g * up) * rc; }
                if (FP8_MOE) { u32x2 o; o.x = pk4_fp8_nc(v[0][0], v[0][1], v[0][2], v[0][3]); o.y = pk4_fp8_nc(v[1][0], v[1][1], v[1][2], v[1][3]);
                    *(u32x2*)((unsigned char*)act + (size_t)(row0 + ai * 128 + m * 16) * FF + c0) = o; }
                else *(u32x4*)(act + (size_t)(row0 + ai * 128 + m * 16) * FF + c0) = pack8(v[0] * (1.f / ASC), v[1] * (1.f / ASC)); }
    }
};
struct EpiEOF {
    static __device__ __forceinline__ int nstores(const pg8::GUnit&) { return 8; }
    const LAS float* btab; bf16* eo;
    __device__ __forceinline__ void operator()(const f32x4 (&acc)[2][2][4][2], const pg8::GUnit& u, int wr, int wc, int fr, int fq) const {
        const int row0 = u.pm * 256 + wr * 64 + fr, col0 = u.pn * 256 + wc * 64 + fq * 16;
        const LAS float* bt = btab + u.s * 256 + wc * 64 + fq * 16;
        constexpr float ESC = (float)(1 << E_SH);
        f32x4 bv[2][2];
#pragma unroll
        for (int bj = 0; bj < 2; ++bj)
#pragma unroll
            for (int n = 0; n < 2; ++n) bv[bj][n] = *(const LAS f32x4*)(bt + bj * 8 + n * 4) * ESC;
#pragma unroll
        for (int ai = 0; ai < 2; ++ai)
#pragma unroll
            for (int m = 0; m < 4; ++m) { u32x4 o; f32x4 v;
                v = acc[ai][0][m][0] * ESC + bv[0][0]; o.x = pk4_fp8(v[0], v[1], v[2], v[3], 1.f);
                v = acc[ai][0][m][1] * ESC + bv[0][1]; o.y = pk4_fp8(v[0], v[1], v[2], v[3], 1.f);
                v = acc[ai][1][m][0] * ESC + bv[1][0]; o.z = pk4_fp8(v[0], v[1], v[2], v[3], 1.f);
                v = acc[ai][1][m][1] * ESC + bv[1][1]; o.w = pk4_fp8(v[0], v[1], v[2], v[3], 1.f);
                *(u32x4*)((unsigned char*)eo + (size_t)(row0 + ai * 128 + m * 16) * D + col0) = o; }
    }
};

constexpr int LDS_STAGE = 0, LDS_STAGE_BYTES = 131072;
constexpr int LDS_GTAB = 131072;
constexpr int LDS_RB2E = LDS_GTAB + 2048;
constexpr int LDS_GQK = LDS_RB2E + 2176;
constexpr int LDS_RBF = LDS_GQK + 512;
constexpr int LDS_MISC = LDS_RBF + 256;
constexpr int LDS_BTAB = LDS_MISC + 256;
constexpr int LDS_BYTES = 147456;
static_assert(LDS_BTAB + 2048 <= LDS_BYTES, "LDS map");

namespace att {
constexpr int SLOT = 32768, KOFF = 0, VOFF = 16384, NSLOT = 4;
constexpr int LDS_WS = LDS_GTAB;
constexpr int LDS_X = 0;
constexpr int LDS_Y = 65536;
constexpr int LDS_XS = LDS_BTAB;
constexpr int LDS_GSUB = LDS_GQK;
constexpr float THR = 8.f;
typedef short v4i16 __attribute__((ext_vector_type(4)));
template <int OFF> __device__ __forceinline__ bf16x8 rd128(unsigned a) { bf16x8 v; asm volatile("ds_read_b128 %0, %1 offset:%2" : "=v"(v) : "v"(a), "n"(OFF)); return v; }
template <int OFF> __device__ __forceinline__ v4i16 rdtr(unsigned a) { v4i16 v; asm volatile("ds_read_b64_tr_b16 %0, %1 offset:%2" : "=v"(v) : "v"(a), "n"(OFF)); return v; }
__device__ __forceinline__ float max3(float a, float b, float c) { float r; asm("v_max3_f32 %0, %1, %2, %3" : "=v"(r) : "v"(a), "v"(b), "v"(c)); return r; }
#define ATT_WAITV(n) asm volatile("s_waitcnt vmcnt(" #n ")" ::: "memory")
#define ATT_BAR() asm volatile("s_waitcnt lgkmcnt(0)\n\ts_barrier" ::: "memory")
#define ATT_WAIT_TILE(k_, last_) do { const int _y = ((last_) < NTu - 1 ? (last_) : NTu - 1) - (k_); if (_y >= 2) ATT_WAITV(8); else if (_y == 1) ATT_WAITV(4); else ATT_WAITV(0); } while (0)
__device__ __forceinline__ void unit(const int b, const int h, const int qb, const int t_lo, const bf16* __restrict__ proj, bf16* __restrict__ odiff, LAS unsigned char* lds, const float lam, const float* __restrict__ gsub,
                                     const bool pre, const bool nvalid, const int nb, const int nh, const int nqb, bf16x8& qn0, bf16x8& qn1, bf16x8& qn2, bf16x8& qn3) {
    int tid = threadIdx.x; asm volatile("" : "+v"(tid));
    const int lane = tid & 63, r = lane & 31, hi = lane >> 5; const int wid = __builtin_amdgcn_readfirstlane(tid >> 6), c = wid >> 2, sb = wid & 3;
    const size_t rowb = (size_t)b * S; const int q0 = 128 * qb + 32 * sb;
    const size_t hrow = (size_t)(b * 8 + h) * S;
    const bf16* Kg = proj + PO_DK + hrow * 128; const bf16* Vg = proj + PO_DV + hrow * 128;
    const bf16* Qg = proj + PO_DQ + (hrow + q0 + r) * 128 + c * 64 + hi * 8;
    bf16x8 qf[4];
    if (pre) { qf[0] = qn0; qf[1] = qn1; qf[2] = qn2; qf[3] = qn3; }
    else {
#pragma unroll
        for (int ks = 0; ks < 4; ++ks) qf[ks] = *(const bf16x8*)(Qg + 16 * ks);
    }
    const float slope2 = __builtin_amdgcn_exp2f(-(float)(h + 1)) * LOG2E;
    const int t_hi = 2 * qb + 1, NTu = t_hi + 1 - t_lo;
    LAS float* wsf = (LAS float*)(lds + LDS_WS) + wid * 64;
    const unsigned lds0 = (unsigned)(uintptr_t)lds;
    unsigned kof[2], vof[2];
#pragma unroll
    for (int j = 0; j < 2; ++j) { const int pc = wid + 8 * j, key = 4 * pc + (lane >> 4); kof[j] = (unsigned)(key * 256 + (((lane & 15) ^ (key & 7)) << 4));
        const int blk = wid + 8 * j, d0 = blk >> 2, kk = blk & 3; vof[j] = (unsigned)((16 * kk + (lane >> 2)) * 256 + (32 * d0 + 8 * (lane & 3)) * 2); }
#define ATT_DMA(it_) do { const int _t = t_hi - (it_); LAS unsigned char* _s = lds + (((it_) + 3) & 3) * SLOT; \
        const char* _kb = (const char*)Kg + (size_t)_t * 16384; const char* _vb = (const char*)Vg + (size_t)_t * 16384; \
        _Pragma("unroll") for (int _j = 0; _j < 2; ++_j) __builtin_amdgcn_global_load_lds((const unsigned*)(_kb + kof[_j]), (LAS unsigned*)(_s + KOFF + (wid + 8 * _j) * 1024), 16, 0, 0); \
        _Pragma("unroll") for (int _j = 0; _j < 2; ++_j) __builtin_amdgcn_global_load_lds((const unsigned*)(_vb + vof[_j]), (LAS unsigned*)(_s + VOFF + (wid + 8 * _j) * 1024), 16, 0, 0); } while (0)
    if (!pre) ATT_DMA(0);
    ATT_DMA(1); if (NTu > 2) ATT_DMA(2);
    f32x16 o[4], ol;
#pragma unroll
    for (int q = 0; q < 16; ++q) { ol[q] = 0.f;
#pragma unroll
        for (int d = 0; d < 4; ++d) o[d][q] = 0.f; }
    float m = 0.f;
    unsigned kl[4];
#pragma unroll
    for (int ks = 0; ks < 4; ++ks) kl[ks] = lds0 + KOFF + r * 256 + (((8 * c + 2 * ks + hi) ^ (r & 7)) << 4);
    const unsigned vl = lds0 + VOFF + ((lane >> 4) & 1) * 32 + (lane & 3) * 8 + (4 * hi + ((lane & 15) >> 2)) * 64;
    f32x16 p0, p1;
    const bf16x8 ones = (bf16x8){0x3F80, 0x3F80, 0x3F80, 0x3F80, 0x3F80, 0x3F80, 0x3F80, 0x3F80};
#define ATT_PINIT(it_) do { const int _t = t_hi - (it_); const float cb = slope2 * (float)(64 * _t - (q0 + r) + 4 * hi) - m; \
        _Pragma("unroll") for (int q = 0; q < 16; ++q) { p0[q] = fmaf(slope2, (float)((q & 3) + 8 * (q >> 2)), cb); p1[q] = fmaf(slope2, (float)((q & 3) + 8 * (q >> 2) + 32), cb); } } while (0)
#define ATT_H1(it_, FIRST_) do { const int _t = t_hi - (it_); \
        if (64 * _t <= q0 + 31) { const unsigned so_ = (unsigned)(((it_) + 3) & 3) * SLOT; \
            bf16x8 k0 = rd128<0>(kl[0] + so_), k1 = rd128<0>(kl[1] + so_), k2 = rd128<0>(kl[2] + so_), k3 = rd128<0>(kl[3] + so_), k4 = rd128<8192>(kl[0] + so_), k5 = rd128<8192>(kl[1] + so_), k6 = rd128<8192>(kl[2] + so_), k7 = rd128<8192>(kl[3] + so_); \
            asm volatile("s_waitcnt lgkmcnt(0)" : "+v"(k0), "+v"(k1), "+v"(k2), "+v"(k3), "+v"(k4), "+v"(k5), "+v"(k6), "+v"(k7)); \
            p0 = __builtin_amdgcn_mfma_f32_32x32x16_bf16(k0, qf[0], p0, 0, 0, 0); p1 = __builtin_amdgcn_mfma_f32_32x32x16_bf16(k4, qf[0], p1, 0, 0, 0); \
            p0 = __builtin_amdgcn_mfma_f32_32x32x16_bf16(k1, qf[1], p0, 0, 0, 0); p1 = __builtin_amdgcn_mfma_f32_32x32x16_bf16(k5, qf[1], p1, 0, 0, 0); \
            p0 = __builtin_amdgcn_mfma_f32_32x32x16_bf16(k2, qf[2], p0, 0, 0, 0); p1 = __builtin_amdgcn_mfma_f32_32x32x16_bf16(k6, qf[2], p1, 0, 0, 0); \
            p0 = __builtin_amdgcn_mfma_f32_32x32x16_bf16(k3, qf[3], p0, 0, 0, 0); p1 = __builtin_amdgcn_mfma_f32_32x32x16_bf16(k7, qf[3], p1, 0, 0, 0); \
            if (64 * _t + 63 > q0) { \
                _Pragma("unroll") for (int q = 0; q < 16; ++q) { const int j = 64 * _t + crow(q, hi); if (j > q0 + r) p0[q] = -INFINITY; if (j + 32 > q0 + r) p1[q] = -INFINITY; } } \
            float rm = max3(p0[0], p0[1], p1[0]); rm = max3(rm, p1[1], p0[2]); rm = max3(rm, p0[3], p1[2]); rm = max3(rm, p1[3], p0[4]); \
            rm = max3(rm, p0[5], p1[4]); rm = max3(rm, p1[5], p0[6]); rm = max3(rm, p0[7], p1[6]); rm = max3(rm, p1[7], p0[8]); \
            rm = max3(rm, p0[9], p1[8]); rm = max3(rm, p1[9], p0[10]); rm = max3(rm, p0[11], p1[10]); rm = max3(rm, p1[11], p0[12]); \
            rm = max3(rm, p0[13], p1[12]); rm = max3(rm, p1[13], p0[14]); rm = max3(rm, p0[15], p1[14]); rm = max3(rm, p1[15], rm); \
            rm = fmaxf(rm, __shfl_xor(rm, 32)); \
            if (FIRST_) { m = rm;                                         \
                _Pragma("unroll") for (int q = 0; q < 16; ++q) { p0[q] -= rm; p1[q] -= rm; } } \
            else if (__any(rm > THR)) { \
                const float dl = fmaxf(rm, 0.f), alpha = __builtin_amdgcn_exp2f(-dl); m += dl; \
                _Pragma("unroll") for (int q = 0; q < 16; ++q) { p0[q] -= dl; p1[q] -= dl; } \
                if (hi == 0) wsf[r] = alpha; \
                asm volatile("s_waitcnt lgkmcnt(0)" ::: "memory"); \
                _Pragma("unroll") for (int g4 = 0; g4 < 4; ++g4) { const f32x4 a4 = *(const LAS f32x4*)(wsf + 8 * g4 + 4 * hi);     \
                    _Pragma("unroll") for (int e = 0; e < 4; ++e) { ol[4 * g4 + e] *= a4[e]; \
                        _Pragma("unroll") for (int d = 0; d < 4; ++d) o[d][4 * g4 + e] *= a4[e]; } \
                    __builtin_amdgcn_sched_barrier(0); } } \
            _Pragma("unroll") for (int q = 0; q < 16; ++q) { p0[q] = __builtin_amdgcn_exp2f(p0[q]); p1[q] = __builtin_amdgcn_exp2f(p1[q]); } } } while (0)
#define ATT_VRD(dst, s_) do { dst##0l = rdtr<(s_) * 2048>(va); dst##0h = rdtr<(s_) * 2048 + 512>(va); dst##1l = rdtr<(s_) * 2048 + 1024>(va); dst##1h = rdtr<(s_) * 2048 + 1536>(va); } while (0)
#define ATT_VWAIT(n, dst) asm volatile("s_waitcnt lgkmcnt(" #n ")" : "+v"(dst##0l), "+v"(dst##0h), "+v"(dst##1l), "+v"(dst##1h))
#define ATT_VF(dst, k) (bf16x8){dst##k##l[0], dst##k##l[1], dst##k##l[2], dst##k##l[3], dst##k##h[0], dst##k##h[1], dst##k##h[2], dst##k##h[3]}
#define ATT_PV(s_, dst, PA, PB) do { o[(s_) >> 1] = __builtin_amdgcn_mfma_f32_32x32x16_bf16(PA, ATT_VF(dst, 0), o[(s_) >> 1], 0, 0, 0); o[(s_) >> 1] = __builtin_amdgcn_mfma_f32_32x32x16_bf16(PB, ATT_VF(dst, 1), o[(s_) >> 1], 0, 0, 0); } while (0)
#define ATT_PACK(P, b8) __builtin_bit_cast(bf16x8, (u32x4){pg8::cvt_pk_bf16(P[b8 + 0], P[b8 + 1]), pg8::cvt_pk_bf16(P[b8 + 2], P[b8 + 3]), pg8::cvt_pk_bf16(P[b8 + 4], P[b8 + 5]), pg8::cvt_pk_bf16(P[b8 + 6], P[b8 + 7])})
#define ATT_H2(it_) do { const int _t = t_hi - (it_); \
        if (64 * _t <= q0 + 31) { const unsigned va = vl + (unsigned)(((it_) + 3) & 3) * SLOT; \
            v4i16 A0l, A0h, A1l, A1h, B0l, B0h, B1l, B1h; \
            ATT_VRD(A, 0); \
            const bf16x8 pa0 = ATT_PACK(p0, 0), pa1 = ATT_PACK(p0, 8), pa2 = ATT_PACK(p1, 0), pa3 = ATT_PACK(p1, 8); \
            ATT_VRD(B, 1); \
            ol = __builtin_amdgcn_mfma_f32_32x32x16_bf16(pa0, ones, ol, 0, 0, 0); ol = __builtin_amdgcn_mfma_f32_32x32x16_bf16(pa1, ones, ol, 0, 0, 0); \
            ol = __builtin_amdgcn_mfma_f32_32x32x16_bf16(pa2, ones, ol, 0, 0, 0); ol = __builtin_amdgcn_mfma_f32_32x32x16_bf16(pa3, ones, ol, 0, 0, 0); \
            ATT_VWAIT(4, A); ATT_PV(0, A, pa0, pa1); ATT_VRD(A, 2); ATT_VWAIT(4, B); ATT_PV(1, B, pa2, pa3); \
            ATT_VRD(B, 3); ATT_VWAIT(4, A); ATT_PV(2, A, pa0, pa1); ATT_VRD(A, 4); ATT_VWAIT(4, B); ATT_PV(3, B, pa2, pa3); \
            ATT_VRD(B, 5); ATT_VWAIT(4, A); ATT_PV(4, A, pa0, pa1); ATT_VRD(A, 6); ATT_VWAIT(4, B); ATT_PV(5, B, pa2, pa3); \
            ATT_VRD(B, 7); ATT_VWAIT(4, A); ATT_PV(6, A, pa0, pa1); ATT_VWAIT(0, B); ATT_PV(7, B, pa2, pa3); } \
        if ((it_) + 1 < NTu) ATT_PINIT((it_) + 1); } while (0)
    { const float m0 = m; (void)m0; ATT_PINIT(0); }
    if (c == 0) {
        ATT_WAIT_TILE(0, 2); ATT_BAR();
        ATT_H1(0, true);
        ATT_BAR();
        ATT_H2(0); if (3 < NTu) ATT_DMA(3);
        for (int it = 1; it < NTu; ++it) {
            ATT_WAIT_TILE(it, it + 2); ATT_BAR();
            ATT_H1(it, false);
            ATT_BAR();
            ATT_H2(it); if (it + 3 < NTu) ATT_DMA(it + 3);
        }
        ATT_BAR();
    } else {
        ATT_WAIT_TILE(0, 2); ATT_BAR();
        ATT_BAR();
        ATT_H1(0, true);
        ATT_WAIT_TILE(1, 2);
        ATT_BAR();
        ATT_H2(0); if (3 < NTu) ATT_DMA(3);
        for (int it = 1; it < NTu; ++it) {
            ATT_BAR();
            ATT_H1(it, false);
            if (it + 1 < NTu) ATT_WAIT_TILE(it + 1, it + 2);
            ATT_BAR();
            ATT_H2(it); if (it + 3 < NTu) ATT_DMA(it + 3);
        }
    }
    float rl[16];
#pragma unroll
    for (int q = 0; q < 16; ++q) rl[q] = (c == 1 ? lam : 1.f) * __builtin_amdgcn_rcpf(ol[q]);
#pragma unroll
    for (int d0 = 0; d0 < 4; ++d0)
#pragma unroll
        for (int q = 0; q < 16; ++q) o[d0][q] *= rl[q];
    ATT_BAR();
    if (nvalid) { const size_t nhrow = (size_t)(nb * 8 + nh) * S; LAS unsigned char* _s = lds + 3 * SLOT;
        const char* _kb = (const char*)(proj + PO_DK + nhrow * 128) + (size_t)(2 * nqb + 1) * 16384; const char* _vb = (const char*)(proj + PO_DV + nhrow * 128) + (size_t)(2 * nqb + 1) * 16384;
#pragma unroll
        for (int _j = 0; _j < 2; ++_j) __builtin_amdgcn_global_load_lds((const unsigned*)(_kb + kof[_j]), (LAS unsigned*)(_s + KOFF + (wid + 8 * _j) * 1024), 16, 0, 0);
#pragma unroll
        for (int _j = 0; _j < 2; ++_j) __builtin_amdgcn_global_load_lds((const unsigned*)(_vb + vof[_j]), (LAS unsigned*)(_s + VOFF + (wid + 8 * _j) * 1024), 16, 0, 0);
        const bf16* nQg = proj + PO_DQ + (nhrow + 128 * nqb + 32 * sb + r) * 128 + c * 64 + hi * 8;
        qn0 = *(const bf16x8*)(nQg); qn1 = *(const bf16x8*)(nQg + 16); qn2 = *(const bf16x8*)(nQg + 32); qn3 = *(const bf16x8*)(nQg + 48); }
    else { qn0 = (bf16x8){}; qn1 = (bf16x8){}; qn2 = (bf16x8){}; qn3 = (bf16x8){}; }
    { LAS f32x4* XE = (LAS f32x4*)(lds + LDS_X) + ((c * 4 + sb) * 8) * 64 + lane;
        if (c == 0) {
#pragma unroll
            for (int j = 0; j < 8; ++j) XE[j * 64] = (f32x4){o[2 + (j >> 2)][4 * (j & 3)], o[2 + (j >> 2)][4 * (j & 3) + 1], o[2 + (j >> 2)][4 * (j & 3) + 2], o[2 + (j >> 2)][4 * (j & 3) + 3]};
        } else {
#pragma unroll
            for (int j = 0; j < 8; ++j) XE[j * 64] = (f32x4){o[j >> 2][4 * (j & 3)], o[j >> 2][4 * (j & 3) + 1], o[j >> 2][4 * (j & 3) + 2], o[j >> 2][4 * (j & 3) + 3]};
        } }
    ATT_BAR();
    float v[2][16], ss[16];
    { const LAS f32x4* XR = (const LAS f32x4*)(lds + LDS_X) + (((c ^ 1) * 4 + sb) * 8) * 64 + lane;
        f32x4 pr[8];
#pragma unroll
        for (int j = 0; j < 8; ++j) pr[j] = XR[j * 64];
        if (c == 0) {
#pragma unroll
            for (int k = 0; k < 2; ++k)
#pragma unroll
                for (int q = 0; q < 16; ++q) v[k][q] = o[k][q] - pr[4 * k + (q >> 2)][q & 3];
        } else {
#pragma unroll
            for (int k = 0; k < 2; ++k)
#pragma unroll
                for (int q = 0; q < 16; ++q) v[k][q] = pr[4 * k + (q >> 2)][q & 3] - o[2 + k][q];
        } }
#pragma unroll
    for (int q = 0; q < 16; ++q) { ss[q] = rowsum16(v[0][q] * v[0][q] + v[1][q] * v[1][q]); ss[q] += __shfl_xor(ss[q], 16); }
    LAS f32x4* XS = (LAS f32x4*)(lds + LDS_XS);
    if (r == 0) {
#pragma unroll
        for (int j = 0; j < 4; ++j) XS[((c * 4 + sb) * 2 + hi) * 4 + j] = (f32x4){ss[4 * j], ss[4 * j + 1], ss[4 * j + 2], ss[4 * j + 3]}; }
    ATT_BAR();
    {
#pragma unroll
        for (int j = 0; j < 4; ++j) { const f32x4 ps = XS[(((c ^ 1) * 4 + sb) * 2 + hi) * 4 + j];
#pragma unroll
            for (int e = 0; e < 4; ++e) ss[4 * j + e] = __builtin_amdgcn_rsqf((ss[4 * j + e] + ps[e]) * (1.f / 128) + EPS) * (1.f - LAMBDA_INIT); } }
    LAS bf16* Y = (LAS bf16*)(lds + LDS_Y) + sb * 32 * 128;
    { const int dA = 2 * c; const LAS float* gL = (const LAS float*)(lds + LDS_GSUB);
#pragma unroll
        for (int k = 0; k < 2; ++k) { const float g = gL[32 * (dA + k) + r];
#pragma unroll
            for (int q = 0; q < 16; ++q) Y[crow(q, hi) * 128 + 32 * (dA + k) + r] = f2bf(v[k][q] * ss[q] * g); } }
    ATT_BAR();
    { bf16* Og = odiff + (rowb + q0) * D + h * 128;
#pragma unroll
        for (int i = 0; i < 4; ++i) { const int row = 16 * c + 4 * i + (lane >> 4), ch = lane & 15; *(u32x4*)(Og + (size_t)row * D + ch * 8) = *(const LAS u32x4*)(Y + row * 128 + ch * 8); } }
    ATT_BAR();
#undef ATT_DMA
#undef ATT_H1
#undef ATT_H2
#undef ATT_PINIT
}
}

namespace ret {
typedef short v4i16 __attribute__((ext_vector_type(4)));
constexpr int STG = 98304;
#define RET_BAR() do { asm volatile("s_waitcnt lgkmcnt(0)" ::: "memory"); __builtin_amdgcn_s_barrier(); asm volatile("" ::: "memory"); } while (0)
__device__ __forceinline__ bf16x8 trfrag(LAS unsigned char* p, int second_off) {
    const v4i16 lo = __builtin_amdgcn_ds_read_tr16_b64_v4i16((LAS v4i16*)p), hh = __builtin_amdgcn_ds_read_tr16_b64_v4i16((LAS v4i16*)(p + second_off));
    return (bf16x8){lo[0], lo[1], lo[2], lo[3], hh[0], hh[1], hh[2], hh[3]};
}
__device__ __forceinline__ void store_tile64(const f32x16& t0, const f32x16& t1, LAS unsigned char* stg, bf16* __restrict__ gdst, const size_t gpitch, const int lane) {
    const int r = lane & 31, hi = lane >> 5;
#pragma unroll
    for (int q = 0; q < 16; ++q) { const int row = crow(q, hi); *(LAS bf16*)(stg + row * 128 + r * 2) = f2bf(t0[q]); *(LAS bf16*)(stg + row * 128 + 64 + r * 2) = f2bf(t1[q]); }
    asm volatile("s_waitcnt lgkmcnt(0)" ::: "memory");
#pragma unroll
    for (int i = 0; i < 4; ++i) { const int row = 8 * i + (lane >> 3), ch = lane & 7; *(u32x4*)(gdst + (size_t)row * gpitch + ch * 8) = *(const LAS u32x4*)(stg + row * 128 + ch * 16); }
    asm volatile("s_waitcnt lgkmcnt(0)" ::: "memory");
}
__device__ __forceinline__ void r1_unit(const int b, const int h, const int j, const bf16* __restrict__ proj, bf16* __restrict__ ubuf, LAS unsigned char* lds) {
    constexpr int KV = 0, VV = 32768;
    int tid = threadIdx.x; asm volatile("" : "+v"(tid));
    const int lane = tid & 63, hi = lane >> 5; const int wid = __builtin_amdgcn_readfirstlane(tid >> 6), db = wid & 3, cg = wid >> 2;
    const size_t hrow = (size_t)(b * 4 + h) * S + (size_t)j * 128;
    const bf16* Kg = proj + PO_RK + hrow * 128; const bf16* Vg = proj + PO_RV + hrow * 256;
#pragma unroll
    for (int i = 0; i < 4; ++i) { const int blk = wid * 4 + i, d_b = blk >> 3, mg = blk & 7;
        __builtin_amdgcn_global_load_lds((const unsigned*)(Kg + (size_t)(16 * mg + (lane >> 2)) * 128 + 32 * d_b + 8 * (lane & 3)), (LAS unsigned*)(lds + KV + blk * 1024), 16, 0, 0); }
#pragma unroll
    for (int i = 0; i < 8; ++i) { const int blk = wid * 8 + i, cb = blk >> 3, mg = blk & 7;
        __builtin_amdgcn_global_load_lds((const unsigned*)(Vg + (size_t)(16 * mg + (lane >> 2)) * 256 + 32 * cb + 8 * (lane & 3)), (LAS unsigned*)(lds + VV + blk * 1024), 16, 0, 0); }
    const int vperm = ((lane >> 4) & 1) * 32 + (lane & 3) * 8 + (4 * hi + ((lane & 15) >> 2)) * 64;
    f32x16 u[4];
#pragma unroll
    for (int t = 0; t < 4; ++t)
#pragma unroll
        for (int q = 0; q < 16; ++q) u[t][q] = 0.f;
    asm volatile("s_waitcnt vmcnt(0)" ::: "memory");
    RET_BAR();
#pragma unroll
    for (int m2 = 0; m2 < 4; ++m2) {
        bf16x8 a[2], bv[2][4];
#pragma unroll
        for (int s = 0; s < 2; ++s) { const int mg = 2 * m2 + s; a[s] = trfrag(lds + KV + (db * 8 + mg) * 1024 + vperm, 512);
#pragma unroll
            for (int t = 0; t < 4; ++t) bv[s][t] = trfrag(lds + VV + ((4 * cg + t) * 8 + mg) * 1024 + vperm, 512); }
#pragma unroll
        for (int s = 0; s < 2; ++s)
#pragma unroll
            for (int t = 0; t < 4; ++t) u[t] = __builtin_amdgcn_mfma_f32_32x32x16_bf16(a[s], bv[s][t], u[t], 0, 0, 0);
    }
    bf16* Ug = ubuf + (((size_t)b * 4 + h) * 32 + j) * 32768 + (size_t)(32 * db) * 256 + 128 * cg;
    LAS unsigned char* stg = lds + STG + wid * 4096;
    store_tile64(u[0], u[1], stg, Ug, 256, lane);
    store_tile64(u[2], u[3], stg, Ug + 64, 256, lane);
    RET_BAR();
}
__device__ __forceinline__ void r3_unit(const int b, const int h, const int j, const int half, const bf16* __restrict__ proj, const bf16* __restrict__ rbbuf, bf16* __restrict__ yret, LAS unsigned char* lds) {
    constexpr int KK = 0, VV = 32768, RB = 65536;
    int tid = threadIdx.x; asm volatile("" : "+v"(tid));
    const int lane = tid & 63, r = lane & 31, hi = lane >> 5; const int wid = __builtin_amdgcn_readfirstlane(tid >> 6), sb = wid & 3, ch = wid >> 2;
    const size_t row0 = (size_t)b * S + (size_t)j * 128, hrow = (size_t)(b * 4 + h) * S + (size_t)j * 128;
    const bf16* Qg = proj + PO_RQ + hrow * 128; const bf16* Kg = proj + PO_RK + hrow * 128; const bf16* Vg = proj + PO_RV + hrow * 256 + half * 128;
    const bf16* Rg = rbbuf + (((size_t)b * 4 + h) * 32 + j) * 32768 + half * 128;
#pragma unroll
    for (int i = 0; i < 4; ++i) { const int pc = wid * 4 + i, cidx = pc >> 1, mh = pc & 1;
        __builtin_amdgcn_global_load_lds((const unsigned*)(Kg + (size_t)(64 * mh + lane) * 128 + cidx * 8), (LAS unsigned*)(lds + KK + cidx * 2048 + mh * 1024), 16, 0, 0); }
#pragma unroll
    for (int i = 0; i < 4; ++i) { const int blk = wid * 4 + i, cb = blk >> 3, mg = blk & 7;
        __builtin_amdgcn_global_load_lds((const unsigned*)(Vg + (size_t)(16 * mg + (lane >> 2)) * 256 + 32 * cb + 8 * (lane & 3)), (LAS unsigned*)(lds + VV + blk * 1024), 16, 0, 0);
        __builtin_amdgcn_global_load_lds((const unsigned*)(Rg + (size_t)(16 * mg + (lane >> 2)) * 256 + 32 * cb + 8 * (lane & 3)), (LAS unsigned*)(lds + RB + blk * 1024), 16, 0, 0); }
    bf16x8 qf[8];
#pragma unroll
    for (int ks = 0; ks < 8; ++ks) qf[ks] = *(const bf16x8*)(Qg + (size_t)(32 * sb + r) * 128 + 16 * ks + 8 * hi);
    const int vperm = ((lane >> 4) & 1) * 32 + (lane & 3) * 8 + (4 * hi + ((lane & 15) >> 2)) * 64;
    const int vnat  = ((lane >> 4) & 1) * 32 + (lane & 3) * 8 + (8 * hi + ((lane & 15) >> 2)) * 64;
    asm volatile("s_waitcnt vmcnt(0)" ::: "memory");
    RET_BAR();
    bf16x8 pa[8];
#pragma unroll
    for (int kb = 0; kb < 4; ++kb) {
        if (kb <= sb) {
            bf16x8 kf[8];
#pragma unroll
            for (int ks = 0; ks < 8; ++ks) kf[ks] = *(const LAS bf16x8*)(lds + KK + (2 * ks + hi) * 2048 + (32 * kb + r) * 16);
            f32x16 p;
#pragma unroll
            for (int q = 0; q < 16; ++q) p[q] = 0.f;
#pragma unroll
            for (int ks = 0; ks < 8; ++ks) p = __builtin_amdgcn_mfma_f32_32x32x16_bf16(kf[ks], qf[ks], p, 0, 0, 0);
            if (kb == sb) {
#pragma unroll
                for (int q = 0; q < 16; ++q) if (crow(q, hi) > r) p[q] = 0.f;
            }
#pragma unroll
            for (int b8 = 0; b8 < 2; ++b8) { u32x4 w;
                w.x = pg8::cvt_pk_bf16(p[8 * b8 + 0], p[8 * b8 + 1]); w.y = pg8::cvt_pk_bf16(p[8 * b8 + 2], p[8 * b8 + 3]); w.z = pg8::cvt_pk_bf16(p[8 * b8 + 4], p[8 * b8 + 5]); w.w = pg8::cvt_pk_bf16(p[8 * b8 + 6], p[8 * b8 + 7]);
                pa[2 * kb + b8] = __builtin_bit_cast(bf16x8, w); }
        }
    }
    f32x16 y[2];
#pragma unroll
    for (int d0 = 0; d0 < 2; ++d0) {
#pragma unroll
        for (int q = 0; q < 16; ++q) y[d0][q] = 0.f;
        const int cb = 2 * ch + d0;
        bf16x8 vf[8];
#pragma unroll
        for (int kk = 0; kk < 8; ++kk) if ((kk >> 1) <= sb) vf[kk] = trfrag(lds + VV + (cb * 8 + kk) * 1024 + vperm, 512);
#pragma unroll
        for (int kk = 0; kk < 8; ++kk) if ((kk >> 1) <= sb) y[d0] = __builtin_amdgcn_mfma_f32_32x32x16_bf16(pa[kk], vf[kk], y[d0], 0, 0, 0);
        bf16x8 rf[8];
#pragma unroll
        for (int ks = 0; ks < 8; ++ks) rf[ks] = trfrag(lds + RB + (cb * 8 + ks) * 1024 + vnat, 256);
#pragma unroll
        for (int ks = 0; ks < 8; ++ks) y[d0] = __builtin_amdgcn_mfma_f32_32x32x16_bf16(qf[ks], rf[ks], y[d0], 0, 0, 0);
    }
    bf16* Yg = yret + (row0 + 32 * sb) * D + h * 256 + half * 128 + 64 * ch;
    store_tile64(y[0], y[1], lds + STG + wid * 4096, Yg, D, lane);
    RET_BAR();
}
__device__ __forceinline__ float rbflo(unsigned u) { return __builtin_bit_cast(float, u << 16); }
__device__ __forceinline__ float rbfhi(unsigned u) { return __builtin_bit_cast(float, u & 0xffff0000u); }
__device__ __forceinline__ void r3m_unit(const int b, const int h, const int j, const bf16* __restrict__ proj, const bf16* __restrict__ rbbuf, const bf16* __restrict__ odiff, bf16* __restrict__ merged,
                                         const float* __restrict__ ggn, const float* __restrict__ bgn, LAS unsigned char* lds) {
    constexpr int KK = 0, VV = 32768, RB = 65536, XS = 98304;
    int tid = threadIdx.x; asm volatile("" : "+v"(tid));
    const int lane = tid & 63, r = lane & 31, hi = lane >> 5; const int wid = __builtin_amdgcn_readfirstlane(tid >> 6), sb = wid & 3, ch = wid >> 2;
    const size_t row0 = (size_t)b * S + (size_t)j * 128, hrow = (size_t)(b * 4 + h) * S + (size_t)j * 128;
    const bf16* Qg = proj + PO_RQ + hrow * 128; const bf16* Kg = proj + PO_RK + hrow * 128; const bf16* Vg = proj + PO_RV + hrow * 256;
    const bf16* Rg = rbbuf + (((size_t)b * 4 + h) * 32 + j) * 32768;
#pragma unroll
    for (int i = 0; i < 4; ++i) { const int pc = wid * 4 + i, cidx = pc >> 1, mh = pc & 1;
        __builtin_amdgcn_global_load_lds((const unsigned*)(Kg + (size_t)(64 * mh + lane) * 128 + cidx * 8), (LAS unsigned*)(lds + KK + cidx * 2048 + mh * 1024), 16, 0, 0); }
#define R3M_DMA_VR(half_) do { _Pragma("unroll") for (int i = 0; i < 4; ++i) { const int blk = wid * 4 + i, cb = blk >> 3, mg = blk & 7; \
        __builtin_amdgcn_global_load_lds((const unsigned*)(Vg + (half_) * 128 + (size_t)(16 * mg + (lane >> 2)) * 256 + 32 * cb + 8 * (lane & 3)), (LAS unsigned*)(lds + VV + blk * 1024), 16, 0, 0); \
        __builtin_amdgcn_global_load_lds((const unsigned*)(Rg + (half_) * 128 + (size_t)(16 * mg + (lane >> 2)) * 256 + 32 * cb + 8 * (lane & 3)), (LAS unsigned*)(lds + RB + blk * 1024), 16, 0, 0); } } while (0)
    R3M_DMA_VR(0);
    bf16x8 qf[8];
#pragma unroll
    for (int ks = 0; ks < 8; ++ks) qf[ks] = *(const bf16x8*)(Qg + (size_t)(32 * sb + r) * 128 + 16 * ks + 8 * hi);
    const int vperm = ((lane >> 4) & 1) * 32 + (lane & 3) * 8 + (4 * hi + ((lane & 15) >> 2)) * 64;
    const int vnat  = ((lane >> 4) & 1) * 32 + (lane & 3) * 8 + (8 * hi + ((lane & 15) >> 2)) * 64;
    asm volatile("s_waitcnt vmcnt(0)" ::: "memory");
    RET_BAR();
    bf16x8 pa[8];
#pragma unroll
    for (int kb = 0; kb < 4; ++kb) {
        if (kb <= sb) {
            bf16x8 kf[8];
#pragma unroll
            for (int ks = 0; ks < 8; ++ks) kf[ks] = *(const LAS bf16x8*)(lds + KK + (2 * ks + hi) * 2048 + (32 * kb + r) * 16);
            f32x16 p;
#pragma unroll
            for (int q = 0; q < 16; ++q) p[q] = 0.f;
#pragma unroll
            for (int ks = 0; ks < 8; ++ks) p = __builtin_amdgcn_mfma_f32_32x32x16_bf16(kf[ks], qf[ks], p, 0, 0, 0);
            if (kb == sb) {
#pragma unroll
                for (int q = 0; q < 16; ++q) if (crow(q, hi) > r) p[q] = 0.f;
            }
#pragma unroll
            for (int b8 = 0; b8 < 2; ++b8) { u32x4 w;
                w.x = pg8::cvt_pk_bf16(p[8 * b8 + 0], p[8 * b8 + 1]); w.y = pg8::cvt_pk_bf16(p[8 * b8 + 2], p[8 * b8 + 3]); w.z = pg8::cvt_pk_bf16(p[8 * b8 + 4], p[8 * b8 + 5]); w.w = pg8::cvt_pk_bf16(p[8 * b8 + 6], p[8 * b8 + 7]);
                pa[2 * kb + b8] = __builtin_bit_cast(bf16x8, w); }
        }
    }
    f32x16 y[2][2];
#define R3M_HALF(hf_) do { _Pragma("unroll") for (int d0 = 0; d0 < 2; ++d0) { \
        _Pragma("unroll") for (int q = 0; q < 16; ++q) y[hf_][d0][q] = 0.f; \
        const int cb = 2 * ch + d0; \
        bf16x8 vf[8]; \
        _Pragma("unroll") for (int kk = 0; kk < 8; ++kk) if ((kk >> 1) <= sb) vf[kk] = trfrag(lds + VV + (cb * 8 + kk) * 1024 + vperm, 512); \
        _Pragma("unroll") for (int kk = 0; kk < 8; ++kk) if ((kk >> 1) <= sb) y[hf_][d0] = __builtin_amdgcn_mfma_f32_32x32x16_bf16(pa[kk], vf[kk], y[hf_][d0], 0, 0, 0); \
        bf16x8 rf[8]; \
        _Pragma("unroll") for (int ks = 0; ks < 8; ++ks) rf[ks] = trfrag(lds + RB + (cb * 8 + ks) * 1024 + vnat, 256); \
        _Pragma("unroll") for (int ks = 0; ks < 8; ++ks) y[hf_][d0] = __builtin_amdgcn_mfma_f32_32x32x16_bf16(qf[ks], rf[ks], y[hf_][d0], 0, 0, 0); } } while (0)
    R3M_HALF(0);
    RET_BAR();
    R3M_DMA_VR(1);
    asm volatile("s_waitcnt vmcnt(0)" ::: "memory");
    RET_BAR();
    R3M_HALF(1);
    RET_BAR();
#undef R3M_DMA_VR
#undef R3M_HALF
    LAS unsigned char* stg = lds + wid * 8192;
#pragma unroll
    for (int hf = 0; hf < 2; ++hf)
#pragma unroll
        for (int d0 = 0; d0 < 2; ++d0)
#pragma unroll
            for (int q = 0; q < 16; ++q) *(LAS bf16*)(stg + crow(q, hi) * 256 + (hf * 64 + d0 * 32 + r) * 2) = f2bf(y[hf][d0][q]);
    asm volatile("s_waitcnt lgkmcnt(0)" ::: "memory");
    const int rs4 = lane >> 4, seg = lane & 15;
    u32x4 yv[8]; float sm[8], sq[8];
#pragma unroll
    for (int i = 0; i < 8; ++i) { yv[i] = *(const LAS u32x4*)(stg + (4 * i + rs4) * 256 + seg * 16);
        const float v0 = rbflo(yv[i].x), v1 = rbfhi(yv[i].x), v2 = rbflo(yv[i].y), v3 = rbfhi(yv[i].y), v4 = rbflo(yv[i].z), v5 = rbfhi(yv[i].z), v6 = rbflo(yv[i].w), v7 = rbfhi(yv[i].w);
        sm[i] = ((v0 + v1) + (v2 + v3)) + ((v4 + v5) + (v6 + v7)); sq[i] = ((v0 * v0 + v1 * v1) + (v2 * v2 + v3 * v3)) + ((v4 * v4 + v5 * v5) + (v6 * v6 + v7 * v7)); }
#pragma unroll
    for (int i = 0; i < 8; ++i) { sm[i] = rowsum16(sm[i]); sq[i] = rowsum16(sq[i]); }
    LAS float* xs = (LAS float*)(lds + XS);
    if (seg == 0) {
#pragma unroll
        for (int i = 0; i < 8; ++i) { xs[(wid * 32 + 4 * i + rs4) * 2] = sm[i]; xs[(wid * 32 + 4 * i + rs4) * 2 + 1] = sq[i]; } }
    RET_BAR();
    const int col = 256 * h + (seg < 8 ? 64 * ch + 8 * seg : 128 + 64 * ch + 8 * (seg - 8));
    const f32x4 g0 = *(const f32x4*)(ggn + col), g1 = *(const f32x4*)(ggn + col + 4), b0 = *(const f32x4*)(bgn + col), b1 = *(const f32x4*)(bgn + col + 4);
#pragma unroll
    for (int ib = 0; ib < 8; ib += 4) {
        u32x4 G1[4], G2[4], OD[4];
#pragma unroll
        for (int i = 0; i < 4; ++i) { const size_t tok = row0 + 32 * sb + 4 * (ib + i) + rs4;
            G1[i] = *(const u32x4*)(proj + PO_RG + tok * 1024 + col); G2[i] = *(const u32x4*)(proj + PO_MG + (size_t)T * 1024 + tok * 1024 + col); OD[i] = *(const u32x4*)(odiff + tok * D + col); }
#pragma unroll
        for (int i = 0; i < 4; ++i) { const int rw = 4 * (ib + i) + rs4; const size_t tok = row0 + 32 * sb + rw;
            const float ts = sm[ib + i] + xs[((wid ^ 4) * 32 + rw) * 2], tq = sq[ib + i] + xs[((wid ^ 4) * 32 + rw) * 2 + 1];
            const float mu = ts * (1.f / 256), rs = __builtin_amdgcn_rsqf(fmaxf(tq * (1.f / 256) - mu * mu, 0.f) + EPS);
            const unsigned yw[4] = {yv[ib + i].x, yv[ib + i].y, yv[ib + i].z, yv[ib + i].w}, g1w[4] = {G1[i].x, G1[i].y, G1[i].z, G1[i].w}, g2w[4] = {G2[i].x, G2[i].y, G2[i].z, G2[i].w}, odw[4] = {OD[i].x, OD[i].y, OD[i].z, OD[i].w};
            unsigned ow[4];
#pragma unroll
            for (int e = 0; e < 4; ++e) { const float gA = e < 2 ? g0[2 * e] : g1[2 * e - 4], gB = e < 2 ? g0[2 * e + 1] : g1[2 * e - 3], bA = e < 2 ? b0[2 * e] : b1[2 * e - 4], bB = e < 2 ? b0[2 * e + 1] : b1[2 * e - 3];
                const float mA = rbflo(g1w[e]) * ((rbflo(yw[e]) - mu) * rs * gA + bA) + rbflo(g2w[e]) * rbflo(odw[e]);
                const float mB = rbfhi(g1w[e]) * ((rbfhi(yw[e]) - mu) * rs * gB + bB) + rbfhi(g2w[e]) * rbfhi(odw[e]);
                ow[e] = pg8::cvt_pk_bf16(mA, mB); }
            *(u32x4*)(merged + tok * D + col) = (u32x4){ow[0], ow[1], ow[2], ow[3]}; }
    }
    RET_BAR();
}
}

struct Args { const float* in[23]; float* out; unsigned char* ws; int ph_lo, ph_hi; };
#define LDS_WAIT() asm volatile("s_waitcnt lgkmcnt(0)" ::: "memory")
__device__ __forceinline__ float wsum(float v) {
#pragma unroll
    for (int o = 1; o < 64; o <<= 1) v += __shfl_xor(v, o);
    return v;
}
__device__ __forceinline__ unsigned pk2(float lo, float hi) { return pg8::cvt_pk_bf16(lo, hi); }
__device__ __forceinline__ float bflo(unsigned u) { return __builtin_bit_cast(float, u << 16); }
__device__ __forceinline__ float bfhi(unsigned u) { return __builtin_bit_cast(float, u & 0xffff0000u); }

template <bool F8>
__device__ __forceinline__ void transpose_item(const float* __restrict__ W, int K, int N, bf16* __restrict__ WT, LAS float* scr, int k0, int n0, int l0, int lane) {
    float wv[32];
#pragma unroll
    for (int i = 0; i < 32; ++i) wv[i] = __builtin_nontemporal_load(W + (size_t)(k0 + 2 * i + (lane >> 5)) * N + l0 + (lane & 31));
#pragma unroll
    for (int i = 0; i < 32; ++i) scr[(2 * i + (lane >> 5)) * 33 + (lane & 31)] = wv[i];
    LDS_WAIT(); asm volatile("" ::: "memory");
    const int c = lane & 7;
#pragma unroll
    for (int j = 0; j < 4; ++j) { const int n = (lane >> 3) + 8 * j; const LAS float* s = scr + (8 * c) * 33 + n;
        if constexpr (F8) { u32x2 o; o.x = pk4_fp8(s[0 * 33], s[1 * 33], s[2 * 33], s[3 * 33], (float)(1 << W_SH)); o.y = pk4_fp8(s[4 * 33], s[5 * 33], s[6 * 33], s[7 * 33], (float)(1 << W_SH));
            *(u32x2*)((unsigned char*)WT + (size_t)(n0 + n) * K + k0 + 8 * c) = o; }
        else { u32x4 o; o.x = pk2(s[0 * 33], s[1 * 33]); o.y = pk2(s[2 * 33], s[3 * 33]); o.z = pk2(s[4 * 33], s[5 * 33]); o.w = pk2(s[6 * 33], s[7 * 33]);
            *(u32x4*)(WT + (size_t)(n0 + n) * K + k0 + 8 * c) = o; } }
    LDS_WAIT(); asm volatile("" ::: "memory");
}

__device__ __forceinline__ void transpose_pair_f8(const float* __restrict__ Wa, const float* __restrict__ Wb, int K, int N, unsigned char* __restrict__ WTa, unsigned char* __restrict__ WTb, LAS float* scr,
                                                  int k0a, int n0a, int l0a, int k0b, int n0b, int l0b, int lane) {
    float wa[32], wb[32];
#pragma unroll
    for (int i = 0; i < 32; ++i) wa[i] = __builtin_nontemporal_load(Wa + (size_t)(k0a + 2 * i + (lane >> 5)) * N + l0a + (lane & 31));
#pragma unroll
    for (int i = 0; i < 32; ++i) wb[i] = __builtin_nontemporal_load(Wb + (size_t)(k0b + 2 * i + (lane >> 5)) * N + l0b + (lane & 31));
    const int c = lane & 7;
#pragma unroll
    for (int p = 0; p < 2; ++p) {
#pragma unroll
        for (int i = 0; i < 32; ++i) scr[(2 * i + (lane >> 5)) * 33 + (lane & 31)] = p ? wb[i] : wa[i];
        LDS_WAIT(); asm volatile("" ::: "memory");
        unsigned char* WT = p ? WTb : WTa; const int k0 = p ? k0b : k0a, n0 = p ? n0b : n0a;
#pragma unroll
        for (int j = 0; j < 4; ++j) { const int n = (lane >> 3) + 8 * j; const LAS float* s = scr + (8 * c) * 33 + n;
            u32x2 o; o.x = pk4_fp8(s[0 * 33], s[1 * 33], s[2 * 33], s[3 * 33], (float)(1 << W_SH)); o.y = pk4_fp8(s[4 * 33], s[5 * 33], s[6 * 33], s[7 * 33], (float)(1 << W_SH));
            *(u32x2*)(WT + (size_t)(n0 + n) * K + k0 + 8 * c) = o; }
        LDS_WAIT(); asm volatile("" ::: "memory");
    }
}

__device__ __forceinline__ void phase_prologue(const Args& args, unsigned char* ws, LAS unsigned char* lds, int vcu, int G) {
    const int tid = threadIdx.x, lane = tid & 63, wave = __builtin_amdgcn_readfirstlane(tid >> 6);
    const float* c = args.in[1]; const float* w_ada = args.in[2]; const float* b_ada = args.in[3]; float* mod = (float*)(ws + WS_MOD);
    for (int blk = vcu; blk < 96; blk += G) {
        LAS float* sc = (LAS float*)lds;
        LAS float* part = (LAS float*)(lds + 32768);
        for (int i = tid; i < NB * D; i += 512) { const float v = c[i]; sc[i] = v * fast_sigmoid(v); }
        __syncthreads();
        float acc[NB];
#pragma unroll
        for (int b = 0; b < NB; ++b) acc[b] = 0.f;
        const float* wp = w_ada + (size_t)(wave * 128) * 6144 + blk * 64 + lane;
        for (int k0 = 0; k0 < 128; k0 += 32) { float wv[32];
#pragma unroll
            for (int k = 0; k < 32; ++k) wv[k] = __builtin_nontemporal_load(wp + (size_t)(k0 + k) * 6144);
#pragma unroll
            for (int k = 0; k < 32; ++k)
#pragma unroll
                for (int b = 0; b < NB; ++b) acc[b] += sc[b * D + wave * 128 + k0 + k] * wv[k]; }
#pragma unroll
        for (int b = 0; b < NB; ++b) part[(wave * NB + b) * 64 + lane] = acc[b];
        __syncthreads();
        { const int b = tid >> 6; float s = b_ada[blk * 64 + lane];
#pragma unroll
            for (int w = 0; w < 8; ++w) s += part[(w * NB + b) * 64 + lane];
            mod[b * 6144 + blk * 64 + lane] = s; }
        __syncthreads();
    }
    if (vcu == (96 % G)) {
        bf16* wrt = (bf16*)(ws + WS_WRT); const float* wr = args.in[17];
        for (int i = tid; i < NE * D; i += 512) { const int e = i >> 10, k = i & 1023; const float w = wr[(size_t)k * NE + e]; const bf16 hb_ = f2bf(w); wrt[i] = hb_; wrt[NE * D + i] = f2bf(w - bf2f(hb_)); }
    }
    LAS float* scr = (LAS float*)(lds + wave * 16384);
    const int gw = vcu * 8 + wave, NGW = G * 8;
    constexpr int I_IN = (D / 64) * (INW / 32), I_OUT = (D / 64) * (D / 32), I_W1 = (D / 64) * (2048 / 32), I_W2 = (FF / 64) * (D / 32);
    constexpr int I_IN8 = IN_GATE_F8 ? (D / 64) * (12 * 8) : 0;
    for (int it = gw; it < I_IN8; it += NGW) { const int kb = it / 96, q = it % 96, tl = q >> 3, n0 = 256 * (tl < 8 ? 8 + tl : 20 + tl) + 32 * (q & 7);
        transpose_item<true>(args.in[5], D, INW, (bf16*)(ws + WS_WIN8), scr, 64 * kb, n0, in_p2l(n0), lane); }
    constexpr int NITEMS = I_IN + I_OUT + (MOE_W_IN_QUEUE ? 0 : NE * I_W1 + NE * I_W2);
    for (int it = gw; it < NITEMS; it += NGW) {
        int rr = it;
        if (rr < I_IN) { const int nblk = INW / 32, kb = rr / nblk, nb = rr % nblk; transpose_item<FP8_IN != 0>(args.in[5], D, INW, (bf16*)(ws + WS_WIN), scr, 64 * kb, 32 * nb, in_p2l(32 * nb), lane); continue; } rr -= I_IN;
        if (rr < I_OUT) { const int nblk = D / 32, kb = rr / nblk, nb = rr % nblk; transpose_item<FP8_OUT != 0>(args.in[15], D, D, (bf16*)(ws + WS_WOUT), scr, 64 * kb, 32 * nb, 32 * nb, lane); continue; } rr -= I_OUT;
        if (rr < NE * I_W1) { const int e = rr / I_W1, q = rr % I_W1, nblk = 2048 / 32, kb = q / nblk, nb = q % nblk;
            transpose_item<FP8_MOE != 0>(args.in[19] + (size_t)e * D * 2048, D, 2048, (bf16*)(ws + WS_W1 + (size_t)e * 2048 * D * (FP8_MOE ? 1 : 2)), scr, 64 * kb, 32 * nb, w1_p2l(32 * nb), lane); continue; } rr -= NE * I_W1;
        { const int e = rr / I_W2, q = rr % I_W2, nblk = D / 32, kb = q / nblk, nb = q % nblk;
            transpose_item<FP8_MOE != 0>(args.in[21] + (size_t)e * FF * D, FF, D, (bf16*)(ws + WS_W2 + (size_t)e * D * FF * (FP8_MOE ? 1 : 2)), scr, 64 * kb, 32 * nb, 32 * nb, lane); }
    }
}

__device__ __forceinline__ void moe_w_item(const Args& args, unsigned char* ws, LAS float* scr, int rr, int lane) {
    constexpr int I_W1 = (D / 64) * (2048 / 32), I_W2 = (FF / 64) * (D / 32);
    if (rr < NE * I_W1) { const int e = rr / I_W1, q = rr % I_W1, nblk = 2048 / 32, kb = q / nblk, nb = q % nblk;
        transpose_item<FP8_MOE != 0>(args.in[19] + (size_t)e * D * 2048, D, 2048, (bf16*)(ws + WS_W1 + (size_t)e * 2048 * D * (FP8_MOE ? 1 : 2)), scr, 64 * kb, 32 * nb, w1_p2l(32 * nb), lane); return; }
    rr -= NE * I_W1;
    { const int e = rr / I_W2, q = rr % I_W2, nblk = D / 32, kb = q / nblk, nb = q % nblk;
        transpose_item<FP8_MOE != 0>(args.in[21] + (size_t)e * FF * D, FF, D, (bf16*)(ws + WS_W2 + (size_t)e * D * FF * (FP8_MOE ? 1 : 2)), scr, 64 * kb, 32 * nb, 32 * nb, lane); }
}

__device__ __forceinline__ void moe_w_pair(const Args& args, unsigned char* ws, LAS float* scr, int pr, int lane) {
    constexpr int I_W1 = (D / 64) * (2048 / 32), I_W2 = (FF / 64) * (D / 32);
    int rr = 2 * pr;
    if (rr < NE * I_W1) { const int e = rr / I_W1, q = rr % I_W1, nblk = 2048 / 32, kb = q / nblk, nb = q % nblk; const float* W = args.in[19] + (size_t)e * D * 2048; unsigned char* WT = ws + WS_W1 + (size_t)e * 2048 * D;
        transpose_pair_f8(W, W, D, 2048, WT, WT, scr, 64 * kb, 32 * nb, w1_p2l(32 * nb), 64 * kb, 32 * (nb + 1), w1_p2l(32 * (nb + 1)), lane); return; }
    rr -= NE * I_W1;
    { const int e = rr / I_W2, q = rr % I_W2, nblk = D / 32, kb = q / nblk, nb = q % nblk; const float* W = args.in[21] + (size_t)e * FF * D; unsigned char* WT = ws + WS_W2 + (size_t)e * D * FF;
        transpose_pair_f8(W, W, FF, D, WT, WT, scr, 64 * kb, 32 * nb, 32 * nb, 64 * kb, 32 * (nb + 1), 32 * (nb + 1), lane); }
}

__device__ __forceinline__ void modnorm_row(const float* __restrict__ xrow, const float* __restrict__ g, const float* __restrict__ sc, const float* __restrict__ sh, bf16* __restrict__ orow, int lane, f32x4 (&v)[4]) {
    float ss = 0.f;
#pragma unroll
    for (int i = 0; i < 4; ++i) { v[i] = *(const f32x4*)(xrow + 4 * lane + 256 * i); ss += (v[i][0] * v[i][0] + v[i][1] * v[i][1]) + (v[i][2] * v[i][2] + v[i][3] * v[i][3]); }
    const float rs = __builtin_amdgcn_rsqf(wsum(ss) * (1.f / D) + EPS);
#pragma unroll
    for (int i = 0; i < 4; ++i) { const int cc = 4 * lane + 256 * i; const f32x4 gg = *(const f32x4*)(g + cc), s1 = *(const f32x4*)(sc + cc), s0 = *(const f32x4*)(sh + cc);
        v[i] = v[i] * rs * gg * (s1 + 1.f) + s0;
        u32x2 o; o.x = pk2(v[i][0], v[i][1]); o.y = pk2(v[i][2], v[i][3]); *(u32x2*)(orow + cc) = o; }
}
template <bool TILE, bool F8, bool XBF = false>
__device__ __forceinline__ void modnorm4(const float* __restrict__ xr, const float* __restrict__ g, const float* __restrict__ sc, const float* __restrict__ sh, bf16* __restrict__ orow, LAS unsigned char* tile, int rtp, int lane, unsigned char* __restrict__ orow8 = nullptr) {
    f32x4 v[4][4];
#pragma unroll
    for (int j = 0; j < 4; ++j)
#pragma unroll
        for (int i = 0; i < 4; ++i) { if constexpr (XBF) { const u32x2 w = *(const u32x2*)((const bf16*)xr + (size_t)j * D + 4 * lane + 256 * i); v[j][i] = (f32x4){bflo(w.x), bfhi(w.x), bflo(w.y), bfhi(w.y)}; }
            else v[j][i] = *(const f32x4*)(xr + (size_t)j * D + 4 * lane + 256 * i); }
    f32x4 gg[4], s1[4], s0[4];
#pragma unroll
    for (int i = 0; i < 4; ++i) { const int cc = 4 * lane + 256 * i; gg[i] = *(const f32x4*)(g + cc); s1[i] = *(const f32x4*)(sc + cc) + 1.f; s0[i] = *(const f32x4*)(sh + cc); gg[i] = gg[i] * s1[i]; }
#pragma unroll
    for (int j = 0; j < 4; ++j) { float ss = 0.f;
#pragma unroll
        for (int i = 0; i < 4; ++i) ss += (v[j][i][0] * v[j][i][0] + v[j][i][1] * v[j][i][1]) + (v[j][i][2] * v[j][i][2] + v[j][i][3] * v[j][i][3]);
        const float rs = __builtin_amdgcn_rsqf(wsum(ss) * (1.f / D) + EPS);
#pragma unroll
        for (int i = 0; i < 4; ++i) { const int cc = 4 * lane + 256 * i; const f32x4 o = v[j][i] * rs * gg[i] + s0[i];
            u32x2 pk; pk.x = pk2(o[0], o[1]); pk.y = pk2(o[2], o[3]);
            if constexpr (F8) *(unsigned*)((unsigned char*)orow + (size_t)j * D + cc) = pk4_fp8(o[0], o[1], o[2], o[3], (float)(1 << A_SH));
            else *(u32x2*)(orow + (size_t)j * D + cc) = pk;
            if (orow8) *(unsigned*)(orow8 + (size_t)j * D + cc) = pk4_fp8(o[0], o[1], o[2], o[3], (float)(1 << A_SH));
            if constexpr (TILE) *(LAS u32x2*)(tile + j * rtp + cc * 2) = pk; } }
}
__device__ __forceinline__ void phase_h1(const Args& args, unsigned char* ws, int vcu, int G) {
    const int lane = threadIdx.x & 63, wave = __builtin_amdgcn_readfirstlane(threadIdx.x >> 6); const float* mod = (const float*)(ws + WS_MOD); bf16* hb = (bf16*)(ws + WS_H);
    for (int t = (vcu * 8 + wave) * 4; t < T; t += G * 32) { const int b = t / S;
        modnorm4<false, FP8_IN != 0>(args.in[0] + (size_t)t * D, args.in[4], mod + b * 6144 + 1024, mod + b * 6144, (bf16*)((unsigned char*)hb + (size_t)t * D * (FP8_IN ? 1 : 2)), nullptr, 0, lane, IN_GATE_F8 ? ws + WS_H8 + (size_t)t * D : nullptr); }
}

__device__ __forceinline__ void phase_merge(const Args& args, unsigned char* ws, int vcu, int G) {
    const int lane = threadIdx.x & 63, wave = __builtin_amdgcn_readfirstlane(threadIdx.x >> 6);
    const bf16* proj = (const bf16*)(ws + WS_PROJ); const bf16* yret = (const bf16*)(ws + WS_YRET); const bf16* odiff = (const bf16*)(ws + WS_ODIFF); bf16* merged = (bf16*)(ws + WS_MRG);
    const float* ggn = args.in[6]; const float* bgn = args.in[7];
    f32x4 gg[4], bb[4];
#pragma unroll
    for (int i = 0; i < 4; ++i) { gg[i] = *(const f32x4*)(ggn + 4 * lane + 256 * i); bb[i] = *(const f32x4*)(bgn + 4 * lane + 256 * i); }
    constexpr int TB = 2;
    for (int t = (vcu * 8 + wave) * TB; t < T; t += G * 8 * TB) {
        u32x2 yy[TB][4], rg[TB][4], md[TB][4], od[TB][4];
#pragma unroll
        for (int j = 0; j < TB; ++j) { const bf16* prg = proj + PO_RG + (size_t)(t + j) * 1024; const bf16* pmg = proj + PO_MG + (size_t)(t + j) * 1024;
#pragma unroll
            for (int i = 0; i < 4; ++i) { const int cc = 4 * lane + 256 * i;
                yy[j][i] = *(const u32x2*)(yret + (size_t)(t + j) * D + cc); od[j][i] = *(const u32x2*)(odiff + (size_t)(t + j) * D + cc);
                rg[j][i] = *(const u32x2*)(prg + cc); md[j][i] = *(const u32x2*)(pmg + (size_t)T * 1024 + cc); } }
#pragma unroll
        for (int j = 0; j < TB; ++j)
#pragma unroll
            for (int i = 0; i < 4; ++i) { const int cc = 4 * lane + 256 * i;
                float y[4] = {bflo(yy[j][i].x), bfhi(yy[j][i].x), bflo(yy[j][i].y), bfhi(yy[j][i].y)};
                const float mu = wsum((y[0] + y[1]) + (y[2] + y[3])) * (1.f / 256);
                float vv = 0.f;
#pragma unroll
                for (int e = 0; e < 4; ++e) { y[e] -= mu; vv += y[e] * y[e]; }
                const float rs = __builtin_amdgcn_rsqf(wsum(vv) * (1.f / 256) + EPS);
                const float rgv[4] = {bflo(rg[j][i].x), bfhi(rg[j][i].x), bflo(rg[j][i].y), bfhi(rg[j][i].y)};
                const float mdv[4] = {bflo(md[j][i].x), bfhi(md[j][i].x), bflo(md[j][i].y), bfhi(md[j][i].y)}, odv[4] = {bflo(od[j][i].x), bfhi(od[j][i].x), bflo(od[j][i].y), bfhi(od[j][i].y)};
                float m[4];
#pragma unroll
                for (int e = 0; e < 4; ++e) m[e] = rgv[e] * (y[e] * rs * gg[i][e] + bb[i][e]) + mdv[e] * odv[e];
                if (FP8_OUT) *(unsigned*)((unsigned char*)merged + (size_t)(t + j) * D + cc) = pk4_fp8(m[0], m[1], m[2], m[3], (float)(1 << A_SH));
                else { u32x2 o; o.x = pk2(m[0], m[1]); o.y = pk2(m[2], m[3]); *(u32x2*)(merged + (size_t)(t + j) * D + cc) = o; } }
    }
}

constexpr int RT_PITCH = 2064;
constexpr int RT_H = 0, RT_P = 32 * RT_PITCH, RT_L = RT_P + 8 * 32 * 32 * 4, RT_CNT = RT_L + 128 * 33 * 4, RT_SEL = RT_CNT + 128;
static_assert(RT_SEL + 2048 <= LDS_STAGE_BYTES, "route LDS map");
__device__ __forceinline__ void phase_route(const Args& args, unsigned char* ws, LAS unsigned char* lds, int vcu, int G) {
    const int tid = threadIdx.x, lane = tid & 63, r = lane & 31, hi = lane >> 5, wave = __builtin_amdgcn_readfirstlane(tid >> 6);
    const float* mod = (const float*)(ws + WS_MOD); bf16* h2 = (bf16*)(ws + WS_H); unsigned* ctl = (unsigned*)(ws + WS_CTL);
    int* tok_e = (int*)(ws + WS_ROUTE); int* tok_pos = tok_e + T * 4; float* tok_w = (float*)(tok_pos + T * 4); int* list = (int*)(ws + WS_LIST);
    const bf16* wrt = (const bf16*)(ws + WS_WRT); const float* br = args.in[18];
    LAS unsigned* lcnt = (LAS unsigned*)(lds + RT_CNT); LAS unsigned* lsel = (LAS unsigned*)(lds + RT_SEL); LAS float* P = (LAS float*)(lds + RT_P); LAS float* L = (LAS float*)(lds + RT_L);
    bf16x8 bh[8], bl[8];
#pragma unroll
    for (int ks = 0; ks < 8; ++ks) { bh[ks] = *(const bf16x8*)(wrt + (size_t)r * D + 128 * wave + 16 * ks + 8 * hi); bl[ks] = *(const bf16x8*)(wrt + (size_t)(NE + r) * D + 128 * wave + 16 * ks + 8 * hi); }
    for (int t0 = vcu * 128; t0 < T; t0 += G * 128) {
        const int b = t0 / S;
        if (tid < NE) lcnt[tid] = 0u;
        const bf16* x1b = (const bf16*)(ws + WS_X1B); const float* sc2 = mod + b * 6144 + 4096; const float* sh2 = mod + b * 6144 + 3072;
        f32x4 gg[4], s0[4];
#pragma unroll
        for (int i = 0; i < 4; ++i) { const int cc = 4 * lane + 256 * i; gg[i] = *(const f32x4*)(args.in[16] + cc) * (*(const f32x4*)(sc2 + cc) + 1.f); s0[i] = *(const f32x4*)(sh2 + cc); }
        u32x2 xr[4][4];
#define RT_LOADX(sbi_) do { const size_t tr_ = (size_t)(t0 + 32 * (sbi_) + 4 * wave); _Pragma("unroll") for (int j = 0; j < 4; ++j) _Pragma("unroll") for (int i = 0; i < 4; ++i) \
            xr[j][i] = *(const u32x2*)(x1b + (tr_ + j) * D + 4 * lane + 256 * i); } while (0)
        RT_LOADX(0);
        for (int sbi = 0; sbi < 4; ++sbi) {
            { const int tl = 4 * wave; const size_t tr = (size_t)(t0 + 32 * sbi + tl);
#pragma unroll
                for (int j = 0; j < 4; ++j) { f32x4 v[4]; float ss = 0.f;
#pragma unroll
                    for (int i = 0; i < 4; ++i) { v[i] = (f32x4){bflo(xr[j][i].x), bfhi(xr[j][i].x), bflo(xr[j][i].y), bfhi(xr[j][i].y)};
                        ss += (v[i][0] * v[i][0] + v[i][1] * v[i][1]) + (v[i][2] * v[i][2] + v[i][3] * v[i][3]); }
                    const float rs = __builtin_amdgcn_rsqf(wsum(ss) * (1.f / D) + EPS);
#pragma unroll
                    for (int i = 0; i < 4; ++i) { const int cc = 4 * lane + 256 * i; const f32x4 o = v[i] * rs * gg[i] + s0[i];
                        u32x2 pk; pk.x = pk2(o[0], o[1]); pk.y = pk2(o[2], o[3]);
                        if (FP8_MOE) *(unsigned*)((unsigned char*)h2 + (tr + j) * D + cc) = pk4_fp8(o[0], o[1], o[2], o[3], (float)(1 << A_SH));
                        else *(u32x2*)(h2 + (tr + j) * D + cc) = pk;
                        *(LAS u32x2*)(lds + RT_H + (tl + j) * RT_PITCH + cc * 2) = pk; } } }
            if (sbi < 3) RT_LOADX(sbi + 1);
            __syncthreads();
            { f32x16 acc;
#pragma unroll
                for (int q = 0; q < 16; ++q) acc[q] = 0.f;
#pragma unroll
                for (int ks = 0; ks < 8; ++ks) { const bf16x8 a = *(const LAS bf16x8*)(lds + RT_H + r * RT_PITCH + (128 * wave + 16 * ks + 8 * hi) * 2);
                    acc = __builtin_amdgcn_mfma_f32_32x32x16_bf16(a, bh[ks], acc, 0, 0, 0); acc = __builtin_amdgcn_mfma_f32_32x32x16_bf16(a, bl[ks], acc, 0, 0, 0); }
#pragma unroll
                for (int q = 0; q < 16; ++q) P[(wave * 32 + crow(q, hi)) * 32 + r] = acc[q]; }
            __syncthreads();
#pragma unroll
            for (int u = 0; u < 2; ++u) { const int idx = tid + 512 * u, tk = idx >> 5, e = idx & 31; float s = br[e];
#pragma unroll
                for (int w = 0; w < 8; ++w) s += P[(w * 32 + tk) * 32 + e];
                L[(32 * sbi + tk) * 33 + e] = s; }
        }
#undef RT_LOADX
        __syncthreads();
        if (tid < 128) { const int t = t0 + tid;
            float lg[NE];
#pragma unroll
            for (int e = 0; e < NE; ++e) lg[e] = L[tid * 33 + e];
            unsigned used = 0u; float tv0 = 0.f, den = 0.f; float wv[TOPK]; int ev[TOPK];
#pragma unroll
            for (int k = 0; k < TOPK; ++k) { float best = -INFINITY; int bi = 0;
#pragma unroll
                for (int e = 0; e < NE; ++e) { const bool ok = !((used >> e) & 1u) && lg[e] > best; best = ok ? lg[e] : best; bi = ok ? e : bi; }
                used |= 1u << bi; if (k == 0) tv0 = best; wv[k] = __expf(best - tv0); den += wv[k]; ev[k] = bi; }
            const float rden = 1.f / den;
#pragma unroll
            for (int k = 0; k < TOPK; ++k) { const unsigned lp = atomicAdd((unsigned*)&lcnt[ev[k]], 1u);
                lsel[tid * 4 + k] = ((unsigned)ev[k] << 16) | lp; tok_e[t * 4 + k] = ev[k]; tok_w[t * 4 + k] = wv[k] * rden; } }
        __syncthreads();
        if (tid < NE) { const unsigned n = lcnt[tid]; lcnt[tid] = n ? atomicAdd(&ctl[CW_CNT + tid], n) : 0u; }
        __syncthreads();
        { const unsigned s = lsel[tid]; const int e = (int)(s >> 16); const int pos = (int)(lcnt[e] + (s & 0xffffu)); const int t = t0 + (tid >> 2);
            tok_pos[t * 4 + (tid & 3)] = pos; list[(size_t)e * T + pos] = t; }
        __syncthreads();
    }
}

__device__ __forceinline__ void phase_scan(unsigned char* ws, int vcu, int G) {
    const bf16* ubuf = (const bf16*)(ws + WS_H); bf16* rbbuf = (bf16*)(ws + WS_MERGED);
    for (int task = vcu * 512 + (int)threadIdx.x; task < 32 * 4096; task += G * 512) {
        const int bh = task >> 12, e8 = task & 4095, h = bh & 3;
        const float lg = __builtin_amdgcn_logf(1.f - __builtin_amdgcn_exp2f(-5.f - (float)h));
        const float gam = __builtin_amdgcn_exp2f(lg), gC = __builtin_amdgcn_exp2f(lg * 128.f), gC1 = __builtin_amdgcn_exp2f(lg * 127.f);
        const bf16* up = ubuf + (size_t)bh * 32 * 32768 + e8 * 8; bf16* rp = rbbuf + (size_t)bh * 32 * 32768 + e8 * 8;
        float R[8];
#pragma unroll
        for (int i = 0; i < 8; ++i) R[i] = 0.f;
        for (int j0 = 0; j0 < 32; j0 += 8) {
            u32x4 uv[8];
#pragma unroll
            for (int jj = 0; jj < 8; ++jj) uv[jj] = *(const u32x4*)(up + (size_t)(j0 + jj) * 32768);
#pragma unroll
            for (int jj = 0; jj < 8; ++jj) {
                u32x4 o; o.x = pk2(R[0] * gam, R[1] * gam); o.y = pk2(R[2] * gam, R[3] * gam); o.z = pk2(R[4] * gam, R[5] * gam); o.w = pk2(R[6] * gam, R[7] * gam);
                *(u32x4*)(rp + (size_t)(j0 + jj) * 32768) = o;
#pragma unroll
                for (int q = 0; q < 4; ++q) { R[2 * q] = gC * R[2 * q] + gC1 * bflo(uv[jj][q]); R[2 * q + 1] = gC * R[2 * q + 1] + gC1 * bfhi(uv[jj][q]); } }
        }
    }
}

__device__ __forceinline__ int build_expert_tables(const unsigned* ctl, LAS unsigned* rbtab, LAS unsigned* rbfirst) {
    if (threadIdx.x < 64) {
        const int e = threadIdx.x & 31; const unsigned c = __hip_atomic_load(&ctl[CW_CNT + e], __ATOMIC_RELAXED, __HIP_MEMORY_SCOPE_AGENT), nb = (c + 255u) >> 8;
        unsigned inc = nb;
#pragma unroll
        for (int o = 1; o < 32; o <<= 1) { const unsigned t = __shfl_up(inc, o, 32); inc += (e >= o) ? t : 0u; }
        const unsigned rb = inc - nb;
        if (threadIdx.x < 32) { rbfirst[e] = rb; if (e == NE - 1) rbfirst[NE] = inc; for (unsigned i = 0; i < nb; ++i) rbtab[rb + i] = (unsigned)e; } }
    __syncthreads();
    return __builtin_amdgcn_readfirstlane((int)rbfirst[NE]);
}

__device__ __forceinline__ void phase_combine(const Args& args, unsigned char* ws, const LAS unsigned* rbfirst, int vcu, int G) {
    const int lane = threadIdx.x & 63, wave = __builtin_amdgcn_readfirstlane(threadIdx.x >> 6);
    const float* mod = (const float*)(ws + WS_MOD); const unsigned char* eo = ws + WS_EO; const bf16* x1b = (const bf16*)(ws + WS_X1B);
    const int* tok_e = (const int*)(ws + WS_ROUTE); const int* tok_pos = tok_e + T * 4; const float* tok_w = (const float*)(tok_pos + T * 4);
    constexpr int TB = 2; constexpr float ESC = 1.f / (float)(1 << E_SH);
    typedef float f32x2_t __attribute__((ext_vector_type(2)));
    for (int t = (vcu * 8 + wave) * TB; t < T; t += G * 8 * TB) { const int b = t / S;
        const unsigned char* rp[TB][TOPK]; float w[TB][TOPK];
#pragma unroll
        for (int j = 0; j < TB; ++j)
#pragma unroll
            for (int k = 0; k < TOPK; ++k) { const int e = tok_e[(t + j) * 4 + k]; rp[j][k] = eo + ((size_t)rbfirst[e] * 256 + tok_pos[(t + j) * 4 + k]) * D; w[j][k] = tok_w[(t + j) * 4 + k] * ESC; }
        unsigned ev[TB][TOPK][4]; u32x2 xv[TB][4];
#pragma unroll
        for (int j = 0; j < TB; ++j)
#pragma unroll
            for (int i = 0; i < 4; ++i) { const int cc = 4 * lane + 256 * i; xv[j][i] = *(const u32x2*)(x1b + (size_t)(t + j) * D + cc);
#pragma unroll
                for (int k = 0; k < TOPK; ++k) ev[j][k][i] = *(const unsigned*)(rp[j][k] + cc); }
#pragma unroll
        for (int i = 0; i < 4; ++i) { const int cc = 4 * lane + 256 * i; const f32x4 gt = *(const f32x4*)(mod + b * 6144 + 5120 + cc);
#pragma unroll
            for (int j = 0; j < TB; ++j) { f32x4 y = {0.f, 0.f, 0.f, 0.f};
#pragma unroll
                for (int k = 0; k < TOPK; ++k) { const f32x2_t lo = __builtin_amdgcn_cvt_pk_f32_fp8((int)ev[j][k][i], false), hi2 = __builtin_amdgcn_cvt_pk_f32_fp8((int)ev[j][k][i], true);
                    y[0] += w[j][k] * lo[0]; y[1] += w[j][k] * lo[1]; y[2] += w[j][k] * hi2[0]; y[3] += w[j][k] * hi2[1]; }
                const f32x4 x1 = (f32x4){bflo(xv[j][i].x), bfhi(xv[j][i].x), bflo(xv[j][i].y), bfhi(xv[j][i].y)};
                *(f32x4*)(args.out + (size_t)(t + j) * D + cc) = x1 + gt * y; } }
    }
}

enum Phase { PH_PRO = 0, PH_H1 = 1, PH_INPROJ = 2, PH_MIX = 3, PH_MERGE = 4, PH_OUTPROJ = 5, PH_ROUTE = 6, PH_MOE1 = 7, PH_MOE2 = 8, PH_COMB = 9, PH_END = 10 };
constexpr int CW_BAR = 4096;
__global__ void __launch_bounds__(512, 2) mk_fwd(Args args) {
    extern __shared__ __attribute__((aligned(16))) unsigned char lds_raw[];
    LAS unsigned char* lds = (LAS unsigned char*)lds_raw;
    volatile LAS unsigned* MISC = (volatile LAS unsigned*)(lds + LDS_MISC);
    const int tid = threadIdx.x, G = gridDim.x;
    const int vcu = (G % 8 == 0) ? ((int)blockIdx.x % 8) * (G / 8) + (int)blockIdx.x / 8 : (int)blockIdx.x;
    unsigned char* ws = args.ws; unsigned* ctl = (unsigned*)(ws + WS_CTL);
    const float* mod = (const float*)(ws + WS_MOD);
    bf16* hb = (bf16*)(ws + WS_H); bf16* proj = (bf16*)(ws + WS_PROJ); bf16* merged = (bf16*)(ws + WS_MRG);
    bf16* win_t = (bf16*)(ws + WS_WIN); bf16* wout_t = (bf16*)(ws + WS_WOUT); bf16* w1t = (bf16*)(ws + WS_W1); bf16* w2t = (bf16*)(ws + WS_W2);
    bf16* act = (bf16*)(ws + WS_ACT); bf16* eo = (bf16*)(ws + WS_EO); const int* list = (const int*)(ws + WS_LIST);
    for (int u = tid; u < 64; u += 512) MISC[u] = 0u;
    __syncthreads();
    const int lo = args.ph_lo, hi = args.ph_hi;
    XcdBarrier bar = xcd_barrier_post(ctl + CW_BAR, MISC + 8);
#define IN(k) (lo <= (k) && (k) < hi)
#define SEAM(k) do { if (IN(k) && IN((k) + 1)) xcd_barrier(bar); } while (0)
    LAS unsigned* gtab = (LAS unsigned*)(lds + LDS_GTAB); LAS unsigned* rbtab = (LAS unsigned*)(lds + LDS_RB2E); LAS float* gqk = (LAS float*)(lds + LDS_GQK); LAS unsigned* rbfirst = (LAS unsigned*)(lds + LDS_RBF);

    if (IN(PH_PRO)) { phase_prologue(args, ws, lds, vcu, G); __syncthreads(); }
    SEAM(PH_PRO);
    if (IN(PH_H1)) phase_h1(args, ws, vcu, G);
    SEAM(PH_H1);
    if (IN(PH_INPROJ)) {
        if (tid < 64) gqk[tid] = args.in[8][tid] * C2; else if (tid < 128) gqk[tid] = args.in[9][tid - 64];
        __syncthreads();
        EpiIn E{proj, gqk};
        if (IN_GATE_F8) {
            struct MapOrder { pg8::StaticOrder s; int split, add0, add1;
                __device__ bool next(int i, pg8::GUnit& u) const { const bool r = s.next(i, u); u.pn += u.pn < split ? add0 : add1; return r; } };
            MapOrder Sa; Sa.s.init(T / 256, 20, G, (int)blockIdx.x, nullptr, nullptr); Sa.split = 8; Sa.add0 = 0; Sa.add1 = 8;
            pg8::gemm_phase<EpiIn, MapOrder, false, false>(lds + LDS_STAGE, hb, win_t, 0, D, Sa, E, nullptr, gtab, 127 - A_SH, 127 - W_SH);
            MapOrder Sb; Sb.s.init(T / 256, 12, G, (int)blockIdx.x, nullptr, nullptr); Sb.split = 8; Sb.add0 = 8; Sb.add1 = 20;
            pg8::gemm_phase<EpiIn, MapOrder, false, true>(lds + LDS_STAGE, ws + WS_H8, ws + WS_WIN8, 0, D, Sb, E, nullptr, gtab, 127 - A_SH, 127 - W_SH);
        } else {
        pg8::StaticOrder So; So.init(T / 256, INW / 256, G, (int)blockIdx.x, nullptr, nullptr);
        pg8::gemm_phase<EpiIn, pg8::StaticOrder, false, FP8_IN != 0>(lds + LDS_STAGE, hb, win_t, 0, D, So, E, nullptr, gtab, 127 - A_SH, 127 - W_SH);
        }
    }
    SEAM(PH_INPROJ);
    if (IN(PH_MIX)) {
        float a1 = 0.f, a2 = 0.f, gm = 0.f;
        for (int d = 0; d < 64; ++d) { a1 += args.in[10][d] * args.in[11][d]; a2 += args.in[12][d] * args.in[13][d]; gm = fmaxf(gm, fabsf(args.in[8][d] * args.in[9][d])); }
        const float lam = __expf(a1) - __expf(a2) + LAMBDA_INIT;
        bf16* odiff = (bf16*)(ws + WS_ODIFF);
        const float w2 = 2.f * 8.f * gm * LOG2E * 1.03f + 32.f;
        LAS unsigned* cost = (LAS unsigned*)(lds + LDS_RB2E); LAS unsigned* order = cost + 256;
        if (tid >= 256 && tid < 384) ((LAS float*)(lds + att::LDS_GSUB))[tid - 256] = args.in[14][tid - 256];
        if (tid < 256) { const int h = tid >> 5, qb = tid & 31; const float slope2 = __builtin_amdgcn_exp2f(-(float)(h + 1)) * LOG2E;
            const float x = (float)(128 * qb - 63) - w2 / slope2; const int t_lo = x <= 0.f ? 0 : (int)ceilf(x * (1.f / 64.f));
            cost[tid] = (unsigned)(2 * qb + 2 - t_lo) | ((unsigned)t_lo << 16); }
        __syncthreads();
        if (tid < 256) { const unsigned mine = cost[tid] & 0xffffu; int rank = 0;
            for (int k = 0; k < 256; ++k) { const unsigned ck = cost[k] & 0xffffu; rank += (ck > mine || (ck == mine && k < tid)) ? 1 : 0; }
            order[rank] = (unsigned)tid | (cost[tid] & 0xffff0000u); }
        __syncthreads();
        static_assert(MOE_W_IN_QUEUE == 1, "the mixer queue carries the expert-weight items");
        constexpr unsigned NR1 = 1024u, NITEMS = NR1 + 2048u;
#ifndef MIX_REPS
#define MIX_REPS 1
#endif
        for (int rep = 0; rep < MIX_REPS; ++rep) {
        if (rep) xcd_barrier(bar);
        unsigned* qhead = &ctl[CW_Q + 64 * rep];
        unsigned n1 = 0u, n2 = 0u; bool prev_att = false; bf16x8 qn0 = {}, qn1 = {}, qn2 = {}, qn3 = {};
        if (tid == 0) { n1 = atomicAdd(qhead, 1u); n2 = atomicAdd(qhead, 1u); }
        for (;;) {
            if (tid == 0) { MISC[16] = n1; MISC[17] = n2; }
            __syncthreads();
            const unsigned item = MISC[16], nitem = MISC[17];
            if (item >= NITEMS) break;
            if (tid == 0) { n1 = n2; n2 = atomicAdd(qhead, 1u); }
            if (item < NR1) { ret::r1_unit((int)(item >> 7), (int)((item >> 5) & 3u), (int)(item & 31u), proj, (bf16*)(ws + WS_H), lds); prev_att = false; qn0 = (bf16x8){}; qn1 = (bf16x8){}; qn2 = (bf16x8){}; qn3 = (bf16x8){}; }
            else { const unsigned u = item - NR1, c0 = 3u * (u >> 1) + (u & 1u), nc = 1u + (u & 1u);
                for (unsigned k = 0; k < nc; ++k) moe_w_pair(args, ws, (LAS float*)(lds + (tid >> 6) * 12288), (int)((c0 + k) * 8u + (unsigned)(tid >> 6)), tid & 63);
                __syncthreads();
                const unsigned oc = order[u >> 3]; const int cls = (int)(oc & 0xffffu);
                const bool nvalid = nitem >= NR1 && nitem < NITEMS; const unsigned nu = nvalid ? nitem - NR1 : 0u; const int ncls = (int)(order[nu >> 3] & 0xffffu);
                att::unit((int)(u & 7u), cls >> 5, cls & 31, (int)(oc >> 16), proj, odiff, lds, lam, args.in[14], prev_att, nvalid, (int)(nu & 7u), ncls >> 5, ncls & 31, qn0, qn1, qn2, qn3);
                prev_att = nvalid; }
        }
        __syncthreads();
        xcd_barrier(bar);
        phase_scan(ws, vcu, G);
        xcd_barrier(bar);
        if (FUSE_MERGE) {
            for (int u = vcu * 4; u < 1024; u += G * 4)
                for (int k = 0; k < 4; ++k) { const int id = u + k; ret::r3m_unit(id >> 7, (id >> 5) & 3, id & 31, proj, (const bf16*)(ws + WS_MERGED), odiff, (bf16*)(ws + WS_MRG), args.in[6], args.in[7], lds); }
        } else
        for (int u = vcu * 8; u < 2048; u += G * 8)
            for (int k = 0; k < 8; ++k) { const int id = u + k; ret::r3_unit(id >> 8, (id >> 6) & 3, (id >> 1) & 31, id & 1, proj, (const bf16*)(ws + WS_MERGED), (bf16*)(ws + WS_YRET), lds); }
        }
    }
    SEAM(PH_MIX);
    if (!FUSE_MERGE) { if (IN(PH_MERGE)) phase_merge(args, ws, vcu, G);
        SEAM(PH_MERGE); }
    if (IN(PH_OUTPROJ)) {
        pg8::StaticOrder So; So.init(T / 256, D / 256, G, (int)blockIdx.x, nullptr, nullptr);
        EpiOutF E{args.in[0], mod, (bf16*)(ws + WS_X1B)};
        pg8::gemm_phase<EpiOutF, pg8::StaticOrder, false, FP8_OUT != 0>(lds + LDS_STAGE, merged, wout_t, 0, D, So, E, nullptr, gtab, 127 - A_SH, 127 - W_SH);
    }
    SEAM(PH_OUTPROJ);
    if (IN(PH_ROUTE)) { phase_route(args, ws, lds, vcu, G); }
    SEAM(PH_ROUTE);
    if (IN(PH_MOE1)) {
        const int nrb = build_expert_tables(ctl, rbtab, rbfirst);
        pg8::StaticOrder So; So.init(nrb, 2048 / 256, G, (int)blockIdx.x, rbtab, rbfirst);
        LAS float* btab = (LAS float*)(lds + LDS_BTAB);
        EpiActF E{btab, act};
        pg8::gemm_phase<EpiActF, pg8::StaticOrder, true, FP8_MOE != 0, 1>(lds + LDS_STAGE, hb, w1t, (size_t)2048 * D * (FP8_MOE ? 1 : 2), D, So, E, list, gtab, 127 - A_SH, 127 - W_SH, args.in[20], btab);
    }
    SEAM(PH_MOE1);
    if (IN(PH_MOE2)) {
        const int nrb = build_expert_tables(ctl, rbtab, rbfirst);
        pg8::StaticOrder So; So.init(nrb, D / 256, G, (int)blockIdx.x, rbtab, rbfirst);
        LAS float* btab = (LAS float*)(lds + LDS_BTAB);
        EpiEOF E{btab, eo};
        pg8::gemm_phase<EpiEOF, pg8::StaticOrder, false, FP8_MOE != 0, 2, 1>(lds + LDS_STAGE, act, w2t, (size_t)D * FF * (FP8_MOE ? 1 : 2), FF, So, E, nullptr, gtab, 127 - A_SH, 127 - W_SH, args.in[22], btab);
    }
    SEAM(PH_MOE2);
    if (IN(PH_COMB)) { (void)build_expert_tables(ctl, rbtab, rbfirst); phase_combine(args, ws, rbfirst, vcu, G); }
#undef IN
#undef SEAM
}

static int g_grid = 0;
static void launch_phases(Args a, int lo, int hi, hipStream_t stream) {
    a.ph_lo = lo; a.ph_hi = hi;
    hipLaunchKernelGGL(mk_fwd, dim3(g_grid), dim3(512), LDS_BYTES, stream, a);
}
extern "C" void kernel_launch(void* const* d_in, const int* in_sizes, int n_in, void* d_out, int out_size, void* d_ws, size_t ws_size, hipStream_t stream) {
    if (n_in != 23 || ws_size < WS_END) { fprintf(stderr, "kernel_launch: unexpected inputs/workspace (%d, %zu)\n", n_in, ws_size); }
    unsigned char* ws = (unsigned char*)d_ws; float* out = (float*)d_out;

    if (g_grid == 0) {
        int dev = 0, cus = 0;
        if (hipGetDevice(&dev) != hipSuccess || hipDeviceGetAttribute(&cus, hipDeviceAttributeMultiprocessorCount, dev) != hipSuccess) { fprintf(stderr, "kernel_launch: device query failed\n"); g_grid = -1; return; }
        if (hipFuncSetAttribute((const void*)mk_fwd, hipFuncAttributeMaxDynamicSharedMemorySize, LDS_BYTES) != hipSuccess) { fprintf(stderr, "kernel_launch: hipFuncSetAttribute failed\n"); g_grid = -1; return; }
        g_grid = cus;
    }
    if (g_grid < 0) return;
    Args a{};
    for (int i = 0; i < 23; ++i) a.in[i] = (const float*)d_in[i];
    a.out = out; a.ws = ws;
    (void)hipMemsetAsync(ws, 0, 8 * MiB, stream);
    launch_phases(a, 0, PH_END, stream);
}
```

```cpp
#include <hip/hip_runtime.h>
#include <cstdio>
#include <cstdint>

typedef unsigned short bf16;
typedef short bf16x8 __attribute__((ext_vector_type(8)));
typedef float f32x4 __attribute__((ext_vector_type(4)));
typedef float f32x16 __attribute__((ext_vector_type(16)));
typedef unsigned u32x4 __attribute__((ext_vector_type(4)));
typedef unsigned u32x2 __attribute__((ext_vector_type(2)));

constexpr int NB = 8, S = 4096, T = NB * S, D = 1024, INW = 8192;
constexpr int NE = 32, TOPK = 4, FF = 1024;
constexpr size_t PO_RQ = 0, PO_RK = (size_t)T * 512, PO_RV = (size_t)T * 1024, PO_RG = (size_t)T * 2048, PO_DQ = (size_t)T * 3072, PO_DK = (size_t)T * 4096, PO_DV = (size_t)T * 5120, PO_MG = (size_t)T * 6144;
constexpr float EPS = 1e-6f;
constexpr float LOG2E = 1.4426950408889634f;
constexpr float C2 = 0.125f * LOG2E;
constexpr float LAMBDA_INIT = 0.2f;
#ifndef FP8_MOE
#define FP8_MOE 1
#endif
#ifndef FP8_IN
#define FP8_IN 0
#endif
#ifndef FP8_OUT
#define FP8_OUT 0
#endif
constexpr int W_SH = 5, A_SH = 2, E_SH = 3;
constexpr int NRB_MAX = 544;
constexpr int NR_MAX = NRB_MAX * 256;

constexpr size_t MiB = 1u << 20;
constexpr size_t WS_CTL = 0;
constexpr size_t WS_MOD = 1 * MiB;
constexpr size_t WS_WRT = 1 * MiB + 512 * 1024;
constexpr size_t WS_ROUTE = 2 * MiB;
constexpr size_t WS_LIST = 4 * MiB;
constexpr size_t WS_WIN = 8 * MiB;
constexpr size_t WS_WOUT = 24 * MiB;
constexpr size_t WS_W1 = 26 * MiB;
constexpr size_t WS_W2 = 154 * MiB;
constexpr size_t WS_H = 218 * MiB;
constexpr size_t WS_PROJ = 282 * MiB;
constexpr size_t WS_YRET = 794 * MiB;
constexpr size_t WS_ODIFF = 858 * MiB;
constexpr size_t WS_MERGED = 922 * MiB;
constexpr size_t WS_ACT = WS_PROJ;
constexpr size_t WS_EO = WS_PROJ + 272 * MiB;
#define IN_GATE_F8 1
#define MOE_W_IN_QUEUE 1
#define FUSE_MERGE 1
constexpr size_t WS_H8 = 858 * MiB;
constexpr size_t WS_WIN8 = 146 * MiB;
constexpr size_t WS_X1B = FUSE_MERGE ? 858 * MiB : 794 * MiB;
constexpr size_t WS_MRG = FUSE_MERGE ? 794 * MiB : 922 * MiB;
constexpr size_t WS_END = 986 * MiB;
constexpr int CW_CNT = 64;
constexpr int CW_ROWOFF = 128;
constexpr int CW_NRB = 192;
constexpr int CW_Q = 512;
constexpr int CW_RB2E = 256;

__device__ __forceinline__ float bf2f(bf16 v) { return __builtin_bit_cast(float, (unsigned)v << 16); }
__device__ __forceinline__ float rowsum16(float x) {
    x += __builtin_bit_cast(float, __builtin_amdgcn_update_dpp(0, __builtin_bit_cast(int, x), 0x128, 0xf, 0xf, false));
    x += __builtin_bit_cast(float, __builtin_amdgcn_update_dpp(0, __builtin_bit_cast(int, x), 0x124, 0xf, 0xf, false));
    x += __builtin_bit_cast(float, __builtin_amdgcn_update_dpp(0, __builtin_bit_cast(int, x), 0x122, 0xf, 0xf, false));
    x += __builtin_bit_cast(float, __builtin_amdgcn_update_dpp(0, __builtin_bit_cast(int, x), 0x121, 0xf, 0xf, false));
    return x; }
__device__ __forceinline__ bf16 f2bf(float f) { unsigned u = __builtin_bit_cast(unsigned, f); return (bf16)((u + 0x7fffu + ((u >> 16) & 1u)) >> 16); }
__host__ __device__ __forceinline__ int crow(int r, int hi) { return (r & 3) + 8 * (r >> 2) + 4 * hi; }
__device__ __forceinline__ float sigmoidf_(float x) { return 1.f / (1.f + __expf(-x)); }

__host__ __device__ __forceinline__ int tile_new2old(int t) { return t < 12 ? t : (t < 16 ? t + 12 : (t < 28 ? t - 4 : t)); }
__host__ __device__ __forceinline__ int in_p2l(int p) { const int tp = p >> 8, t = tile_new2old(tp), q = p & 255, bj = q >> 7, wc = (q >> 5) & 3, j = q & 31;
    if (tp >= 8 && tp < 16) return (bj ? 6144 : 2048) + (tp - 8) * 128 + (q & 127);
    return t * 256 + 64 * wc + 32 * bj + j; }
__host__ __device__ __forceinline__ int w1_p2l(int p) { const int t = p >> 8, q = p & 255, bj = q >> 7; return bj * 1024 + t * 128 + (q & 127); }

#define LAS __attribute__((address_space(3)))
#define GAS __attribute__((address_space(1)))
namespace pg8 {
constexpr int BM = 256, BK = 64, HALF = 128, HTB = HALF * BK * 2  , STAGE_BYTES = 8 * HTB, NXCD = 8, WGM = 8;

__host__ __device__ __forceinline__ int lds_byte(int r, int c) { const int st = (r >> 4) * 2 + (c >> 5), rr = r & 15, cc = c & 31, ob = rr * 64 + cc * 2; return st * 1024 + (ob ^ (((ob >> 9) & 1) << 5)); }
__host__ __device__ __forceinline__ void stage_rc(int b, int& R, int& C) { const int st = b / 1024, sb = b % 1024, swz = sb ^ (((sb >> 9) & 1) << 5); R = (st >> 1) * 16 + swz / 64; C = (st & 1) * 32 + (swz % 64) / 2; }
__host__ __device__ __forceinline__ int perm32(int rho) { const int n = rho >> 4, i = rho & 15; return 8 * (i >> 2) + 4 * n + (i & 3); }
struct GUnit { int pm, pn, e, g, s; };

struct StaticOrder {
    int nM, nN, nwg, G, c; const LAS unsigned* rb2e; const LAS unsigned* rbfirst;
    __device__ void init(int nM_, int nN_, int G_, int c_, const LAS unsigned* t, const LAS unsigned* f) { nM = nM_; nN = nN_; nwg = nM * nN; G = G_; c = c_; rb2e = t; rbfirst = f; }
    __device__ bool next(int i, GUnit& u) const {
        const long L = (long)i * G + c; if (L >= nwg) return false;
        int wgid = (int)L; { const int q = nwg / NXCD, r = nwg % NXCD, xcd = wgid % NXCD, off = wgid / NXCD; wgid = (xcd < r ? xcd * (q + 1) : r * (q + 1) + (xcd - r) * q) + off; }
        const int nig = WGM * nN, gid = wgid / nig, fm = gid * WGM, gsz = (nM - fm) < WGM ? (nM - fm) : WGM;
        u.pm = fm + ((wgid % nig) % gsz); u.pn = (wgid % nig) / gsz; u.e = rb2e ? __builtin_amdgcn_readfirstlane((int)rb2e[u.pm]) : 0; u.g = rb2e ? u.e * T + (u.pm - __builtin_amdgcn_readfirstlane((int)rbfirst[u.e])) * 256 : 0; return true;
    }
};

__device__ __forceinline__ unsigned cvt_pk_bf16(float lo, float hi) { unsigned r; asm volatile("v_cvt_pk_bf16_f32 %0, %1, %2" : "=v"(r) : "v"(lo), "v"(hi)); return r; }

template <class Epi, class Sched, bool GATHER, bool FP8 = false, int BIAS = 0, int BP = 0>
__device__ __forceinline__ void gemm_phase(LAS unsigned char* lds, const void* Aglob, const void* Bglob, const size_t bstride, const int K, const Sched& S, const Epi& E,
                                           const int* rowtok, LAS unsigned* gtab, const int sA = 127, const int sB = 127, const float* bias = nullptr, LAS float* btab = nullptr) {
    typedef int v4i_t __attribute__((ext_vector_type(4))); typedef int v8i_t __attribute__((ext_vector_type(8)));
    const int KB = FP8 ? K : 2 * K;
    const int tid = threadIdx.x, wid = __builtin_amdgcn_readfirstlane(tid >> 6), lane = tid & 63, wr = wid >> 2, wc = wid & 3, fr = lane & 15, fq = lane >> 4;
    const int nt = KB / 128;
    unsigned voffA[2], voffB[2];
#pragma unroll
    for (int i = 0; i < 2; ++i) { int R, C; stage_rc(tid * 16 + i * 8192, R, C);
        const int Rb = BP ? 64 * (R >> 5) + 16 * ((R >> 2) & 3) + 4 * ((R >> 4) & 1) + (R & 3) : (R & ~31) + perm32(R & 31);
        voffA[i] = (unsigned)(R * KB + C * 2); voffB[i] = (unsigned)(Rb * KB + C * 2); }
    constexpr unsigned kstep = 128u;
    const unsigned hstep = (unsigned)(HALF * KB);
    const unsigned hstepB = BP ? (unsigned)(8 * KB) : hstep;
    const unsigned tstep = 2u * hstep;
    const unsigned ldsw = (unsigned)wid * 1024u;
    const int aoff = lds_byte(wr * 64 + fr, fq * 8), boff = lds_byte(wc * 32 + fr, fq * 8);
#define PG8_SA(b, h) (((b) * 2 + (h)) * HTB)
#define PG8_SB(b, h) ((4 + (b) * 2 + (h)) * HTB)
#define PG8_STAGE(bufoff, gbase, voff) do { _Pragma("unroll") for (int _i = 0; _i < 2; ++_i) \
        __builtin_amdgcn_global_load_lds((const unsigned*)((const char*)(gbase) + (voff)[_i]), (LAS unsigned*)(lds + (bufoff) + ldsw + _i * 8192), 16, 0, 0); } while (0)
#define PG8_STAGE_A(b, h, kptr, VO) do { if constexpr (GATHER) { PG8_STAGE(PG8_SA(b, h), kptr, VO[h]); } else { PG8_STAGE(PG8_SA(b, h), (kptr) + (h) * hstep, voffA); } } while (0)
#define PG8_STAGE_A2(b, h, kptr) do { if constexpr (GATHER) { _Pragma("unroll") for (int _i = 0; _i < 2; ++_i) \
        __builtin_amdgcn_global_load_lds((const unsigned*)((const char*)(kptr) + (usen ? vN[h][_i] : vC[h][_i])), (LAS unsigned*)(lds + PG8_SA(b, h) + ldsw + _i * 8192), 16, 0, 0); } \
        else { PG8_STAGE(PG8_SA(b, h), (kptr) + (h) * hstep, voffA); } } while (0)
#define PG8_LD8(p_) __builtin_shufflevector(*(const LAS v4i_t*)(p_), *(const LAS v4i_t*)((p_) + 1024), 0, 1, 2, 3, 4, 5, 6, 7)
#define PG8_LDA(dst, b, h) do { if constexpr (FP8) { _Pragma("unroll") for (int m = 0; m < 4; ++m) dst##8[m] = PG8_LD8(lds + PG8_SA(b, h) + aoff + m * 2048); } \
        else { _Pragma("unroll") for (int m = 0; m < 4; ++m) _Pragma("unroll") for (int k = 0; k < 2; ++k) dst[m][k] = *(const LAS bf16x8*)(lds + PG8_SA(b, h) + aoff + m * 2048 + k * 1024); } } while (0)
#define PG8_LDB(dst, b, h) do { if constexpr (FP8) { _Pragma("unroll") for (int n = 0; n < 2; ++n) dst##8[n] = PG8_LD8(lds + PG8_SB(b, h) + boff + n * 2048); } \
        else { _Pragma("unroll") for (int n = 0; n < 2; ++n) _Pragma("unroll") for (int k = 0; k < 2; ++k) dst[n][k] = *(const LAS bf16x8*)(lds + PG8_SB(b, h) + boff + n * 2048 + k * 1024); } } while (0)
#define PG8_MMA(ai, bj, At, Bt) do { __builtin_amdgcn_s_setprio(1); \
        if constexpr (FP8) { _Pragma("unroll") for (int m = 0; m < 4; ++m) _Pragma("unroll") for (int n = 0; n < 2; ++n)   \
            asm volatile("v_mfma_scale_f32_16x16x128_f8f6f4 %0, %1, %2, %0, %3, %4 op_sel_hi:[0,0,0]" : "+v"(acc[ai][bj][m][n]) : "v"(Bt##8[n]), "v"(At##8[m]), "v"(sB), "v"(sA)); } \
        else { _Pragma("unroll") for (int m = 0; m < 4; ++m) _Pragma("unroll") for (int n = 0; n < 2; ++n) _Pragma("unroll") for (int k = 0; k < 2; ++k) \
            asm volatile("v_mfma_f32_16x16x32_bf16 %0, %1, %2, %0" : "+v"(acc[ai][bj][m][n]) : "v"(Bt[n][k]), "v"(At[m][k])); } \
        __builtin_amdgcn_s_setprio(0); } while (0)
#define PG8_MMA0(ai, bj, At, Bt) do { __builtin_amdgcn_s_setprio(1); \
        if constexpr (FP8) { _Pragma("unroll") for (int m = 0; m < 4; ++m) _Pragma("unroll") for (int n = 0; n < 2; ++n) \
            asm volatile("v_mfma_scale_f32_16x16x128_f8f6f4 %0, %1, %2, 0, %3, %4 op_sel_hi:[0,0,0]" : "=&v"(acc[ai][bj][m][n]) : "v"(Bt##8[n]), "v"(At##8[m]), "v"(sB), "v"(sA)); } \
        else { _Pragma("unroll") for (int m = 0; m < 4; ++m) _Pragma("unroll") for (int n = 0; n < 2; ++n) { \
            asm volatile("v_mfma_f32_16x16x32_bf16 %0, %1, %2, 0" : "=&v"(acc[ai][bj][m][n]) : "v"(Bt[n][0]), "v"(At[m][0])); \
            asm volatile("v_mfma_f32_16x16x32_bf16 %0, %1, %2, %0" : "+v"(acc[ai][bj][m][n]) : "v"(Bt[n][1]), "v"(At[m][1])); } } \
        __builtin_amdgcn_s_setprio(0); } while (0)
#define PG8_WAIT_V(n) asm volatile("s_waitcnt vmcnt(" #n ")" ::: "memory")
#define PG8_WAIT_L(n) asm volatile("s_waitcnt lgkmcnt(" #n ")" ::: "memory")
#define PG8_BAR __builtin_amdgcn_s_barrier()
#define PG8_SCHED __builtin_amdgcn_sched_barrier(0)
#define PG8_GTAB_DMA(g_, slot_) do { if (wid < 4) __builtin_amdgcn_global_load_lds((const unsigned*)(rowtok + (size_t)(g_) + tid), (LAS unsigned*)(gtab + (slot_) * 256 + wid * 64), 4, 0, 0); } while (0)
#define PG8_GOFF(dst, slot_) do { _Pragma("unroll") for (int _i = 0; _i < 2; ++_i) { int _R, _C; stage_rc(tid * 16 + _i * 8192, _R, _C); \
        _Pragma("unroll") for (int _h = 0; _h < 2; ++_h) dst[_h][_i] = gtab[(slot_) * 256 + _h * 128 + _R] * (unsigned)KB + (unsigned)(_C * 2); } } while (0)
#define PG8_BTAB_DMA(u_, slot_) do { if constexpr (BIAS != 0) { if (wid >= 4) { const int _i = tid - 256; \
        const float* _src = BIAS == 1 ? bias + (size_t)(u_).e * 2048 + (_i < 128 ? 128 * (u_).pn + _i : 1024 + 128 * (u_).pn + (_i - 128)) : bias + (size_t)(u_).e * 1024 + 256 * (u_).pn + _i; \
        __builtin_amdgcn_global_load_lds((const unsigned*)_src, (LAS unsigned*)(btab + (slot_) * 256 + (wid - 4) * 64), 4, 0, 0); } } } while (0)
    GUnit cur, nxt; int ui = 0;
    if (!S.next(0, cur)) return;
    cur.s = 0; PG8_BTAB_DMA(cur, 0);
    f32x4 acc[2][2][4][2];
    bf16x8 At[4][2], B0[2][2], B1[2][2]; v8i_t At8[4], B08[2], B18[2];
    unsigned vC[2][2], vN[2][2];
    if constexpr (GATHER) { PG8_GTAB_DMA(cur.g, 0); PG8_WAIT_V(0); PG8_BAR; PG8_GOFF(vC, 0); PG8_WAIT_L(0);
#pragma unroll
        for (int h = 0; h < 2; ++h)
#pragma unroll
            for (int i = 0; i < 2; ++i) vN[h][i] = vC[h][i]; }
    const char* cA = GATHER ? (const char*)Aglob : (const char*)Aglob + (size_t)cur.pm * tstep;
    const char* cB = (const char*)Bglob + (size_t)cur.e * bstride + (size_t)cur.pn * tstep;
    PG8_STAGE(PG8_SB(0, 0), cB, voffB); PG8_STAGE(PG8_SB(0, 1), cB + hstepB, voffB); PG8_STAGE_A(0, 0, cA, vC); PG8_STAGE_A(0, 1, cA, vC);
    if (wr == 1) PG8_BAR;
    PG8_WAIT_V(2); PG8_BAR;
    PG8_STAGE(PG8_SB(1, 0), cB + kstep, voffB); PG8_STAGE_A(1, 0, cA + kstep, vC); PG8_STAGE(PG8_SB(1, 1), cB + hstepB + kstep, voffB);
    PG8_WAIT_V(6); PG8_BAR;
    int sprev = 0;
    for (;;) {
        const bool has_next = S.next(ui + 1, nxt);
        if constexpr (GATHER) { if (has_next) PG8_GTAB_DMA(nxt.g, (ui + 1) & 1); }
        const char* nA = has_next ? (GATHER ? (const char*)Aglob : (const char*)Aglob + (size_t)nxt.pm * tstep) : cA;
        const char* nB = has_next ? (const char*)Bglob + (size_t)nxt.e * bstride + (size_t)nxt.pn * tstep : cB;
#define PG8_STEP(t, WV1, WV2, LASTOK, MM) do { \
            const bool last = (LASTOK) && ((t) == nt - 2); \
            const char* a1 = cA + (size_t)((t) + 1) * kstep; \
            const char* a2 = last ? nA : cA + (size_t)((t) + 2) * kstep; const char* b2 = last ? nB : cB + (size_t)((t) + 2) * kstep; \
            const char* a3 = a2 + kstep; const char* b3 = b2 + kstep; \
            if constexpr (GATHER) { if (last && has_next) { PG8_GOFF(vN, (ui + 1) & 1); } } \
            const bool usen = last && has_next; \
              \
            PG8_LDB(B0, 0, 0); PG8_LDB(B1, 0, 1); PG8_SCHED; PG8_LDA(At, 0, 0); PG8_STAGE_A(1, 1, a1, vC); \
            WV1; PG8_WAIT_L(0); PG8_BAR; MM(0, 0, At, B0); MM(0, 1, At, B1); PG8_BAR; PG8_SCHED; \
              \
            PG8_LDA(At, 0, 1); PG8_STAGE(PG8_SB(0, 0), b2, voffB); PG8_STAGE(PG8_SB(0, 1), b2 + hstepB, voffB); PG8_STAGE_A2(0, 0, a2); \
            WV2; PG8_WAIT_L(0); PG8_BAR; MM(1, 0, At, B0); MM(1, 1, At, B1); PG8_BAR; PG8_SCHED; \
              \
            PG8_LDB(B0, 1, 0); PG8_LDB(B1, 1, 1); PG8_SCHED; PG8_LDA(At, 1, 0); PG8_STAGE_A2(0, 1, a2); \
            PG8_WAIT_V(8); PG8_WAIT_L(0); PG8_BAR; PG8_MMA(0, 0, At, B0); PG8_MMA(0, 1, At, B1); PG8_BAR; PG8_SCHED; \
              \
            PG8_LDA(At, 1, 1); PG8_STAGE(PG8_SB(1, 0), b3, voffB); PG8_STAGE(PG8_SB(1, 1), b3 + hstepB, voffB); PG8_STAGE_A2(1, 0, a3); \
            PG8_WAIT_V(8); PG8_WAIT_L(0); PG8_BAR; PG8_MMA(1, 0, At, B0); PG8_MMA(1, 1, At, B1); PG8_BAR; PG8_SCHED; } while (0)
#define PG8_WAIT_VR() do { if (sprev >= 16) PG8_WAIT_V(24); else if (sprev >= 8) PG8_WAIT_V(16); else PG8_WAIT_V(8); } while (0)
        if constexpr (FP8) {
            PG8_STEP(0, PG8_WAIT_VR(), PG8_WAIT_VR(), false, PG8_MMA0);
            for (int t = 2; t < nt; t += 2) PG8_STEP(t, PG8_WAIT_V(8), PG8_WAIT_V(8), true, PG8_MMA);
        } else {
#define PG8_WAIT_VR2() do { if (sprev >= 8) PG8_WAIT_V(16); else PG8_WAIT_V(8); } while (0)
            PG8_STEP(0, PG8_WAIT_VR2(), PG8_WAIT_VR2(), false, PG8_MMA0);
            for (int t = 2; t < nt; t += 2) PG8_STEP(t, PG8_WAIT_V(8), PG8_WAIT_V(8), true, PG8_MMA);
        }
        if (wr == 0) PG8_BAR;
        asm volatile("s_nop 15\n\ts_nop 15\n\ts_nop 7" ::: "memory");
        E(acc, cur, wr, wc, fr, fq);
        sprev = Epi::nstores(cur);
        if (!has_next) break;
        cur = nxt; cA = nA; cB = nB; ++ui; cur.s = ui & 1;
        if constexpr (GATHER) {
#pragma unroll
            for (int h = 0; h < 2; ++h)
#pragma unroll
                for (int i = 0; i < 2; ++i) vC[h][i] = vN[h][i]; }
        if (wr == 1) PG8_BAR;
        PG8_BTAB_DMA(cur, ui & 1);
    }
    PG8_WAIT_V(0);
    PG8_BAR;
#undef PG8_SA
#undef PG8_SB
#undef PG8_STAGE
#undef PG8_STAGE_A
#undef PG8_STAGE_A2
#undef PG8_LDA
#undef PG8_LDB
#undef PG8_MMA
#undef PG8_MMA0
#undef PG8_LD8
#undef PG8_WAIT_V
#undef PG8_WAIT_VR
#undef PG8_STEP
#undef PG8_WAIT_L
#undef PG8_BAR
#undef PG8_SCHED
#undef PG8_GTAB_DMA
#undef PG8_BTAB_DMA
#undef PG8_GOFF
}
}

#define XB_TMO      128
#define XB_XCNT(j)  (256  + 64 * (j))
#define XB_XSUB(j)  (1280 + 64 * (j))
#define XB_XGEN(j)  (2304 + 64 * (j))
#define XB_TOP      3328
#define XB_TOPGEN   3392
#define XCD_BAR_WORDS 3456
#define XB_SPIN_CAP (1u << 24)

__device__ __forceinline__ unsigned xb_ld(unsigned* p)              { return __hip_atomic_load(p, __ATOMIC_RELAXED, __HIP_MEMORY_SCOPE_AGENT); }
__device__ __forceinline__ unsigned xb_add(unsigned* p, unsigned v) { return __hip_atomic_fetch_add(p, v, __ATOMIC_RELAXED, __HIP_MEMORY_SCOPE_AGENT); }
__device__ __forceinline__ unsigned xb_xcc_id() { return (unsigned)__builtin_amdgcn_s_getreg((3 << 11) | 20) & 0xFu; }
#define XB_SPIN(cond, bar) do { unsigned _sp = 0; while (cond) { __builtin_amdgcn_s_sleep(1); \
    if ((++_sp & 255u) == 0u) { if (xb_ld(&(bar)[XB_TMO])) break; if (_sp > XB_SPIN_CAP) { atomicAdd(&(bar)[XB_TMO], 1u); break; } } } } while (0)

struct XcdBarrier {
    unsigned* bar; unsigned x;
    volatile LAS unsigned* st;
};

__device__ __forceinline__ XcdBarrier xcd_barrier_post(unsigned* bar, volatile LAS unsigned* st) {
    XcdBarrier b; b.bar = bar; b.x = xb_xcc_id(); b.st = st;
    if (threadIdx.x == 0) (void)xb_add(&bar[XB_XCNT(b.x)], 1u);
    return b;
}
__device__ __forceinline__ void xcd_barrier_complete(unsigned* bar, unsigned x, unsigned& nloc, unsigned& nx) {
    const unsigned G = gridDim.x * gridDim.y * gridDim.z;
    unsigned sum, cnt, mine, sp = 0u;
    for (;;) {
        sum = 0u; cnt = 0u; mine = 0u;
#pragma unroll
        for (unsigned j = 0; j < 16; ++j) { const unsigned c = xb_ld(&bar[XB_XCNT(j)]); sum += c; cnt += (c > 0u) ? 1u : 0u; mine = (j == x) ? c : mine; }
        if (sum == G) break;
        __builtin_amdgcn_s_sleep(1);
        if ((++sp & 255u) == 0u) { if (xb_ld(&bar[XB_TMO])) break; if (sp > XB_SPIN_CAP) { atomicAdd(&bar[XB_TMO], 1u); break; } }
    }
    nloc = mine > 0u ? mine : 1u; nx = cnt > 0u ? cnt : 1u;
}

__device__ __forceinline__ void xcd_barrier(const XcdBarrier& b) {
    asm volatile("s_waitcnt vmcnt(0)" ::: "memory");
    __syncthreads();
    if (threadIdx.x == 0) {
        unsigned* bar = b.bar;
        __builtin_amdgcn_s_waitcnt(0);
        unsigned nloc = b.st[0], nx = b.st[1];
        if (nloc == 0u) { xcd_barrier_complete(bar, b.x, nloc, nx); b.st[0] = nloc; b.st[1] = nx; }
        const unsigned old = xb_add(&bar[XB_XSUB(b.x)], 1u);
        const unsigned gen = old / nloc;
        if (old + 1u == (gen + 1u) * nloc) {
            __builtin_amdgcn_fence(__ATOMIC_RELEASE, "agent");
            asm volatile("s_waitcnt vmcnt(0)" ::: "memory");
            const unsigned og = xb_add(&bar[XB_TOP], 1u);
            const unsigned tg = og / nx;
            if (og + 1u == (tg + 1u) * nx) xb_add(&bar[XB_TOPGEN], 1u);
            else XB_SPIN(xb_ld(&bar[XB_TOPGEN]) == tg, bar);
            __builtin_amdgcn_fence(__ATOMIC_ACQUIRE, "agent");
            xb_add(&bar[XB_XGEN(b.x)], 1u);
            asm volatile("s_waitcnt vmcnt(0)" ::: "memory");
        } else {
            XB_SPIN(xb_ld(&bar[XB_XGEN(b.x)]) == gen, bar);
            __builtin_amdgcn_fence(__ATOMIC_ACQUIRE, "agent");
            asm volatile("s_waitcnt vmcnt(0)" ::: "memory");
        }
    }
    __syncthreads();
}

__device__ __forceinline__ float fast_sigmoid(float x) { return __builtin_amdgcn_rcpf(1.f + __builtin_amdgcn_exp2f(-LOG2E * x)); }
__device__ __forceinline__ u32x4 pack8(const f32x4 a, const f32x4 b) { u32x4 w; w.x = pg8::cvt_pk_bf16(a[0], a[1]); w.y = pg8::cvt_pk_bf16(a[2], a[3]); w.z = pg8::cvt_pk_bf16(b[0], b[1]); w.w = pg8::cvt_pk_bf16(b[2], b[3]); return w; }

__device__ __forceinline__ unsigned pk4_fp8(float a, float b, float c, float d, float sc) {
    a = __builtin_amdgcn_fmed3f(a * sc, -448.f, 448.f); b = __builtin_amdgcn_fmed3f(b * sc, -448.f, 448.f); c = __builtin_amdgcn_fmed3f(c * sc, -448.f, 448.f); d = __builtin_amdgcn_fmed3f(d * sc, -448.f, 448.f);
    int v = __builtin_amdgcn_cvt_pk_fp8_f32(a, b, 0, false); v = __builtin_amdgcn_cvt_pk_fp8_f32(c, d, v, true); return (unsigned)v; }
__device__ __forceinline__ unsigned pk4_fp8_nc(float a, float b, float c, float d) {
    int v = __builtin_amdgcn_cvt_pk_fp8_f32(a, b, 0, false); v = __builtin_amdgcn_cvt_pk_fp8_f32(c, d, v, true); return (unsigned)v; }
struct EpiIn {
    bf16* proj; const LAS float* gqk;
    static __device__ __forceinline__ int nstores(const pg8::GUnit& u) { return (u.pn >= 8 && u.pn < 16) ? 8 : 16; }
    __device__ __forceinline__ void operator()(const f32x4 (&acc)[2][2][4][2], const pg8::GUnit& u, int wr, int wc, int fr, int fq) const {
        const int pn = tile_new2old(u.pn); const int bb = u.pm >> 4, s0 = (u.pm & 15) * 256 + wr * 64 + fr; const size_t t0 = (size_t)u.pm * 256 + wr * 64 + fr;
        bf16* base; size_t INWp;
        if (u.pn >= 8 && u.pn < 16) {
            bf16* gb = proj + PO_RG + t0 * 1024 + (u.pn - 8) * 128 + wc * 32 + fq * 8;
#pragma unroll
            for (int ai = 0; ai < 2; ++ai)
#pragma unroll
                for (int m = 0; m < 4; ++m) { f32x4 v[2];
#pragma unroll
                    for (int n = 0; n < 2; ++n) {
                        const f32x4 x = acc[ai][0][m][n], a = x * (-LOG2E), b = acc[ai][1][m][n] * (-LOG2E); f32x4 ex, ey, r;
#pragma unroll
                        for (int e = 0; e < 4; ++e) { ex[e] = __builtin_amdgcn_exp2f(a[e]); ey[e] = __builtin_amdgcn_exp2f(b[e]); }
                        const f32x4 d = (ex + 1.f) * (ey + 1.f);
#pragma unroll
                        for (int e = 0; e < 4; ++e) r[e] = __builtin_amdgcn_rcpf(d[e]);
                        v[n] = x * r; }
                    *(u32x4*)(gb + (size_t)(ai * 128 + m * 16) * 1024) = pack8(v[0], v[1]); }
            return;
        }
        if (pn < 4)       { const int h = 2 * (pn & 1) + (wc >> 1); base = proj + (pn < 2 ? PO_RQ : PO_RK) + ((size_t)(bb * 4 + h) * S + s0) * 128 + (wc & 1) * 64 + fq * 8; INWp = 128; }
        else if (pn < 8)  { base = proj + PO_RV + ((size_t)(bb * 4 + (pn - 4)) * S + s0) * 256 + wc * 64 + fq * 8; INWp = 256; }
        else if (pn < 12) { base = proj + PO_RG + t0 * 1024 + (pn - 8) * 256 + wc * 64 + fq * 8; INWp = 1024; }
        else if (pn < 24) { const int rg3 = (pn - 12) >> 2, h = 2 * ((pn - 12) & 3) + (wc >> 1); base = proj + (rg3 == 0 ? PO_DQ : (rg3 == 1 ? PO_DK : PO_DV)) + ((size_t)(bb * 8 + h) * S + s0) * 128 + (wc & 1) * 64 + fq * 8; INWp = 128; }
        else              { base = proj + PO_MG + (pn >= 28 ? (size_t)T * 1024 : 0) + t0 * 1024 + ((pn - 24) & 3) * 256 + wc * 64 + fq * 8; INWp = 1024; }
        if (pn < 8 || (pn >= 20 && pn < 24)) {
            float f[4];
#pragma unroll
            for (int m = 0; m < 4; ++m) f[m] = 1.f;
            if (pn < 4) { const int h = 2 * (pn & 1) + (wc >> 1); const float lg = __builtin_amdgcn_logf(1.f - __builtin_amdgcn_exp2f(-5.f - (float)h));
#pragma unroll
                for (int m = 0; m < 4; ++m) { const float pos = (float)(wr * 64 + m * 16 + fr); f[m] = pn < 2 ? __builtin_amdgcn_exp2f(lg * pos) : 0.08838834764831845f * __builtin_amdgcn_exp2f(-lg * pos); } }
#pragma unroll
            for (int ai = 0; ai < 2; ++ai)
#pragma unroll
                for (int m = 0; m < 4; ++m)
#pragma unroll
                    for (int bj = 0; bj < 2; ++bj) *(u32x4*)(base + (size_t)(ai * 128 + m * 16) * INWp + bj * 32) = pack8(acc[ai][bj][m][0] * f[m], acc[ai][bj][m][1] * f[m]);
        } else if (pn < 12 || pn >= 24) {
            const bool silu = pn < 12;
#pragma unroll
            for (int ai = 0; ai < 2; ++ai)
#pragma unroll
                for (int m = 0; m < 4; ++m)
#pragma unroll
                    for (int bj = 0; bj < 2; ++bj) { f32x4 v[2];
#pragma unroll
                        for (int n = 0; n < 2; ++n)
#pragma unroll
                            for (int e = 0; e < 4; ++e) { const float x = acc[ai][bj][m][n][e], s = fast_sigmoid(x); v[n][e] = silu ? x * s : s; }
                        *(u32x4*)(base + (size_t)(ai * 128 + m * 16) * INWp + bj * 32) = pack8(v[0], v[1]); }
        } else {
            const LAS float* g = gqk + (pn < 16 ? 0 : 64) + fq * 8;
            f32x4 gv[2][2];
#pragma unroll
            for (int bj = 0; bj < 2; ++bj)
#pragma unroll
                for (int n = 0; n < 2; ++n) gv[bj][n] = *(const LAS f32x4*)(g + bj * 32 + n * 4);
#pragma unroll
            for (int ai = 0; ai < 2; ++ai)
#pragma unroll
                for (int m = 0; m < 4; ++m) { float ss = 0.f;
#pragma unroll
                    for (int bj = 0; bj < 2; ++bj)
#pragma unroll
                        for (int n = 0; n < 2; ++n) { const f32x4 x = acc[ai][bj][m][n]; ss += (x[0] * x[0] + x[1] * x[1]) + (x[2] * x[2] + x[3] * x[3]); }
                    ss += __shfl_xor(ss, 16); ss += __shfl_xor(ss, 32);
                    const float r = __builtin_amdgcn_rsqf(ss * (1.f / 64) + EPS);
#pragma unroll
                    for (int bj = 0; bj < 2; ++bj) *(u32x4*)(base + (size_t)(ai * 128 + m * 16) * INWp + bj * 32) = pack8(acc[ai][bj][m][0] * gv[bj][0] * r, acc[ai][bj][m][1] * gv[bj][1] * r); }
        }
    }
};
struct EpiOutF {
    const float* x; const float* mod; bf16* x1b;
    static __device__ __forceinline__ int nstores(const pg8::GUnit&) { return 16; }
    __device__ __forceinline__ void operator()(const f32x4 (&acc)[2][2][4][2], const pg8::GUnit& u, int wr, int wc, int fr, int fq) const {
        const int row0 = u.pm * 256 + wr * 64 + fr, col0 = u.pn * 256 + wc * 32 + fq * 8, b = (u.pm * 256) / S;
        f32x4 gt[2][2];
#pragma unroll
        for (int bj = 0; bj < 2; ++bj)
#pragma unroll
            for (int n = 0; n < 2; ++n) gt[bj][n] = *(const f32x4*)(mod + b * 6144 + 2048 + col0 + bj * 128 + n * 4);
#pragma unroll
        for (int ai = 0; ai < 2; ++ai)
#pragma unroll
            for (int m = 0; m < 4; ++m) { const size_t ro = (size_t)(row0 + ai * 128 + m * 16) * D + col0;
#pragma unroll
                for (int bj = 0; bj < 2; ++bj) { const f32x4 x0 = *(const f32x4*)(x + ro + bj * 128), x1 = *(const f32x4*)(x + ro + bj * 128 + 4);
                    *(u32x4*)(x1b + ro + bj * 128) = pack8(x0 + gt[bj][0] * acc[ai][bj][m][0], x1 + gt[bj][1] * acc[ai][bj][m][1]); } }
    }
};
struct EpiActF {
    static __device__ __forceinline__ int nstores(const pg8::GUnit&) { return 8; }
    const LAS float* btab; bf16* act;
    __device__ __forceinline__ void operator()(const f32x4 (&acc)[2][2][4][2], const pg8::GUnit& u, int wr, int wc, int fr, int fq) const {
        const int row0 = u.pm * 256 + wr * 64 + fr, c0 = u.pn * 128 + wc * 32 + fq * 8;
        const LAS float* bt = btab + u.s * 256 + wc * 32 + fq * 8;
        constexpr float ASC = (float)(1 << A_SH);
        f32x4 bg[2], bu[2];
#pragma unroll
        for (int n = 0; n < 2; ++n) { bg[n] = *(const LAS f32x4*)(bt + n * 4); bu[n] = (*(const LAS f32x4*)(bt + 128 + n * 4) + 1.f) * ASC; }
#pragma unroll
        for (int ai = 0; ai < 2; ++ai)
#pragma unroll
            for (int m = 0; m < 4; ++m) { f32x4 v[2];
#pragma unroll
                for (int n = 0; n < 2; ++n) {
                    f32x4 g = acc[ai][0][m][n] + bg[n], up = acc[ai][1][m][n] * ASC + bu[n], ex, rc;
#pragma unroll
                    for (int e = 0; e < 4; ++e) { g[e] = fminf(g[e], 7.f); up[e] = __builtin_amdgcn_fmed3f(up[e], -6.f * ASC, 8.f * ASC); }
                    const f32x4 a = g * (-1.702f * LOG2E);
#pragma unroll
                    for (int e = 0; e < 4; ++e) ex[e] = __builtin_amdgcn_exp2f(a[e]);
                    const f32x4 d = ex + 1.f;
#pragma unroll
                    for (int e = 0; e < 4; ++e) rc[e] = __builtin_amdgcn_rcpf(d[e]);
                    v[n] = (g * up) * rc; }
                if (FP8_MOE) { u32x2 o; o.x = pk4_fp8_nc(v[0][0], v[0][1], v[0][2], v[0][3]); o.y = pk4_fp8_nc(v[1][0], v[1][1], v[1][2], v[1][3]);
                    *(u32x2*)((unsigned char*)act + (size_t)(row0 + ai * 128 + m * 16) * FF + c0) = o; }
                else *(u32x4*)(act + (size_t)(row0 + ai * 128 + m * 16) * FF + c0) = pack8(v[0] * (1.f / ASC), v[1] * (1.f / ASC)); }
    }
};
struct EpiEOF {
    static __device__ __forceinline__ int nstores(const pg8::GUnit&) { return 8; }
    const LAS float* btab; bf16* eo;
    __device__ __forceinline__ void operator()(const f32x4 (&acc)[2][2][4][2], const pg8::GUnit& u, int wr, int wc, int fr, int fq) const {
        const int row0 = u.pm * 256 + wr * 64 + fr, col0 = u.pn * 256 + wc * 64 + fq * 16;
        const LAS float* bt = btab + u.s * 256 + wc * 64 + fq * 16;
        constexpr float ESC = (float)(1 << E_SH);
        f32x4 bv[2][2];
#pragma unroll
        for (int bj = 0; bj < 2; ++bj)
#pragma unroll
            for (int n = 0; n < 2; ++n) bv[bj][n] = *(const LAS f32x4*)(bt + bj * 8 + n * 4) * ESC;
#pragma unroll
        for (int ai = 0; ai < 2; ++ai)
#pragma unroll
            for (int m = 0; m < 4; ++m) { u32x4 o; f32x4 v;
                v = acc[ai][0][m][0] * ESC + bv[0][0]; o.x = pk4_fp8(v[0], v[1], v[2], v[3], 1.f);
                v = acc[ai][0][m][1] * ESC + bv[0][1]; o.y = pk4_fp8(v[0], v[1], v[2], v[3], 1.f);
                v = acc[ai][1][m][0] * ESC + bv[1][0]; o.z = pk4_fp8(v[0], v[1], v[2], v[3], 1.f);
                v = acc[ai][1][m][1] * ESC + bv[1][1]; o.w = pk4_fp8(v[0], v[1], v[2], v[3], 1.f);
                *(u32x4*)((unsigned char*)eo + (size_t)(row0 + ai * 128 + m * 16) * D + col0) = o; }
    }
};

constexpr int LDS_STAGE = 0, LDS_STAGE_BYTES = 131072;
constexpr int LDS_GTAB = 131072;
constexpr int LDS_RB2E = LDS_GTAB + 2048;
constexpr int LDS_GQK = LDS_RB2E + 2176;
constexpr int LDS_RBF = LDS_GQK + 512;
constexpr int LDS_MISC = LDS_RBF + 256;
constexpr int LDS_BTAB = LDS_MISC + 256;
constexpr int LDS_BYTES = 147456;
static_assert(LDS_BTAB + 2048 <= LDS_BYTES, "LDS map");

namespace att {
constexpr int SLOT = 32768, KOFF = 0, VOFF = 16384, NSLOT = 4;
constexpr int LDS_WS = LDS_GTAB;
constexpr int LDS_X = 0;
constexpr int LDS_Y = 65536;
constexpr int LDS_XS = LDS_BTAB;
constexpr int LDS_GSUB = LDS_GQK;
constexpr float THR = 8.f;
typedef short v4i16 __attribute__((ext_vector_type(4)));
template <int OFF> __device__ __forceinline__ bf16x8 rd128(unsigned a) { bf16x8 v; asm volatile("ds_read_b128 %0, %1 offset:%2" : "=v"(v) : "v"(a), "n"(OFF)); return v; }
template <int OFF> __device__ __forceinline__ v4i16 rdtr(unsigned a) { v4i16 v; asm volatile("ds_read_b64_tr_b16 %0, %1 offset:%2" : "=v"(v) : "v"(a), "n"(OFF)); return v; }
__device__ __forceinline__ float max3(float a, float b, float c) { float r; asm("v_max3_f32 %0, %1, %2, %3" : "=v"(r) : "v"(a), "v"(b), "v"(c)); return r; }
#define ATT_WAITV(n) asm volatile("s_waitcnt vmcnt(" #n ")" ::: "memory")
#define ATT_BAR() asm volatile("s_waitcnt lgkmcnt(0)\n\ts_barrier" ::: "memory")
#define ATT_WAIT_TILE(k_, last_) do { const int _y = ((last_) < NTu - 1 ? (last_) : NTu - 1) - (k_); if (_y >= 2) ATT_WAITV(8); else if (_y == 1) ATT_WAITV(4); else ATT_WAITV(0); } while (0)
__device__ __forceinline__ void unit(const int b, const int h, const int qb, const int t_lo, const bf16* __restrict__ proj, bf16* __restrict__ odiff, LAS unsigned char* lds, const float lam, const float* __restrict__ gsub,
                                     const bool pre, const bool nvalid, const int nb, const int nh, const int nqb, bf16x8& qn0, bf16x8& qn1, bf16x8& qn2, bf16x8& qn3) {
    int tid = threadIdx.x; asm volatile("" : "+v"(tid));
    const int lane = tid & 63, r = lane & 31, hi = lane >> 5; const int wid = __builtin_amdgcn_readfirstlane(tid >> 6), c = wid >> 2, sb = wid & 3;
    const size_t rowb = (size_t)b * S; const int q0 = 128 * qb + 32 * sb;
    const size_t hrow = (size_t)(b * 8 + h) * S;
    const bf16* Kg = proj + PO_DK + hrow * 128; const bf16* Vg = proj + PO_DV + hrow * 128;
    const bf16* Qg = proj + PO_DQ + (hrow + q0 + r) * 128 + c * 64 + hi * 8;
    bf16x8 qf[4];
    if (pre) { qf[0] = qn0; qf[1] = qn1; qf[2] = qn2; qf[3] = qn3; }
    else {
#pragma unroll
        for (int ks = 0; ks < 4; ++ks) qf[ks] = *(const bf16x8*)(Qg + 16 * ks);
    }
    const float slope2 = __builtin_amdgcn_exp2f(-(float)(h + 1)) * LOG2E;
    const int t_hi = 2 * qb + 1, NTu = t_hi + 1 - t_lo;
    LAS float* wsf = (LAS float*)(lds + LDS_WS) + wid * 64;
    const unsigned lds0 = (unsigned)(uintptr_t)lds;
    unsigned kof[2], vof[2];
#pragma unroll
    for (int j = 0; j < 2; ++j) { const int pc = wid + 8 * j, key = 4 * pc + (lane >> 4); kof[j] = (unsigned)(key * 256 + (((lane & 15) ^ (key & 7)) << 4));
        const int blk = wid + 8 * j, d0 = blk >> 2, kk = blk & 3; vof[j] = (unsigned)((16 * kk + (lane >> 2)) * 256 + (32 * d0 + 8 * (lane & 3)) * 2); }
#define ATT_DMA(it_) do { const int _t = t_hi - (it_); LAS unsigned char* _s = lds + (((it_) + 3) & 3) * SLOT; \
        const char* _kb = (const char*)Kg + (size_t)_t * 16384; const char* _vb = (const char*)Vg + (size_t)_t * 16384; \
        _Pragma("unroll") for (int _j = 0; _j < 2; ++_j) __builtin_amdgcn_global_load_lds((const unsigned*)(_kb + kof[_j]), (LAS unsigned*)(_s + KOFF + (wid + 8 * _j) * 1024), 16, 0, 0); \
        _Pragma("unroll") for (int _j = 0; _j < 2; ++_j) __builtin_amdgcn_global_load_lds((const unsigned*)(_vb + vof[_j]), (LAS unsigned*)(_s + VOFF + (wid + 8 * _j) * 1024), 16, 0, 0); } while (0)
    if (!pre) ATT_DMA(0);
    ATT_DMA(1); if (NTu > 2) ATT_DMA(2);
    f32x16 o[4], ol;
#pragma unroll
    for (int q = 0; q < 16; ++q) { ol[q] = 0.f;
#pragma unroll
        for (int d = 0; d < 4; ++d) o[d][q] = 0.f; }
    float m = 0.f;
    unsigned kl[4];
#pragma unroll
    for (int ks = 0; ks < 4; ++ks) kl[ks] = lds0 + KOFF + r * 256 + (((8 * c + 2 * ks + hi) ^ (r & 7)) << 4);
    const unsigned vl = lds0 + VOFF + ((lane >> 4) & 1) * 32 + (lane & 3) * 8 + (4 * hi + ((lane & 15) >> 2)) * 64;
    f32x16 p0, p1;
    const bf16x8 ones = (bf16x8){0x3F80, 0x3F80, 0x3F80, 0x3F80, 0x3F80, 0x3F80, 0x3F80, 0x3F80};
#define ATT_PINIT(it_) do { const int _t = t_hi - (it_); const float cb = slope2 * (float)(64 * _t - (q0 + r) + 4 * hi) - m; \
        _Pragma("unroll") for (int q = 0; q < 16; ++q) { p0[q] = fmaf(slope2, (float)((q & 3) + 8 * (q >> 2)), cb); p1[q] = fmaf(slope2, (float)((q & 3) + 8 * (q >> 2) + 32), cb); } } while (0)
#define ATT_H1(it_, FIRST_) do { const int _t = t_hi - (it_); \
        if (64 * _t <= q0 + 31) { const unsigned so_ = (unsigned)(((it_) + 3) & 3) * SLOT; \
            bf16x8 k0 = rd128<0>(kl[0] + so_), k1 = rd128<0>(kl[1] + so_), k2 = rd128<0>(kl[2] + so_), k3 = rd128<0>(kl[3] + so_), k4 = rd128<8192>(kl[0] + so_), k5 = rd128<8192>(kl[1] + so_), k6 = rd128<8192>(kl[2] + so_), k7 = rd128<8192>(kl[3] + so_); \
            asm volatile("s_waitcnt lgkmcnt(0)" : "+v"(k0), "+v"(k1), "+v"(k2), "+v"(k3), "+v"(k4), "+v"(k5), "+v"(k6), "+v"(k7)); \
            p0 = __builtin_amdgcn_mfma_f32_32x32x16_bf16(k0, qf[0], p0, 0, 0, 0); p1 = __builtin_amdgcn_mfma_f32_32x32x16_bf16(k4, qf[0], p1, 0, 0, 0); \
            p0 = __builtin_amdgcn_mfma_f32_32x32x16_bf16(k1, qf[1], p0, 0, 0, 0); p1 = __builtin_amdgcn_mfma_f32_32x32x16_bf16(k5, qf[1], p1, 0, 0, 0); \
            p0 = __builtin_amdgcn_mfma_f32_32x32x16_bf16(k2, qf[2], p0, 0, 0, 0); p1 = __builtin_amdgcn_mfma_f32_32x32x16_bf16(k6, qf[2], p1, 0, 0, 0); \
            p0 = __builtin_amdgcn_mfma_f32_32x32x16_bf16(k3, qf[3], p0, 0, 0, 0); p1 = __builtin_amdgcn_mfma_f32_32x32x16_bf16(k7, qf[3], p1, 0, 0, 0); \
            if (64 * _t + 63 > q0) { \
                _Pragma("unroll") for (int q = 0; q < 16; ++q) { const int j = 64 * _t + crow(q, hi); if (j > q0 + r) p0[q] = -INFINITY; if (j + 32 > q0 + r) p1[q] = -INFINITY; } } \
            float rm = max3(p0[0], p0[1], p1[0]); rm = max3(rm, p1[1], p0[2]); rm = max3(rm, p0[3], p1[2]); rm = max3(rm, p1[3], p0[4]); \
            rm = max3(rm, p0[5], p1[4]); rm = max3(rm, p1[5], p0[6]); rm = max3(rm, p0[7], p1[6]); rm = max3(rm, p1[7], p0[8]); \
            rm = max3(rm, p0[9], p1[8]); rm = max3(rm, p1[9], p0[10]); rm = max3(rm, p0[11], p1[10]); rm = max3(rm, p1[11], p0[12]); \
            rm = max3(rm, p0[13], p1[12]); rm = max3(rm, p1[13], p0[14]); rm = max3(rm, p0[15], p1[14]); rm = max3(rm, p1[15], rm); \
            rm = fmaxf(rm, __shfl_xor(rm, 32)); \
            if (FIRST_) { m = rm;                                         \
                _Pragma("unroll") for (int q = 0; q < 16; ++q) { p0[q] -= rm; p1[q] -= rm; } } \
            else if (__any(rm > THR)) { \
                const float dl = fmaxf(rm, 0.f), alpha = __builtin_amdgcn_exp2f(-dl); m += dl; \
                _Pragma("unroll") for (int q = 0; q < 16; ++q) { p0[q] -= dl; p1[q] -= dl; } \
                if (hi == 0) wsf[r] = alpha; \
                asm volatile("s_waitcnt lgkmcnt(0)" ::: "memory"); \
                _Pragma("unroll") for (int g4 = 0; g4 < 4; ++g4) { const f32x4 a4 = *(const LAS f32x4*)(wsf + 8 * g4 + 4 * hi);     \
                    _Pragma("unroll") for (int e = 0; e < 4; ++e) { ol[4 * g4 + e] *= a4[e]; \
                        _Pragma("unroll") for (int d = 0; d < 4; ++d) o[d][4 * g4 + e] *= a4[e]; } \
                    __builtin_amdgcn_sched_barrier(0); } } \
            _Pragma("unroll") for (int q = 0; q < 16; ++q) { p0[q] = __builtin_amdgcn_exp2f(p0[q]); p1[q] = __builtin_amdgcn_exp2f(p1[q]); } } } while (0)
#define ATT_VRD(dst, s_) do { dst##0l = rdtr<(s_) * 2048>(va); dst##0h = rdtr<(s_) * 2048 + 512>(va); dst##1l = rdtr<(s_) * 2048 + 1024>(va); dst##1h = rdtr<(s_) * 2048 + 1536>(va); } while (0)
#define ATT_VWAIT(n, dst) asm volatile("s_waitcnt lgkmcnt(" #n ")" : "+v"(dst##0l), "+v"(dst##0h), "+v"(dst##1l), "+v"(dst##1h))
#define ATT_VF(dst, k) (bf16x8){dst##k##l[0], dst##k##l[1], dst##k##l[2], dst##k##l[3], dst##k##h[0], dst##k##h[1], dst##k##h[2], dst##k##h[3]}
#define ATT_PV(s_, dst, PA, PB) do { o[(s_) >> 1] = __builtin_amdgcn_mfma_f32_32x32x16_bf16(PA, ATT_VF(dst, 0), o[(s_) >> 1], 0, 0, 0); o[(s_) >> 1] = __builtin_amdgcn_mfma_f32_32x32x16_bf16(PB, ATT_VF(dst, 1), o[(s_) >> 1], 0, 0, 0); } while (0)
#define ATT_PACK(P, b8) __builtin_bit_cast(bf16x8, (u32x4){pg8::cvt_pk_bf16(P[b8 + 0], P[b8 + 1]), pg8::cvt_pk_bf16(P[b8 + 2], P[b8 + 3]), pg8::cvt_pk_bf16(P[b8 + 4], P[b8 + 5]), pg8::cvt_pk_bf16(P[b8 + 6], P[b8 + 7])})
#define ATT_H2(it_) do { const int _t = t_hi - (it_); \
        if (64 * _t <= q0 + 31) { const unsigned va = vl + (unsigned)(((it_) + 3) & 3) * SLOT; \
            v4i16 A0l, A0h, A1l, A1h, B0l, B0h, B1l, B1h; \
            ATT_VRD(A, 0); \
            const bf16x8 pa0 = ATT_PACK(p0, 0), pa1 = ATT_PACK(p0, 8), pa2 = ATT_PACK(p1, 0), pa3 = ATT_PACK(p1, 8); \
            ATT_VRD(B, 1); \
            ol = __builtin_amdgcn_mfma_f32_32x32x16_bf16(pa0, ones, ol, 0, 0, 0); ol = __builtin_amdgcn_mfma_f32_32x32x16_bf16(pa1, ones, ol, 0, 0, 0); \
            ol = __builtin_amdgcn_mfma_f32_32x32x16_bf16(pa2, ones, ol, 0, 0, 0); ol = __builtin_amdgcn_mfma_f32_32x32x16_bf16(pa3, ones, ol, 0, 0, 0); \
            ATT_VWAIT(4, A); ATT_PV(0, A, pa0, pa1); ATT_VRD(A, 2); ATT_VWAIT(4, B); ATT_PV(1, B, pa2, pa3); \
            ATT_VRD(B, 3); ATT_VWAIT(4, A); ATT_PV(2, A, pa0, pa1); ATT_VRD(A, 4); ATT_VWAIT(4, B); ATT_PV(3, B, pa2, pa3); \
            ATT_VRD(B, 5); ATT_VWAIT(4, A); ATT_PV(4, A, pa0, pa1); ATT_VRD(A, 6); ATT_VWAIT(4, B); ATT_PV(5, B, pa2, pa3); \
            ATT_VRD(B, 7); ATT_VWAIT(4, A); ATT_PV(6, A, pa0, pa1); ATT_VWAIT(0, B); ATT_PV(7, B, pa2, pa3); } \
        if ((it_) + 1 < NTu) ATT_PINIT((it_) + 1); } while (0)
    { const float m0 = m; (void)m0; ATT_PINIT(0); }
    if (c == 0) {
        ATT_WAIT_TILE(0, 2); ATT_BAR();
        ATT_H1(0, true);
        ATT_BAR();
        ATT_H2(0); if (3 < NTu) ATT_DMA(3);
        for (int it = 1; it < NTu; ++it) {
            ATT_WAIT_TILE(it, it + 2); ATT_BAR();
            ATT_H1(it, false);
            ATT_BAR();
            ATT_H2(it); if (it + 3 < NTu) ATT_DMA(it + 3);
        }
        ATT_BAR();
    } else {
        ATT_WAIT_TILE(0, 2); ATT_BAR();
        ATT_BAR();
        ATT_H1(0, true);
        ATT_WAIT_TILE(1, 2);
        ATT_BAR();
        ATT_H2(0); if (3 < NTu) ATT_DMA(3);
        for (int it = 1; it < NTu; ++it) {
            ATT_BAR();
            ATT_H1(it, false);
            if (it + 1 < NTu) ATT_WAIT_TILE(it + 1, it + 2);
            ATT_BAR();
            ATT_H2(it); if (it + 3 < NTu) ATT_DMA(it + 3);
        }
    }
    float rl[16];
#pragma unroll
    for (int q = 0; q < 16; ++q) rl[q] = (c == 1 ? lam : 1.f) * __builtin_amdgcn_rcpf(ol[q]);
#pragma unroll
    for (int d0 = 0; d0 < 4; ++d0)
#pragma unroll
        for (int q = 0; q < 16; ++q) o[d0][q] *= rl[q];
    ATT_BAR();
    if (nvalid) { const size_t nhrow = (size_t)(nb * 8 + nh) * S; LAS unsigned char* _s = lds + 3 * SLOT;
        const char* _kb = (const char*)(proj + PO_DK + nhrow * 128) + (size_t)(2 * nqb + 1) * 16384; const char* _vb = (const char*)(proj + PO_DV + nhrow * 128) + (size_t)(2 * nqb + 1) * 16384;
#pragma unroll
        for (int _j = 0; _j < 2; ++_j) __builtin_amdgcn_global_load_lds((const unsigned*)(_kb + kof[_j]), (LAS unsigned*)(_s + KOFF + (wid + 8 * _j) * 1024), 16, 0, 0);
#pragma unroll
        for (int _j = 0; _j < 2; ++_j) __builtin_amdgcn_global_load_lds((const unsigned*)(_vb + vof[_j]), (LAS unsigned*)(_s + VOFF + (wid + 8 * _j) * 1024), 16, 0, 0);
        const bf16* nQg = proj + PO_DQ + (nhrow + 128 * nqb + 32 * sb + r) * 128 + c * 64 + hi * 8;
        qn0 = *(const bf16x8*)(nQg); qn1 = *(const bf16x8*)(nQg + 16); qn2 = *(const bf16x8*)(nQg + 32); qn3 = *(const bf16x8*)(nQg + 48); }
    else { qn0 = (bf16x8){}; qn1 = (bf16x8){}; qn2 = (bf16x8){}; qn3 = (bf16x8){}; }
    { LAS f32x4* XE = (LAS f32x4*)(lds + LDS_X) + ((c * 4 + sb) * 8) * 64 + lane;
        if (c == 0) {
#pragma unroll
            for (int j = 0; j < 8; ++j) XE[j * 64] = (f32x4){o[2 + (j >> 2)][4 * (j & 3)], o[2 + (j >> 2)][4 * (j & 3) + 1], o[2 + (j >> 2)][4 * (j & 3) + 2], o[2 + (j >> 2)][4 * (j & 3) + 3]};
        } else {
#pragma unroll
            for (int j = 0; j < 8; ++j) XE[j * 64] = (f32x4){o[j >> 2][4 * (j & 3)], o[j >> 2][4 * (j & 3) + 1], o[j >> 2][4 * (j & 3) + 2], o[j >> 2][4 * (j & 3) + 3]};
        } }
    ATT_BAR();
    float v[2][16], ss[16];
    { const LAS f32x4* XR = (const LAS f32x4*)(lds + LDS_X) + (((c ^ 1) * 4 + sb) * 8) * 64 + lane;
        f32x4 pr[8];
#pragma unroll
        for (int j = 0; j < 8; ++j) pr[j] = XR[j * 64];
        if (c == 0) {
#pragma unroll
            for (int k = 0; k < 2; ++k)
#pragma unroll
                for (int q = 0; q < 16; ++q) v[k][q] = o[k][q] - pr[4 * k + (q >> 2)][q & 3];
        } else {
#pragma unroll
            for (int k = 0; k < 2; ++k)
#pragma unroll
                for (int q = 0; q < 16; ++q) v[k][q] = pr[4 * k + (q >> 2)][q & 3] - o[2 + k][q];
        } }
#pragma unroll
    for (int q = 0; q < 16; ++q) { ss[q] = rowsum16(v[0][q] * v[0][q] + v[1][q] * v[1][q]); ss[q] += __shfl_xor(ss[q], 16); }
    LAS f32x4* XS = (LAS f32x4*)(lds + LDS_XS);
    if (r == 0) {
#pragma unroll
        for (int j = 0; j < 4; ++j) XS[((c * 4 + sb) * 2 + hi) * 4 + j] = (f32x4){ss[4 * j], ss[4 * j + 1], ss[4 * j + 2], ss[4 * j + 3]}; }
    ATT_BAR();
    {
#pragma unroll
        for (int j = 0; j < 4; ++j) { const f32x4 ps = XS[(((c ^ 1) * 4 + sb) * 2 + hi) * 4 + j];
#pragma unroll
            for (int e = 0; e < 4; ++e) ss[4 * j + e] = __builtin_amdgcn_rsqf((ss[4 * j + e] + ps[e]) * (1.f / 128) + EPS) * (1.f - LAMBDA_INIT); } }
    LAS bf16* Y = (LAS bf16*)(lds + LDS_Y) + sb * 32 * 128;
    { const int dA = 2 * c; const LAS float* gL = (const LAS float*)(lds + LDS_GSUB);
#pragma unroll
        for (int k = 0; k < 2; ++k) { const float g = gL[32 * (dA + k) + r];
#pragma unroll
            for (int q = 0; q < 16; ++q) Y[crow(q, hi) * 128 + 32 * (dA + k) + r] = f2bf(v[k][q] * ss[q] * g); } }
    ATT_BAR();
    { bf16* Og = odiff + (rowb + q0) * D + h * 128;
#pragma unroll
        for (int i = 0; i < 4; ++i) { const int row = 16 * c + 4 * i + (lane >> 4), ch = lane & 15; *(u32x4*)(Og + (size_t)row * D + ch * 8) = *(const LAS u32x4*)(Y + row * 128 + ch * 8); } }
    ATT_BAR();
#undef ATT_DMA
#undef ATT_H1
#undef ATT_H2
#undef ATT_PINIT
}
}

namespace ret {
typedef short v4i16 __attribute__((ext_vector_type(4)));
constexpr int STG = 98304;
#define RET_BAR() do { asm volatile("s_waitcnt lgkmcnt(0)" ::: "memory"); __builtin_amdgcn_s_barrier(); asm volatile("" ::: "memory"); } while (0)
__device__ __forceinline__ bf16x8 trfrag(LAS unsigned char* p, int second_off) {
    const v4i16 lo = __builtin_amdgcn_ds_read_tr16_b64_v4i16((LAS v4i16*)p), hh = __builtin_amdgcn_ds_read_tr16_b64_v4i16((LAS v4i16*)(p + second_off));
    return (bf16x8){lo[0], lo[1], lo[2], lo[3], hh[0], hh[1], hh[2], hh[3]};
}
__device__ __forceinline__ void store_tile64(const f32x16& t0, const f32x16& t1, LAS unsigned char* stg, bf16* __restrict__ gdst, const size_t gpitch, const int lane) {
    const int r = lane & 31, hi = lane >> 5;
#pragma unroll
    for (int q = 0; q < 16; ++q) { const int row = crow(q, hi); *(LAS bf16*)(stg + row * 128 + r * 2) = f2bf(t0[q]); *(LAS bf16*)(stg + row * 128 + 64 + r * 2) = f2bf(t1[q]); }
    asm volatile("s_waitcnt lgkmcnt(0)" ::: "memory");
#pragma unroll
    for (int i = 0; i < 4; ++i) { const int row = 8 * i + (lane >> 3), ch = lane & 7; *(u32x4*)(gdst + (size_t)row * gpitch + ch * 8) = *(const LAS u32x4*)(stg + row * 128 + ch * 16); }
    asm volatile("s_waitcnt lgkmcnt(0)" ::: "memory");
}
__device__ __forceinline__ void r1_unit(const int b, const int h, const int j, const bf16* __restrict__ proj, bf16* __restrict__ ubuf, LAS unsigned char* lds) {
    constexpr int KV = 0, VV = 32768;
    int tid = threadIdx.x; asm volatile("" : "+v"(tid));
    const int lane = tid & 63, hi = lane >> 5; const int wid = __builtin_amdgcn_readfirstlane(tid >> 6), db = wid & 3, cg = wid >> 2;
    const size_t hrow = (size_t)(b * 4 + h) * S + (size_t)j * 128;
    const bf16* Kg = proj + PO_RK + hrow * 128; const bf16* Vg = proj + PO_RV + hrow * 256;
#pragma unroll
    for (int i = 0; i < 4; ++i) { const int blk = wid * 4 + i, d_b = blk >> 3, mg = blk & 7;
        __builtin_amdgcn_global_load_lds((const unsigned*)(Kg + (size_t)(16 * mg + (lane >> 2)) * 128 + 32 * d_b + 8 * (lane & 3)), (LAS unsigned*)(lds + KV + blk * 1024), 16, 0, 0); }
#pragma unroll
    for (int i = 0; i < 8; ++i) { const int blk = wid * 8 + i, cb = blk >> 3, mg = blk & 7;
        __builtin_amdgcn_global_load_lds((const unsigned*)(Vg + (size_t)(16 * mg + (lane >> 2)) * 256 + 32 * cb + 8 * (lane & 3)), (LAS unsigned*)(lds + VV + blk * 1024), 16, 0, 0); }
    const int vperm = ((lane >> 4) & 1) * 32 + (lane & 3) * 8 + (4 * hi + ((lane & 15) >> 2)) * 64;
    f32x16 u[4];
#pragma unroll
    for (int t = 0; t < 4; ++t)
#pragma unroll
        for (int q = 0; q < 16; ++q) u[t][q] = 0.f;
    asm volatile("s_waitcnt vmcnt(0)" ::: "memory");
    RET_BAR();
#pragma unroll
    for (int m2 = 0; m2 < 4; ++m2) {
        bf16x8 a[2], bv[2][4];
#pragma unroll
        for (int s = 0; s < 2; ++s) { const int mg = 2 * m2 + s; a[s] = trfrag(lds + KV + (db * 8 + mg) * 1024 + vperm, 512);
#pragma unroll
            for (int t = 0; t < 4; ++t) bv[s][t] = trfrag(lds + VV + ((4 * cg + t) * 8 + mg) * 1024 + vperm, 512); }
#pragma unroll
        for (int s = 0; s < 2; ++s)
#pragma unroll
            for (int t = 0; t < 4; ++t) u[t] = __builtin_amdgcn_mfma_f32_32x32x16_bf16(a[s], bv[s][t], u[t], 0, 0, 0);
    }
    bf16* Ug = ubuf + (((size_t)b * 4 + h) * 32 + j) * 32768 + (size_t)(32 * db) * 256 + 128 * cg;
    LAS unsigned char* stg = lds + STG + wid * 4096;
    store_tile64(u[0], u[1], stg, Ug, 256, lane);
    store_tile64(u[2], u[3], stg, Ug + 64, 256, lane);
    RET_BAR();
}
__device__ __forceinline__ void r3_unit(const int b, const int h, const int j, const int half, const bf16* __restrict__ proj, const bf16* __restrict__ rbbuf, bf16* __restrict__ yret, LAS unsigned char* lds) {
    constexpr int KK = 0, VV = 32768, RB = 65536;
    int tid = threadIdx.x; asm volatile("" : "+v"(tid));
    const int lane = tid & 63, r = lane & 31, hi = lane >> 5; const int wid = __builtin_amdgcn_readfirstlane(tid >> 6), sb = wid & 3, ch = wid >> 2;
    const size_t row0 = (size_t)b * S + (size_t)j * 128, hrow = (size_t)(b * 4 + h) * S + (size_t)j * 128;
    const bf16* Qg = proj + PO_RQ + hrow * 128; const bf16* Kg = proj + PO_RK + hrow * 128; const bf16* Vg = proj + PO_RV + hrow * 256 + half * 128;
    const bf16* Rg = rbbuf + (((size_t)b * 4 + h) * 32 + j) * 32768 + half * 128;
#pragma unroll
    for (int i = 0; i < 4; ++i) { const int pc = wid * 4 + i, cidx = pc >> 1, mh = pc & 1;
        __builtin_amdgcn_global_load_lds((const unsigned*)(Kg + (size_t)(64 * mh + lane) * 128 + cidx * 8), (LAS unsigned*)(lds + KK + cidx * 2048 + mh * 1024), 16, 0, 0); }
#pragma unroll
    for (int i = 0; i < 4; ++i) { const int blk = wid * 4 + i, cb = blk >> 3, mg = blk & 7;
        __builtin_amdgcn_global_load_lds((const unsigned*)(Vg + (size_t)(16 * mg + (lane >> 2)) * 256 + 32 * cb + 8 * (lane & 3)), (LAS unsigned*)(lds + VV + blk * 1024), 16, 0, 0);
        __builtin_amdgcn_global_load_lds((const unsigned*)(Rg + (size_t)(16 * mg + (lane >> 2)) * 256 + 32 * cb + 8 * (lane & 3)), (LAS unsigned*)(lds + RB + blk * 1024), 16, 0, 0); }
    bf16x8 qf[8];
#pragma unroll
    for (int ks = 0; ks < 8; ++ks) qf[ks] = *(const bf16x8*)(Qg + (size_t)(32 * sb + r) * 128 + 16 * ks + 8 * hi);
    const int vperm = ((lane >> 4) & 1) * 32 + (lane & 3) * 8 + (4 * hi + ((lane & 15) >> 2)) * 64;
    const int vnat  = ((lane >> 4) & 1) * 32 + (lane & 3) * 8 + (8 * hi + ((lane & 15) >> 2)) * 64;
    asm volatile("s_waitcnt vmcnt(0)" ::: "memory");
    RET_BAR();
    bf16x8 pa[8];
#pragma unroll
    for (int kb = 0; kb < 4; ++kb) {
        if (kb <= sb) {
            bf16x8 kf[8];
#pragma unroll
            for (int ks = 0; ks < 8; ++ks) kf[ks] = *(const LAS bf16x8*)(lds + KK + (2 * ks + hi) * 2048 + (32 * kb + r) * 16);
            f32x16 p;
#pragma unroll
            for (int q = 0; q < 16; ++q) p[q] = 0.f;
#pragma unroll
            for (int ks = 0; ks < 8; ++ks) p = __builtin_amdgcn_mfma_f32_32x32x16_bf16(kf[ks], qf[ks], p, 0, 0, 0);
            if (kb == sb) {
#pragma unroll
                for (int q = 0; q < 16; ++q) if (crow(q, hi) > r) p[q] = 0.f;
            }
#pragma unroll
            for (int b8 = 0; b8 < 2; ++b8) { u32x4 w;
                w.x = pg8::cvt_pk_bf16(p[8 * b8 + 0], p[8 * b8 + 1]); w.y = pg8::cvt_pk_bf16(p[8 * b8 + 2], p[8 * b8 + 3]); w.z = pg8::cvt_pk_bf16(p[8 * b8 + 4], p[8 * b8 + 5]); w.w = pg8::cvt_pk_bf16(p[8 * b8 + 6], p[8 * b8 + 7]);
                pa[2 * kb + b8] = __builtin_bit_cast(bf16x8, w); }
        }
    }
    f32x16 y[2];
#pragma unroll
    for (int d0 = 0; d0 < 2; ++d0) {
#pragma unroll
        for (int q = 0; q < 16; ++q) y[d0][q] = 0.f;
        const int cb = 2 * ch + d0;
        bf16x8 vf[8];
#pragma unroll
        for (int kk = 0; kk < 8; ++kk) if ((kk >> 1) <= sb) vf[kk] = trfrag(lds + VV + (cb * 8 + kk) * 1024 + vperm, 512);
#pragma unroll
        for (int kk = 0; kk < 8; ++kk) if ((kk >> 1) <= sb) y[d0] = __builtin_amdgcn_mfma_f32_32x32x16_bf16(pa[kk], vf[kk], y[d0], 0, 0, 0);
        bf16x8 rf[8];
#pragma unroll
        for (int ks = 0; ks < 8; ++ks) rf[ks] = trfrag(lds + RB + (cb * 8 + ks) * 1024 + vnat, 256);
#pragma unroll
        for (int ks = 0; ks < 8; ++ks) y[d0] = __builtin_amdgcn_mfma_f32_32x32x16_bf16(qf[ks], rf[ks], y[d0], 0, 0, 0);
    }
    bf16* Yg = yret + (row0 + 32 * sb) * D + h * 256 + half * 128 + 64 * ch;
    store_tile64(y[0], y[1], lds + STG + wid * 4096, Yg, D, lane);
    RET_BAR();
}
__device__ __forceinline__ float rbflo(unsigned u) { return __builtin_bit_cast(float, u << 16); }
__device__ __forceinline__ float rbfhi(unsigned u) { return __builtin_bit_cast(float, u & 0xffff0000u); }
__device__ __forceinline__ void r3m_unit(const int b, const int h, const int j, const bf16* __restrict__ proj, const bf16* __restrict__ rbbuf, const bf16* __restrict__ odiff, bf16* __restrict__ merged,
                                         const float* __restrict__ ggn, const float* __restrict__ bgn, LAS unsigned char* lds) {
    constexpr int KK = 0, VV = 32768, RB = 65536, XS = 98304;
    int tid = threadIdx.x; asm volatile("" : "+v"(tid));
    const int lane = tid & 63, r = lane & 31, hi = lane >> 5; const int wid = __builtin_amdgcn_readfirstlane(tid >> 6), sb = wid & 3, ch = wid >> 2;
    const size_t row0 = (size_t)b * S + (size_t)j * 128, hrow = (size_t)(b * 4 + h) * S + (size_t)j * 128;
    const bf16* Qg = proj + PO_RQ + hrow * 128; const bf16* Kg = proj + PO_RK + hrow * 128; const bf16* Vg = proj + PO_RV + hrow * 256;
    const bf16* Rg = rbbuf + (((size_t)b * 4 + h) * 32 + j) * 32768;
#pragma unroll
    for (int i = 0; i < 4; ++i) { const int pc = wid * 4 + i, cidx = pc >> 1, mh = pc & 1;
        __builtin_amdgcn_global_load_lds((const unsigned*)(Kg + (size_t)(64 * mh + lane) * 128 + cidx * 8), (LAS unsigned*)(lds + KK + cidx * 2048 + mh * 1024), 16, 0, 0); }
#define R3M_DMA_VR(half_) do { _Pragma("unroll") for (int i = 0; i < 4; ++i) { const int blk = wid * 4 + i, cb = blk >> 3, mg = blk & 7; \
        __builtin_amdgcn_global_load_lds((const unsigned*)(Vg + (half_) * 128 + (size_t)(16 * mg + (lane >> 2)) * 256 + 32 * cb + 8 * (lane & 3)), (LAS unsigned*)(lds + VV + blk * 1024), 16, 0, 0); \
        __builtin_amdgcn_global_load_lds((const unsigned*)(Rg + (half_) * 128 + (size_t)(16 * mg + (lane >> 2)) * 256 + 32 * cb + 8 * (lane & 3)), (LAS unsigned*)(lds + RB + blk * 1024), 16, 0, 0); } } while (0)
    R3M_DMA_VR(0);
    bf16x8 qf[8];
#pragma unroll
    for (int ks = 0; ks < 8; ++ks) qf[ks] = *(const bf16x8*)(Qg + (size_t)(32 * sb + r) * 128 + 16 * ks + 8 * hi);
    const int vperm = ((lane >> 4) & 1) * 32 + (lane & 3) * 8 + (4 * hi + ((lane & 15) >> 2)) * 64;
    const int vnat  = ((lane >> 4) & 1) * 32 + (lane & 3) * 8 + (8 * hi + ((lane & 15) >> 2)) * 64;
    asm volatile("s_waitcnt vmcnt(0)" ::: "memory");
    RET_BAR();
    bf16x8 pa[8];
#pragma unroll
    for (int kb = 0; kb < 4; ++kb) {
        if (kb <= sb) {
            bf16x8 kf[8];
#pragma unroll
            for (int ks = 0; ks < 8; ++ks) kf[ks] = *(const LAS bf16x8*)(lds + KK + (2 * ks + hi) * 2048 + (32 * kb + r) * 16);
            f32x16 p;
#pragma unroll
            for (int q = 0; q < 16; ++q) p[q] = 0.f;
#pragma unroll
            for (int ks = 0; ks < 8; ++ks) p = __builtin_amdgcn_mfma_f32_32x32x16_bf16(kf[ks], qf[ks], p, 0, 0, 0);
            if (kb == sb) {
#pragma unroll
                for (int q = 0; q < 16; ++q) if (crow(q, hi) > r) p[q] = 0.f;
            }
#pragma unroll
            for (int b8 = 0; b8 < 2; ++b8) { u32x4 w;
                w.x = pg8::cvt_pk_bf16(p[8 * b8 + 0], p[8 * b8 + 1]); w.y = pg8::cvt_pk_bf16(p[8 * b8 + 2], p[8 * b8 + 3]); w.z = pg8::cvt_pk_bf16(p[8 * b8 + 4], p[8 * b8 + 5]); w.w = pg8::cvt_pk_bf16(p[8 * b8 + 6], p[8 * b8 + 7]);
                pa[2 * kb + b8] = __builtin_bit_cast(bf16x8, w); }
        }
    }
    f32x16 y[2][2];
#define R3M_HALF(hf_) do { _Pragma("unroll") for (int d0 = 0; d0 < 2; ++d0) { \
        _Pragma("unroll") for (int q = 0; q < 16; ++q) y[hf_][d0][q] = 0.f; \
        const int cb = 2 * ch + d0; \
        bf16x8 vf[8]; \
        _Pragma("unroll") for (int kk = 0; kk < 8; ++kk) if ((kk >> 1) <= sb) vf[kk] = trfrag(lds + VV + (cb * 8 + kk) * 1024 + vperm, 512); \
        _Pragma("unroll") for (int kk = 0; kk < 8; ++kk) if ((kk >> 1) <= sb) y[hf_][d0] = __builtin_amdgcn_mfma_f32_32x32x16_bf16(pa[kk], vf[kk], y[hf_][d0], 0, 0, 0); \
        bf16x8 rf[8]; \
        _Pragma("unroll") for (int ks = 0; ks < 8; ++ks) rf[ks] = trfrag(lds + RB + (cb * 8 + ks) * 1024 + vnat, 256); \
        _Pragma("unroll") for (int ks = 0; ks < 8; ++ks) y[hf_][d0] = __builtin_amdgcn_mfma_f32_32x32x16_bf16(qf[ks], rf[ks], y[hf_][d0], 0, 0, 0); } } while (0)
    R3M_HALF(0);
    RET_BAR();
    R3M_DMA_VR(1);
    asm volatile("s_waitcnt vmcnt(0)" ::: "memory");
    RET_BAR();
    R3M_HALF(1);
    RET_BAR();
#undef R3M_DMA_VR
#undef R3M_HALF
    LAS unsigned char* stg = lds + wid * 8192;
#pragma unroll
    for (int hf = 0; hf < 2; ++hf)
#pragma unroll
        for (int d0 = 0; d0 < 2; ++d0)
#pragma unroll
            for (int q = 0; q < 16; ++q) *(LAS bf16*)(stg + crow(q, hi) * 256 + (hf * 64 + d0 * 32 + r) * 2) = f2bf(y[hf][d0][q]);
    asm volatile("s_waitcnt lgkmcnt(0)" ::: "memory");
    const int rs4 = lane >> 4, seg = lane & 15;
    u32x4 yv[8]; float sm[8], sq[8];
#pragma unroll
    for (int i = 0; i < 8; ++i) { yv[i] = *(const LAS u32x4*)(stg + (4 * i + rs4) * 256 + seg * 16);
        const float v0 = rbflo(yv[i].x), v1 = rbfhi(yv[i].x), v2 = rbflo(yv[i].y), v3 = rbfhi(yv[i].y), v4 = rbflo(yv[i].z), v5 = rbfhi(yv[i].z), v6 = rbflo(yv[i].w), v7 = rbfhi(yv[i].w);
        sm[i] = ((v0 + v1) + (v2 + v3)) + ((v4 + v5) + (v6 + v7)); sq[i] = ((v0 * v0 + v1 * v1) + (v2 * v2 + v3 * v3)) + ((v4 * v4 + v5 * v5) + (v6 * v6 + v7 * v7)); }
#pragma unroll
    for (int i = 0; i < 8; ++i) { sm[i] = rowsum16(sm[i]); sq[i] = rowsum16(sq[i]); }
    LAS float* xs = (LAS float*)(lds + XS);
    if (seg == 0) {
#pragma unroll
        for (int i = 0; i < 8; ++i) { xs[(wid * 32 + 4 * i + rs4) * 2] = sm[i]; xs[(wid * 32 + 4 * i + rs4) * 2 + 1] = sq[i]; } }
    RET_BAR();
    const int col = 256 * h + (seg < 8 ? 64 * ch + 8 * seg : 128 + 64 * ch + 8 * (seg - 8));
    const f32x4 g0 = *(const f32x4*)(ggn + col), g1 = *(const f32x4*)(ggn + col + 4), b0 = *(const f32x4*)(bgn + col), b1 = *(const f32x4*)(bgn + col + 4);
#pragma unroll
    for (int ib = 0; ib < 8; ib += 4) {
        u32x4 G1[4], G2[4], OD[4];
#pragma unroll
        for (int i = 0; i < 4; ++i) { const size_t tok = row0 + 32 * sb + 4 * (ib + i) + rs4;
            G1[i] = *(const u32x4*)(proj + PO_RG + tok * 1024 + col); G2[i] = *(const u32x4*)(proj + PO_MG + (size_t)T * 1024 + tok * 1024 + col); OD[i] = *(const u32x4*)(odiff + tok * D + col); }
#pragma unroll
        for (int i = 0; i < 4; ++i) { const int rw = 4 * (ib + i) + rs4; const size_t tok = row0 + 32 * sb + rw;
            const float ts = sm[ib + i] + xs[((wid ^ 4) * 32 + rw) * 2], tq = sq[ib + i] + xs[((wid ^ 4) * 32 + rw) * 2 + 1];
            const float mu = ts * (1.f / 256), rs = __builtin_amdgcn_rsqf(fmaxf(tq * (1.f / 256) - mu * mu, 0.f) + EPS);
            const unsigned yw[4] = {yv[ib + i].x, yv[ib + i].y, yv[ib + i].z, yv[ib + i].w}, g1w[4] = {G1[i].x, G1[i].y, G1[i].z, G1[i].w}, g2w[4] = {G2[i].x, G2[i].y, G2[i].z, G2[i].w}, odw[4] = {OD[i].x, OD[i].y, OD[i].z, OD[i].w};
            unsigned ow[4];
#pragma unroll
            for (int e = 0; e < 4; ++e) { const float gA = e < 2 ? g0[2 * e] : g1[2 * e - 4], gB = e < 2 ? g0[2 * e + 1] : g1[2 * e - 3], bA = e < 2 ? b0[2 * e] : b1[2 * e - 4], bB = e < 2 ? b0[2 * e + 1] : b1[2 * e - 3];
                const float mA = rbflo(g1w[e]) * ((rbflo(yw[e]) - mu) * rs * gA + bA) + rbflo(g2w[e]) * rbflo(odw[e]);
                const float mB = rbfhi(g1w[e]) * ((rbfhi(yw[e]) - mu) * rs * gB + bB) + rbfhi(g2w[e]) * rbfhi(odw[e]);
                ow[e] = pg8::cvt_pk_bf16(mA, mB); }
            *(u32x4*)(merged + tok * D + col) = (u32x4){ow[0], ow[1], ow[2], ow[3]}; }
    }
    RET_BAR();
}
}

struct Args { const float* in[23]; float* out; unsigned char* ws; int ph_lo, ph_hi; };
#define LDS_WAIT() asm volatile("s_waitcnt lgkmcnt(0)" ::: "memory")
__device__ __forceinline__ float wsum(float v) {
#pragma unroll
    for (int o = 1; o < 64; o <<= 1) v += __shfl_xor(v, o);
    return v;
}
__device__ __forceinline__ unsigned pk2(float lo, float hi) { return pg8::cvt_pk_bf16(lo, hi); }
__device__ __forceinline__ float bflo(unsigned u) { return __builtin_bit_cast(float, u << 16); }
__device__ __forceinline__ float bfhi(unsigned u) { return __builtin_bit_cast(float, u & 0xffff0000u); }

template <bool F8>
__device__ __forceinline__ void transpose_item(const float* __restrict__ W, int K, int N, bf16* __restrict__ WT, LAS float* scr, int k0, int n0, int l0, int lane) {
    float wv[32];
#pragma unroll
    for (int i = 0; i < 32; ++i) wv[i] = __builtin_nontemporal_load(W + (size_t)(k0 + 2 * i + (lane >> 5)) * N + l0 + (lane & 31));
#pragma unroll
    for (int i = 0; i < 32; ++i) scr[(2 * i + (lane >> 5)) * 33 + (lane & 31)] = wv[i];
    LDS_WAIT(); asm volatile("" ::: "memory");
    const int c = lane & 7;
#pragma unroll
    for (int j = 0; j < 4; ++j) { const int n = (lane >> 3) + 8 * j; const LAS float* s = scr + (8 * c) * 33 + n;
        if constexpr (F8) { u32x2 o; o.x = pk4_fp8(s[0 * 33], s[1 * 33], s[2 * 33], s[3 * 33], (float)(1 << W_SH)); o.y = pk4_fp8(s[4 * 33], s[5 * 33], s[6 * 33], s[7 * 33], (float)(1 << W_SH));
            *(u32x2*)((unsigned char*)WT + (size_t)(n0 + n) * K + k0 + 8 * c) = o; }
        else { u32x4 o; o.x = pk2(s[0 * 33], s[1 * 33]); o.y = pk2(s[2 * 33], s[3 * 33]); o.z = pk2(s[4 * 33], s[5 * 33]); o.w = pk2(s[6 * 33], s[7 * 33]);
            *(u32x4*)(WT + (size_t)(n0 + n) * K + k0 + 8 * c) = o; } }
    LDS_WAIT(); asm volatile("" ::: "memory");
}

__device__ __forceinline__ void transpose_pair_f8(const float* __restrict__ Wa, const float* __restrict__ Wb, int K, int N, unsigned char* __restrict__ WTa, unsigned char* __restrict__ WTb, LAS float* scr,
                                                  int k0a, int n0a, int l0a, int k0b, int n0b, int l0b, int lane) {
    float wa[32], wb[32];
#pragma unroll
    for (int i = 0; i < 32; ++i) wa[i] = __builtin_nontemporal_load(Wa + (size_t)(k0a + 2 * i + (lane >> 5)) * N + l0a + (lane & 31));
#pragma unroll
    for (int i = 0; i < 32; ++i) wb[i] = __builtin_nontemporal_load(Wb + (size_t)(k0b + 2 * i + (lane >> 5)) * N + l0b + (lane & 31));
    const int c = lane & 7;
#pragma unroll
    for (int p = 0; p < 2; ++p) {
#pragma unroll
        for (int i = 0; i < 32; ++i) scr[(2 * i + (lane >> 5)) * 33 + (lane & 31)] = p ? wb[i] : wa[i];
        LDS_WAIT(); asm volatile("" ::: "memory");
        unsigned char* WT = p ? WTb : WTa; const int k0 = p ? k0b : k0a, n0 = p ? n0b : n0a;
#pragma unroll
        for (int j = 0; j < 4; ++j) { const int n = (lane >> 3) + 8 * j; const LAS float* s = scr + (8 * c) * 33 + n;
            u32x2 o; o.x = pk4_fp8(s[0 * 33], s[1 * 33], s[2 * 33], s[3 * 33], (float)(1 << W_SH)); o.y = pk4_fp8(s[4 * 33], s[5 * 33], s[6 * 33], s[7 * 33], (float)(1 << W_SH));
            *(u32x2*)(WT + (size_t)(n0 + n) * K + k0 + 8 * c) = o; }
        LDS_WAIT(); asm volatile("" ::: "memory");
    }
}

__device__ __forceinline__ void phase_prologue(const Args& args, unsigned char* ws, LAS unsigned char* lds, int vcu, int G) {
    const int tid = threadIdx.x, lane = tid & 63, wave = __builtin_amdgcn_readfirstlane(tid >> 6);
    const float* c = args.in[1]; const float* w_ada = args.in[2]; const float* b_ada = args.in[3]; float* mod = (float*)(ws + WS_MOD);
    for (int blk = vcu; blk < 96; blk += G) {
        LAS float* sc = (LAS float*)lds;
        LAS float* part = (LAS float*)(lds + 32768);
        for (int i = tid; i < NB * D; i += 512) { const float v = c[i]; sc[i] = v * fast_sigmoid(v); }
        __syncthreads();
        float acc[NB];
#pragma unroll
        for (int b = 0; b < NB; ++b) acc[b] = 0.f;
        const float* wp = w_ada + (size_t)(wave * 128) * 6144 + blk * 64 + lane;
        for (int k0 = 0; k0 < 128; k0 += 32) { float wv[32];
#pragma unroll
            for (int k = 0; k < 32; ++k) wv[k] = __builtin_nontemporal_load(wp + (size_t)(k0 + k) * 6144);
#pragma unroll
            for (int k = 0; k < 32; ++k)
#pragma unroll
                for (int b = 0; b < NB; ++b) acc[b] += sc[b * D + wave * 128 + k0 + k] * wv[k]; }
#pragma unroll
        for (int b = 0; b < NB; ++b) part[(wave * NB + b) * 64 + lane] = acc[b];
        __syncthreads();
        { const int b = tid >> 6; float s = b_ada[blk * 64 + lane];
#pragma unroll
            for (int w = 0; w < 8; ++w) s += part[(w * NB + b) * 64 + lane];
            mod[b * 6144 + blk * 64 + lane] = s; }
        __syncthreads();
    }
    if (vcu == (96 % G)) {
        bf16* wrt = (bf16*)(ws + WS_WRT); const float* wr = args.in[17];
        for (int i = tid; i < NE * D; i += 512) { const int e = i >> 10, k = i & 1023; const float w = wr[(size_t)k * NE + e]; const bf16 hb_ = f2bf(w); wrt[i] = hb_; wrt[NE * D + i] = f2bf(w - bf2f(hb_)); }
    }
    LAS float* scr = (LAS float*)(lds + wave * 16384);
    const int gw = vcu * 8 + wave, NGW = G * 8;
    constexpr int I_IN = (D / 64) * (INW / 32), I_OUT = (D / 64) * (D / 32), I_W1 = (D / 64) * (2048 / 32), I_W2 = (FF / 64) * (D / 32);
    constexpr int I_IN8 = IN_GATE_F8 ? (D / 64) * (12 * 8) : 0;
    static_assert(MOE_W_IN_QUEUE == 1, "expert weights (and w_out) are transposed by items of the mixer work queue");
    constexpr int NV = I_IN8 + I_IN;
    const int ngem = G > 96 ? 96 : 0, own = ngem * 8;
    const int first = vcu < ngem ? vcu * 8 + wave : own + (vcu - ngem) * 8 + wave, step = vcu < ngem ? NV : (G - ngem) * 8;
    for (int v = first; v < NV; v += step) {
        if (v < I_IN8) { const int kb = v / 96, q = v % 96, tl = q >> 3, n0 = 256 * (tl < 8 ? 8 + tl : 20 + tl) + 32 * (q & 7);
            transpose_item<true>(args.in[5], D, INW, (bf16*)(ws + WS_WIN8), scr, 64 * kb, n0, in_p2l(n0), lane); }
        else { const int rr = v - I_IN8, nblk = INW / 32, kb = rr / nblk, nb = rr % nblk; transpose_item<FP8_IN != 0>(args.in[5], D, INW, (bf16*)(ws + WS_WIN), scr, 64 * kb, 32 * nb, in_p2l(32 * nb), lane); }
    }
    (void)gw; (void)NGW; (void)I_OUT; (void)I_W1; (void)I_W2;
}

__device__ __forceinline__ void wout_item(const Args& args, unsigned char* ws, LAS float* scr, int rr, int lane) {
    const int nblk = D / 32, kb = rr / nblk, nb = rr % nblk; transpose_item<FP8_OUT != 0>(args.in[15], D, D, (bf16*)(ws + WS_WOUT), scr, 64 * kb, 32 * nb, 32 * nb, lane);
}

__device__ __forceinline__ void moe_w_item(const Args& args, unsigned char* ws, LAS float* scr, int rr, int lane) {
    constexpr int I_W1 = (D / 64) * (2048 / 32), I_W2 = (FF / 64) * (D / 32);
    if (rr < NE * I_W1) { const int e = rr / I_W1, q = rr % I_W1, nblk = 2048 / 32, kb = q / nblk, nb = q % nblk;
        transpose_item<FP8_MOE != 0>(args.in[19] + (size_t)e * D * 2048, D, 2048, (bf16*)(ws + WS_W1 + (size_t)e * 2048 * D * (FP8_MOE ? 1 : 2)), scr, 64 * kb, 32 * nb, w1_p2l(32 * nb), lane); return; }
    rr -= NE * I_W1;
    { const int e = rr / I_W2, q = rr % I_W2, nblk = D / 32, kb = q / nblk, nb = q % nblk;
        transpose_item<FP8_MOE != 0>(args.in[21] + (size_t)e * FF * D, FF, D, (bf16*)(ws + WS_W2 + (size_t)e * D * FF * (FP8_MOE ? 1 : 2)), scr, 64 * kb, 32 * nb, 32 * nb, lane); }
}

__device__ __forceinline__ void moe_w_pair(const Args& args, unsigned char* ws, LAS float* scr, int pr, int lane) {
    constexpr int I_W1 = (D / 64) * (2048 / 32), I_W2 = (FF / 64) * (D / 32);
    int rr = 2 * pr;
    if (rr < NE * I_W1) { const int e = rr / I_W1, q = rr % I_W1, nblk = 2048 / 32, kb = q / nblk, nb = q % nblk; const float* W = args.in[19] + (size_t)e * D * 2048; unsigned char* WT = ws + WS_W1 + (size_t)e * 2048 * D;
        transpose_pair_f8(W, W, D, 2048, WT, WT, scr, 64 * kb, 32 * nb, w1_p2l(32 * nb), 64 * kb, 32 * (nb + 1), w1_p2l(32 * (nb + 1)), lane); return; }
    rr -= NE * I_W1;
    { const int e = rr / I_W2, q = rr % I_W2, nblk = D / 32, kb = q / nblk, nb = q % nblk; const float* W = args.in[21] + (size_t)e * FF * D; unsigned char* WT = ws + WS_W2 + (size_t)e * D * FF;
        transpose_pair_f8(W, W, FF, D, WT, WT, scr, 64 * kb, 32 * nb, 32 * nb, 64 * kb, 32 * (nb + 1), 32 * (nb + 1), lane); }
}

__device__ __forceinline__ void modnorm_row(const float* __restrict__ xrow, const float* __restrict__ g, const float* __restrict__ sc, const float* __restrict__ sh, bf16* __restrict__ orow, int lane, f32x4 (&v)[4]) {
    float ss = 0.f;
#pragma unroll
    for (int i = 0; i < 4; ++i) { v[i] = *(const f32x4*)(xrow + 4 * lane + 256 * i); ss += (v[i][0] * v[i][0] + v[i][1] * v[i][1]) + (v[i][2] * v[i][2] + v[i][3] * v[i][3]); }
    const float rs = __builtin_amdgcn_rsqf(wsum(ss) * (1.f / D) + EPS);
#pragma unroll
    for (int i = 0; i < 4; ++i) { const int cc = 4 * lane + 256 * i; const f32x4 gg = *(const f32x4*)(g + cc), s1 = *(const f32x4*)(sc + cc), s0 = *(const f32x4*)(sh + cc);
        v[i] = v[i] * rs * gg * (s1 + 1.f) + s0;
        u32x2 o; o.x = pk2(v[i][0], v[i][1]); o.y = pk2(v[i][2], v[i][3]); *(u32x2*)(orow + cc) = o; }
}
template <bool TILE, bool F8, bool XBF = false>
__device__ __forceinline__ void modnorm4(const float* __restrict__ xr, const float* __restrict__ g, const float* __restrict__ sc, const float* __restrict__ sh, bf16* __restrict__ orow, LAS unsigned char* tile, int rtp, int lane, unsigned char* __restrict__ orow8 = nullptr) {
    f32x4 v[4][4];
#pragma unroll
    for (int j = 0; j < 4; ++j)
#pragma unroll
        for (int i = 0; i < 4; ++i) { if constexpr (XBF) { const u32x2 w = *(const u32x2*)((const bf16*)xr + (size_t)j * D + 4 * lane + 256 * i); v[j][i] = (f32x4){bflo(w.x), bfhi(w.x), bflo(w.y), bfhi(w.y)}; }
            else v[j][i] = *(const f32x4*)(xr + (size_t)j * D + 4 * lane + 256 * i); }
    f32x4 gg[4], s1[4], s0[4];
#pragma unroll
    for (int i = 0; i < 4; ++i) { const int cc = 4 * lane + 256 * i; gg[i] = *(const f32x4*)(g + cc); s1[i] = *(const f32x4*)(sc + cc) + 1.f; s0[i] = *(const f32x4*)(sh + cc); gg[i] = gg[i] * s1[i]; }
#pragma unroll
    for (int j = 0; j < 4; ++j) { float ss = 0.f;
#pragma unroll
        for (int i = 0; i < 4; ++i) ss += (v[j][i][0] * v[j][i][0] + v[j][i][1] * v[j][i][1]) + (v[j][i][2] * v[j][i][2] + v[j][i][3] * v[j][i][3]);
        const float rs = __builtin_amdgcn_rsqf(wsum(ss) * (1.f / D) + EPS);
#pragma unroll
        for (int i = 0; i < 4; ++i) { const int cc = 4 * lane + 256 * i; const f32x4 o = v[j][i] * rs * gg[i] + s0[i];
            u32x2 pk; pk.x = pk2(o[0], o[1]); pk.y = pk2(o[2], o[3]);
            if constexpr (F8) *(unsigned*)((unsigned char*)orow + (size_t)j * D + cc) = pk4_fp8(o[0], o[1], o[2], o[3], (float)(1 << A_SH));
            else *(u32x2*)(orow + (size_t)j * D + cc) = pk;
            if (orow8) *(unsigned*)(orow8 + (size_t)j * D + cc) = pk4_fp8(o[0], o[1], o[2], o[3], (float)(1 << A_SH));
            if constexpr (TILE) *(LAS u32x2*)(tile + j * rtp + cc * 2) = pk; } }
}
__device__ __forceinline__ void phase_h1(const Args& args, unsigned char* ws, int vcu, int G) {
    const int lane = threadIdx.x & 63, wave = __builtin_amdgcn_readfirstlane(threadIdx.x >> 6); const float* mod = (const float*)(ws + WS_MOD); bf16* hb = (bf16*)(ws + WS_H);
    for (int t = (vcu * 8 + wave) * 4; t < T; t += G * 32) { const int b = t / S;
        modnorm4<false, FP8_IN != 0>(args.in[0] + (size_t)t * D, args.in[4], mod + b * 6144 + 1024, mod + b * 6144, (bf16*)((unsigned char*)hb + (size_t)t * D * (FP8_IN ? 1 : 2)), nullptr, 0, lane, IN_GATE_F8 ? ws + WS_H8 + (size_t)t * D : nullptr); }
}

__device__ __forceinline__ void phase_merge(const Args& args, unsigned char* ws, int vcu, int G) {
    const int lane = threadIdx.x & 63, wave = __builtin_amdgcn_readfirstlane(threadIdx.x >> 6);
    const bf16* proj = (const bf16*)(ws + WS_PROJ); const bf16* yret = (const bf16*)(ws + WS_YRET); const bf16* odiff = (const bf16*)(ws + WS_ODIFF); bf16* merged = (bf16*)(ws + WS_MRG);
    const float* ggn = args.in[6]; const float* bgn = args.in[7];
    f32x4 gg[4], bb[4];
#pragma unroll
    for (int i = 0; i < 4; ++i) { gg[i] = *(const f32x4*)(ggn + 4 * lane + 256 * i); bb[i] = *(const f32x4*)(bgn + 4 * lane + 256 * i); }
    constexpr int TB = 2;
    for (int t = (vcu * 8 + wave) * TB; t < T; t += G * 8 * TB) {
        u32x2 yy[TB][4], rg[TB][4], md[TB][4], od[TB][4];
#pragma unroll
        for (int j = 0; j < TB; ++j) { const bf16* prg = proj + PO_RG + (size_t)(t + j) * 1024; const bf16* pmg = proj + PO_MG + (size_t)(t + j) * 1024;
#pragma unroll
            for (int i = 0; i < 4; ++i) { const int cc = 4 * lane + 256 * i;
                yy[j][i] = *(const u32x2*)(yret + (size_t)(t + j) * D + cc); od[j][i] = *(const u32x2*)(odiff + (size_t)(t + j) * D + cc);
                rg[j][i] = *(const u32x2*)(prg + cc); md[j][i] = *(const u32x2*)(pmg + (size_t)T * 1024 + cc); } }
#pragma unroll
        for (int j = 0; j < TB; ++j)
#pragma unroll
            for (int i = 0; i < 4; ++i) { const int cc = 4 * lane + 256 * i;
                float y[4] = {bflo(yy[j][i].x), bfhi(yy[j][i].x), bflo(yy[j][i].y), bfhi(yy[j][i].y)};
                const float mu = wsum((y[0] + y[1]) + (y[2] + y[3])) * (1.f / 256);
                float vv = 0.f;
#pragma unroll
                for (int e = 0; e < 4; ++e) { y[e] -= mu; vv += y[e] * y[e]; }
                const float rs = __builtin_amdgcn_rsqf(wsum(vv) * (1.f / 256) + EPS);
                const float rgv[4] = {bflo(rg[j][i].x), bfhi(rg[j][i].x), bflo(rg[j][i].y), bfhi(rg[j][i].y)};
                const float mdv[4] = {bflo(md[j][i].x), bfhi(md[j][i].x), bflo(md[j][i].y), bfhi(md[j][i].y)}, odv[4] = {bflo(od[j][i].x), bfhi(od[j][i].x), bflo(od[j][i].y), bfhi(od[j][i].y)};
                float m[4];
#pragma unroll
                for (int e = 0; e < 4; ++e) m[e] = rgv[e] * (y[e] * rs * gg[i][e] + bb[i][e]) + mdv[e] * odv[e];
                if (FP8_OUT) *(unsigned*)((unsigned char*)merged + (size_t)(t + j) * D + cc) = pk4_fp8(m[0], m[1], m[2], m[3], (float)(1 << A_SH));
                else { u32x2 o; o.x = pk2(m[0], m[1]); o.y = pk2(m[2], m[3]); *(u32x2*)(merged + (size_t)(t + j) * D + cc) = o; } }
    }
}

constexpr int RT_PITCH = 2064;
constexpr int RT_H = 0, RT_P = 32 * RT_PITCH, RT_L = RT_P + 8 * 32 * 32 * 4, RT_CNT = RT_L + 128 * 33 * 4, RT_SEL = RT_CNT + 128;
static_assert(RT_SEL + 2048 <= LDS_STAGE_BYTES, "route LDS map");
__device__ __forceinline__ void phase_route(const Args& args, unsigned char* ws, LAS unsigned char* lds, int vcu, int G) {
    const int tid = threadIdx.x, lane = tid & 63, r = lane & 31, hi = lane >> 5, wave = __builtin_amdgcn_readfirstlane(tid >> 6);
    const float* mod = (const float*)(ws + WS_MOD); bf16* h2 = (bf16*)(ws + WS_H); unsigned* ctl = (unsigned*)(ws + WS_CTL);
    int* tok_e = (int*)(ws + WS_ROUTE); int* tok_pos = tok_e + T * 4; float* tok_w = (float*)(tok_pos + T * 4); int* list = (int*)(ws + WS_LIST);
    const bf16* wrt = (const bf16*)(ws + WS_WRT); const float* br = args.in[18];
    LAS unsigned* lcnt = (LAS unsigned*)(lds + RT_CNT); LAS unsigned* lsel = (LAS unsigned*)(lds + RT_SEL); LAS float* P = (LAS float*)(lds + RT_P); LAS float* L = (LAS float*)(lds + RT_L);
    bf16x8 bh[8], bl[8];
#pragma unroll
    for (int ks = 0; ks < 8; ++ks) { bh[ks] = *(const bf16x8*)(wrt + (size_t)r * D + 128 * wave + 16 * ks + 8 * hi); bl[ks] = *(const bf16x8*)(wrt + (size_t)(NE + r) * D + 128 * wave + 16 * ks + 8 * hi); }
    for (int t0 = vcu * 128; t0 < T; t0 += G * 128) {
        const int b = t0 / S;
        if (tid < NE) lcnt[tid] = 0u;
        const bf16* x1b = (const bf16*)(ws + WS_X1B); const float* sc2 = mod + b * 6144 + 4096; const float* sh2 = mod + b * 6144 + 3072;
        f32x4 gg[4], s0[4];
#pragma unroll
        for (int i = 0; i < 4; ++i) { const int cc = 4 * lane + 256 * i; gg[i] = *(const f32x4*)(args.in[16] + cc) * (*(const f32x4*)(sc2 + cc) + 1.f); s0[i] = *(const f32x4*)(sh2 + cc); }
        u32x2 xr[4][4];
#define RT_LOADX(sbi_) do { const size_t tr_ = (size_t)(t0 + 32 * (sbi_) + 4 * wave); _Pragma("unroll") for (int j = 0; j < 4; ++j) _Pragma("unroll") for (int i = 0; i < 4; ++i) \
            xr[j][i] = *(const u32x2*)(x1b + (tr_ + j) * D + 4 * lane + 256 * i); } while (0)
        RT_LOADX(0);
        for (int sbi = 0; sbi < 4; ++sbi) {
            { const int tl = 4 * wave; const size_t tr = (size_t)(t0 + 32 * sbi + tl);
#pragma unroll
                for (int j = 0; j < 4; ++j) { f32x4 v[4]; float ss = 0.f;
#pragma unroll
                    for (int i = 0; i < 4; ++i) { v[i] = (f32x4){bflo(xr[j][i].x), bfhi(xr[j][i].x), bflo(xr[j][i].y), bfhi(xr[j][i].y)};
                        ss += (v[i][0] * v[i][0] + v[i][1] * v[i][1]) + (v[i][2] * v[i][2] + v[i][3] * v[i][3]); }
                    const float rs = __builtin_amdgcn_rsqf(wsum(ss) * (1.f / D) + EPS);
#pragma unroll
                    for (int i = 0; i < 4; ++i) { const int cc = 4 * lane + 256 * i; const f32x4 o = v[i] * rs * gg[i] + s0[i];
                        u32x2 pk; pk.x = pk2(o[0], o[1]); pk.y = pk2(o[2], o[3]);
                        if (FP8_MOE) *(unsigned*)((unsigned char*)h2 + (tr + j) * D + cc) = pk4_fp8(o[0], o[1], o[2], o[3], (float)(1 << A_SH));
                        else *(u32x2*)(h2 + (tr + j) * D + cc) = pk;
                        *(LAS u32x2*)(lds + RT_H + (tl + j) * RT_PITCH + cc * 2) = pk; } } }
            if (sbi < 3) RT_LOADX(sbi + 1);
            __syncthreads();
            { f32x16 acc;
#pragma unroll
                for (int q = 0; q < 16; ++q) acc[q] = 0.f;
#pragma unroll
                for (int ks = 0; ks < 8; ++ks) { const bf16x8 a = *(const LAS bf16x8*)(lds + RT_H + r * RT_PITCH + (128 * wave + 16 * ks + 8 * hi) * 2);
                    acc = __builtin_amdgcn_mfma_f32_32x32x16_bf16(a, bh[ks], acc, 0, 0, 0); acc = __builtin_amdgcn_mfma_f32_32x32x16_bf16(a, bl[ks], acc, 0, 0, 0); }
#pragma unroll
                for (int q = 0; q < 16; ++q) P[(wave * 32 + crow(q, hi)) * 32 + r] = acc[q]; }
            __syncthreads();
#pragma unroll
            for (int u = 0; u < 2; ++u) { const int idx = tid + 512 * u, tk = idx >> 5, e = idx & 31; float s = br[e];
#pragma unroll
                for (int w = 0; w < 8; ++w) s += P[(w * 32 + tk) * 32 + e];
                L[(32 * sbi + tk) * 33 + e] = s; }
        }
#undef RT_LOADX
        __syncthreads();
        if (tid < 128) { const int t = t0 + tid;
            float lg[NE];
#pragma unroll
            for (int e = 0; e < NE; ++e) lg[e] = L[tid * 33 + e];
            unsigned used = 0u; float tv0 = 0.f, den = 0.f; float wv[TOPK]; int ev[TOPK];
#pragma unroll
            for (int k = 0; k < TOPK; ++k) { float best = -INFINITY; int bi = 0;
#pragma unroll
                for (int e = 0; e < NE; ++e) { const bool ok = !((used >> e) & 1u) && lg[e] > best; best = ok ? lg[e] : best; bi = ok ? e : bi; }
                used |= 1u << bi; if (k == 0) tv0 = best; wv[k] = __expf(best - tv0); den += wv[k]; ev[k] = bi; }
            const float rden = 1.f / den;
#pragma unroll
            for (int k = 0; k < TOPK; ++k) { const unsigned lp = atomicAdd((unsigned*)&lcnt[ev[k]], 1u);
                lsel[tid * 4 + k] = ((unsigned)ev[k] << 16) | lp; tok_e[t * 4 + k] = ev[k]; tok_w[t * 4 + k] = wv[k] * rden; } }
        __syncthreads();
        if (tid < NE) { const unsigned n = lcnt[tid]; lcnt[tid] = n ? atomicAdd(&ctl[CW_CNT + tid], n) : 0u; }
        __syncthreads();
        { const unsigned s = lsel[tid]; const int e = (int)(s >> 16); const int pos = (int)(lcnt[e] + (s & 0xffffu)); const int t = t0 + (tid >> 2);
            tok_pos[t * 4 + (tid & 3)] = pos; list[(size_t)e * T + pos] = t; }
        __syncthreads();
    }
}

__device__ __forceinline__ void phase_scan(unsigned char* ws, int vcu, int G) {
    const bf16* ubuf = (const bf16*)(ws + WS_H); bf16* rbbuf = (bf16*)(ws + WS_MERGED);
    for (int task = vcu * 512 + (int)threadIdx.x; task < 32 * 4096; task += G * 512) {
        const int bh = task >> 12, e8 = task & 4095, h = bh & 3;
        const float lg = __builtin_amdgcn_logf(1.f - __builtin_amdgcn_exp2f(-5.f - (float)h));
        const float gam = __builtin_amdgcn_exp2f(lg), gC = __builtin_amdgcn_exp2f(lg * 128.f), gC1 = __builtin_amdgcn_exp2f(lg * 127.f);
        const bf16* up = ubuf + (size_t)bh * 32 * 32768 + e8 * 8; bf16* rp = rbbuf + (size_t)bh * 32 * 32768 + e8 * 8;
        float R[8];
#pragma unroll
        for (int i = 0; i < 8; ++i) R[i] = 0.f;
        for (int j0 = 0; j0 < 32; j0 += 8) {
            u32x4 uv[8];
#pragma unroll
            for (int jj = 0; jj < 8; ++jj) uv[jj] = *(const u32x4*)(up + (size_t)(j0 + jj) * 32768);
#pragma unroll
            for (int jj = 0; jj < 8; ++jj) {
                u32x4 o; o.x = pk2(R[0] * gam, R[1] * gam); o.y = pk2(R[2] * gam, R[3] * gam); o.z = pk2(R[4] * gam, R[5] * gam); o.w = pk2(R[6] * gam, R[7] * gam);
                *(u32x4*)(rp + (size_t)(j0 + jj) * 32768) = o;
#pragma unroll
                for (int q = 0; q < 4; ++q) { R[2 * q] = gC * R[2 * q] + gC1 * bflo(uv[jj][q]); R[2 * q + 1] = gC * R[2 * q + 1] + gC1 * bfhi(uv[jj][q]); } }
        }
    }
}

__device__ __forceinline__ int build_expert_tables(const unsigned* ctl, LAS unsigned* rbtab, LAS unsigned* rbfirst) {
    if (threadIdx.x < 64) {
        const int e = threadIdx.x & 31; const unsigned c = __hip_atomic_load(&ctl[CW_CNT + e], __ATOMIC_RELAXED, __HIP_MEMORY_SCOPE_AGENT), nb = (c + 255u) >> 8;
        unsigned inc = nb;
#pragma unroll
        for (int o = 1; o < 32; o <<= 1) { const unsigned t = __shfl_up(inc, o, 32); inc += (e >= o) ? t : 0u; }
        const unsigned rb = inc - nb;
        if (threadIdx.x < 32) { rbfirst[e] = rb; if (e == NE - 1) rbfirst[NE] = inc; for (unsigned i = 0; i < nb; ++i) rbtab[rb + i] = (unsigned)e; } }
    __syncthreads();
    return __builtin_amdgcn_readfirstlane((int)rbfirst[NE]);
}

__device__ __forceinline__ void phase_combine(const Args& args, unsigned char* ws, const LAS unsigned* rbfirst, int vcu, int G) {
    const int lane = threadIdx.x & 63, wave = __builtin_amdgcn_readfirstlane(threadIdx.x >> 6);
    const float* mod = (const float*)(ws + WS_MOD); const unsigned char* eo = ws + WS_EO; const bf16* x1b = (const bf16*)(ws + WS_X1B);
    const int* tok_e = (const int*)(ws + WS_ROUTE); const int* tok_pos = tok_e + T * 4; const float* tok_w = (const float*)(tok_pos + T * 4);
    constexpr int TB = 2; constexpr float ESC = 1.f / (float)(1 << E_SH);
    typedef float f32x2_t __attribute__((ext_vector_type(2)));
    for (int t = (vcu * 8 + wave) * TB; t < T; t += G * 8 * TB) { const int b = t / S;
        const unsigned char* rp[TB][TOPK]; float w[TB][TOPK];
#pragma unroll
        for (int j = 0; j < TB; ++j)
#pragma unroll
            for (int k = 0; k < TOPK; ++k) { const int e = tok_e[(t + j) * 4 + k]; rp[j][k] = eo + ((size_t)rbfirst[e] * 256 + tok_pos[(t + j) * 4 + k]) * D; w[j][k] = tok_w[(t + j) * 4 + k] * ESC; }
        unsigned ev[TB][TOPK][4]; u32x2 xv[TB][4];
#pragma unroll
        for (int j = 0; j < TB; ++j)
#pragma unroll
            for (int i = 0; i < 4; ++i) { const int cc = 4 * lane + 256 * i; xv[j][i] = *(const u32x2*)(x1b + (size_t)(t + j) * D + cc);
#pragma unroll
                for (int k = 0; k < TOPK; ++k) ev[j][k][i] = *(const unsigned*)(rp[j][k] + cc); }
#pragma unroll
        for (int i = 0; i < 4; ++i) { const int cc = 4 * lane + 256 * i; const f32x4 gt = *(const f32x4*)(mod + b * 6144 + 5120 + cc);
#pragma unroll
            for (int j = 0; j < TB; ++j) { f32x4 y = {0.f, 0.f, 0.f, 0.f};
#pragma unroll
                for (int k = 0; k < TOPK; ++k) { const f32x2_t lo = __builtin_amdgcn_cvt_pk_f32_fp8((int)ev[j][k][i], false), hi2 = __builtin_amdgcn_cvt_pk_f32_fp8((int)ev[j][k][i], true);
                    y[0] += w[j][k] * lo[0]; y[1] += w[j][k] * lo[1]; y[2] += w[j][k] * hi2[0]; y[3] += w[j][k] * hi2[1]; }
                const f32x4 x1 = (f32x4){bflo(xv[j][i].x), bfhi(xv[j][i].x), bflo(xv[j][i].y), bfhi(xv[j][i].y)};
                *(f32x4*)(args.out + (size_t)(t + j) * D + cc) = x1 + gt * y; } }
    }
}

enum Phase { PH_PRO = 0, PH_H1 = 1, PH_INPROJ = 2, PH_MIX = 3, PH_MERGE = 4, PH_OUTPROJ = 5, PH_ROUTE = 6, PH_MOE1 = 7, PH_MOE2 = 8, PH_COMB = 9, PH_END = 10 };
constexpr int CW_BAR = 4096;
__global__ void __launch_bounds__(512, 2) mk_fwd(Args args) {
    extern __shared__ __attribute__((aligned(16))) unsigned char lds_raw[];
    LAS unsigned char* lds = (LAS unsigned char*)lds_raw;
    volatile LAS unsigned* MISC = (volatile LAS unsigned*)(lds + LDS_MISC);
    const int tid = threadIdx.x, G = gridDim.x;
    const int vcu = (G % 8 == 0) ? ((int)blockIdx.x % 8) * (G / 8) + (int)blockIdx.x / 8 : (int)blockIdx.x;
    unsigned char* ws = args.ws; unsigned* ctl = (unsigned*)(ws + WS_CTL);
    const float* mod = (const float*)(ws + WS_MOD);
    bf16* hb = (bf16*)(ws + WS_H); bf16* proj = (bf16*)(ws + WS_PROJ); bf16* merged = (bf16*)(ws + WS_MRG);
    bf16* win_t = (bf16*)(ws + WS_WIN); bf16* wout_t = (bf16*)(ws + WS_WOUT); bf16* w1t = (bf16*)(ws + WS_W1); bf16* w2t = (bf16*)(ws + WS_W2);
    bf16* act = (bf16*)(ws + WS_ACT); bf16* eo = (bf16*)(ws + WS_EO); const int* list = (const int*)(ws + WS_LIST);
    for (int u = tid; u < 64; u += 512) MISC[u] = 0u;
    __syncthreads();
    const int lo = args.ph_lo, hi = args.ph_hi;
    XcdBarrier bar = xcd_barrier_post(ctl + CW_BAR, MISC + 8);
#define IN(k) (lo <= (k) && (k) < hi)
#define SEAM(k) do { if (IN(k) && IN((k) + 1)) xcd_barrier(bar); } while (0)
    LAS unsigned* gtab = (LAS unsigned*)(lds + LDS_GTAB); LAS unsigned* rbtab = (LAS unsigned*)(lds + LDS_RB2E); LAS float* gqk = (LAS float*)(lds + LDS_GQK); LAS unsigned* rbfirst = (LAS unsigned*)(lds + LDS_RBF);

    if (IN(PH_PRO)) { phase_prologue(args, ws, lds, vcu, G); __syncthreads(); }
    SEAM(PH_PRO);
    if (IN(PH_H1)) phase_h1(args, ws, vcu, G);
    SEAM(PH_H1);
    if (IN(PH_INPROJ)) {
        if (tid < 64) gqk[tid] = args.in[8][tid] * C2; else if (tid < 128) gqk[tid] = args.in[9][tid - 64];
        __syncthreads();
        EpiIn E{proj, gqk};
        if (IN_GATE_F8) {
            struct MapOrder { pg8::StaticOrder s; int split, add0, add1;
                __device__ bool next(int i, pg8::GUnit& u) const { const bool r = s.next(i, u); u.pn += u.pn < split ? add0 : add1; return r; } };
            MapOrder Sa; Sa.s.init(T / 256, 20, G, (int)blockIdx.x, nullptr, nullptr); Sa.split = 8; Sa.add0 = 0; Sa.add1 = 8;
            pg8::gemm_phase<EpiIn, MapOrder, false, false>(lds + LDS_STAGE, hb, win_t, 0, D, Sa, E, nullptr, gtab, 127 - A_SH, 127 - W_SH);
            MapOrder Sb; Sb.s.init(T / 256, 12, G, (int)blockIdx.x, nullptr, nullptr); Sb.split = 8; Sb.add0 = 8; Sb.add1 = 20;
            pg8::gemm_phase<EpiIn, MapOrder, false, true>(lds + LDS_STAGE, ws + WS_H8, ws + WS_WIN8, 0, D, Sb, E, nullptr, gtab, 127 - A_SH, 127 - W_SH);
        } else {
        pg8::StaticOrder So; So.init(T / 256, INW / 256, G, (int)blockIdx.x, nullptr, nullptr);
        pg8::gemm_phase<EpiIn, pg8::StaticOrder, false, FP8_IN != 0>(lds + LDS_STAGE, hb, win_t, 0, D, So, E, nullptr, gtab, 127 - A_SH, 127 - W_SH);
        }
    }
    SEAM(PH_INPROJ);
    if (IN(PH_MIX)) {
        float a1 = 0.f, a2 = 0.f, gm = 0.f;
        for (int d = 0; d < 64; ++d) { a1 += args.in[10][d] * args.in[11][d]; a2 += args.in[12][d] * args.in[13][d]; gm = fmaxf(gm, fabsf(args.in[8][d] * args.in[9][d])); }
        const float lam = __expf(a1) - __expf(a2) + LAMBDA_INIT;
        bf16* odiff = (bf16*)(ws + WS_ODIFF);
        const float w2 = 2.f * 8.f * gm * LOG2E * 1.03f + 32.f;
        LAS unsigned* cost = (LAS unsigned*)(lds + LDS_RB2E); LAS unsigned* order = cost + 256;
        if (tid >= 256 && tid < 384) ((LAS float*)(lds + att::LDS_GSUB))[tid - 256] = args.in[14][tid - 256];
        if (tid < 256) { const int h = tid >> 5, qb = tid & 31; const float slope2 = __builtin_amdgcn_exp2f(-(float)(h + 1)) * LOG2E;
            const float x = (float)(128 * qb - 63) - w2 / slope2; const int t_lo = x <= 0.f ? 0 : (int)ceilf(x * (1.f / 64.f));
            cost[tid] = (unsigned)(2 * qb + 2 - t_lo) | ((unsigned)t_lo << 16); }
        __syncthreads();
        if (tid < 256) { const unsigned mine = cost[tid] & 0xffffu; int rank = 0;
            for (int k = 0; k < 256; ++k) { const unsigned ck = cost[k] & 0xffffu; rank += (ck > mine || (ck == mine && k < tid)) ? 1 : 0; }
            order[rank] = (unsigned)tid | (cost[tid] & 0xffff0000u); }
        __syncthreads();
        static_assert(MOE_W_IN_QUEUE == 1, "the mixer queue carries the expert-weight items");
        constexpr unsigned NR1 = 1024u, NITEMS = NR1 + 2048u;
#ifndef MIX_REPS
#define MIX_REPS 1
#endif
        for (int rep = 0; rep < MIX_REPS; ++rep) {
        if (rep) xcd_barrier(bar);
        unsigned* qhead = &ctl[CW_Q + 64 * rep];
        unsigned n1 = 0u, n2 = 0u; bool prev_att = false; bf16x8 qn0 = {}, qn1 = {}, qn2 = {}, qn3 = {};
        if (tid == 0) { n1 = atomicAdd(qhead, 1u); n2 = atomicAdd(qhead, 1u); }
        for (;;) {
            if (tid == 0) { MISC[16] = n1; MISC[17] = n2; }
            __syncthreads();
            const unsigned item = MISC[16], nitem = MISC[17];
            if (item >= NITEMS) break;
            if (tid == 0) { n1 = n2; n2 = atomicAdd(qhead, 1u); }
            if (item < NR1) { ret::r1_unit((int)(item >> 7), (int)((item >> 5) & 3u), (int)(item & 31u), proj, (bf16*)(ws + WS_H), lds); prev_att = false; qn0 = (bf16x8){}; qn1 = (bf16x8){}; qn2 = (bf16x8){}; qn3 = (bf16x8){}; }
            else { const unsigned u = item - NR1, c0 = 3u * (u >> 1) + (u & 1u), nc = 1u + (u & 1u);
                if (u < 64u) wout_item(args, ws, (LAS float*)(lds + (tid >> 6) * 12288), (int)(u * 8u + (unsigned)(tid >> 6)), tid & 63);
                for (unsigned k = 0; k < nc; ++k) moe_w_pair(args, ws, (LAS float*)(lds + (tid >> 6) * 12288), (int)((c0 + k) * 8u + (unsigned)(tid >> 6)), tid & 63);
                __syncthreads();
                const unsigned oc = order[u >> 3]; const int cls = (int)(oc & 0xffffu);
                const bool nvalid = nitem >= NR1 && nitem < NITEMS; const unsigned nu = nvalid ? nitem - NR1 : 0u; const int ncls = (int)(order[nu >> 3] & 0xffffu);
                att::unit((int)(u & 7u), cls >> 5, cls & 31, (int)(oc >> 16), proj, odiff, lds, lam, args.in[14], prev_att, nvalid, (int)(nu & 7u), ncls >> 5, ncls & 31, qn0, qn1, qn2, qn3);
                prev_att = nvalid; }
        }
        __syncthreads();
        xcd_barrier(bar);
        phase_scan(ws, vcu, G);
        xcd_barrier(bar);
        if (FUSE_MERGE) {
            for (int u = vcu * 4; u < 1024; u += G * 4)
                for (int k = 0; k < 4; ++k) { const int id = u + k; ret::r3m_unit(id >> 7, (id >> 5) & 3, id & 31, proj, (const bf16*)(ws + WS_MERGED), odiff, (bf16*)(ws + WS_MRG), args.in[6], args.in[7], lds); }
        } else
        for (int u = vcu * 8; u < 2048; u += G * 8)
            for (int k = 0; k < 8; ++k) { const int id = u + k; ret::r3_unit(id >> 8, (id >> 6) & 3, (id >> 1) & 31, id & 1, proj, (const bf16*)(ws + WS_MERGED), (bf16*)(ws + WS_YRET), lds); }
        }
    }
    SEAM(PH_MIX);
    if (!FUSE_MERGE) { if (IN(PH_MERGE)) phase_merge(args, ws, vcu, G);
        SEAM(PH_MERGE); }
    if (IN(PH_OUTPROJ)) {
        pg8::StaticOrder So; So.init(T / 256, D / 256, G, (int)blockIdx.x, nullptr, nullptr);
        EpiOutF E{args.in[0], mod, (bf16*)(ws + WS_X1B)};
        pg8::gemm_phase<EpiOutF, pg8::StaticOrder, false, FP8_OUT != 0>(lds + LDS_STAGE, merged, wout_t, 0, D, So, E, nullptr, gtab, 127 - A_SH, 127 - W_SH);
    }
    SEAM(PH_OUTPROJ);
    if (IN(PH_ROUTE)) { phase_route(args, ws, lds, vcu, G); }
    SEAM(PH_ROUTE);
    if (IN(PH_MOE1)) {
        const int nrb = build_expert_tables(ctl, rbtab, rbfirst);
        pg8::StaticOrder So; So.init(nrb, 2048 / 256, G, (int)blockIdx.x, rbtab, rbfirst);
        LAS float* btab = (LAS float*)(lds + LDS_BTAB);
        EpiActF E{btab, act};
        pg8::gemm_phase<EpiActF, pg8::StaticOrder, true, FP8_MOE != 0, 1>(lds + LDS_STAGE, hb, w1t, (size_t)2048 * D * (FP8_MOE ? 1 : 2), D, So, E, list, gtab, 127 - A_SH, 127 - W_SH, args.in[20], btab);
    }
    SEAM(PH_MOE1);
    if (IN(PH_MOE2)) {
        const int nrb = build_expert_tables(ctl, rbtab, rbfirst);
        pg8::StaticOrder So; So.init(nrb, D / 256, G, (int)blockIdx.x, rbtab, rbfirst);
        LAS float* btab = (LAS float*)(lds + LDS_BTAB);
        EpiEOF E{btab, eo};
        pg8::gemm_phase<EpiEOF, pg8::StaticOrder, false, FP8_MOE != 0, 2, 1>(lds + LDS_STAGE, act, w2t, (size_t)D * FF * (FP8_MOE ? 1 : 2), FF, So, E, nullptr, gtab, 127 - A_SH, 127 - W_SH, args.in[22], btab);
    }
    SEAM(PH_MOE2);
    if (IN(PH_COMB)) { (void)build_expert_tables(ctl, rbtab, rbfirst); phase_combine(args, ws, rbfirst, vcu, G); }
#undef IN
#undef SEAM
}

static int g_grid = 0;
static void launch_phases(Args a, int lo, int hi, hipStream_t stream) {
    a.ph_lo = lo; a.ph_hi = hi;
    hipLaunchKernelGGL(mk_fwd, dim3(g_grid), dim3(512), LDS_BYTES, stream, a);
}
extern "C" void kernel_launch(void* const* d_in, const int* in_sizes, int n_in, void* d_out, int out_size, void* d_ws, size_t ws_size, hipStream_t stream) {
    if (n_in != 23 || ws_size < WS_END) { fprintf(stderr, "kernel_launch: unexpected inputs/workspace (%d, %zu)\n", n_in, ws_size); }
    unsigned char* ws = (unsigned char*)d_ws; float* out = (float*)d_out;

    if (g_grid == 0) {
        int dev = 0, cus = 0;
        if (hipGetDevice(&dev) != hipSuccess || hipDeviceGetAttribute(&cus, hipDeviceAttributeMultiprocessorCount, dev) != hipSuccess) { fprintf(stderr, "kernel_launch: device query failed\n"); g_grid = -1; return; }
        if (hipFuncSetAttribute((const void*)mk_fwd, hipFuncAttributeMaxDynamicSharedMemorySize, LDS_BYTES) != hipSuccess) { fprintf(stderr, "kernel_launch: hipFuncSetAttribute failed\n"); g_grid = -1; return; }
        g_grid = cus;
    }
    if (g_grid < 0) return;
    Args a{};
    for (int i = 0; i < 23; ++i) a.in[i] = (const float*)d_in[i];
    a.out = out; a.ws = ws;
    (void)hipMemsetAsync(ws, 0, 8 * MiB, stream);
    launch_phases(a, 0, PH_END, stream);
}
```

```cpp
#include <hip/hip_runtime.h>
#include <cstdio>
#include <cstdint>

typedef unsigned short bf16;
typedef short bf16x8 __attribute__((ext_vector_type(8)));
typedef float f32x4 __attribute__((ext_vector_type(4)));
typedef float f32x16 __attribute__((ext_vector_type(16)));
typedef unsigned u32x4 __attribute__((ext_vector_type(4)));
typedef unsigned u32x2 __attribute__((ext_vector_type(2)));

constexpr int NB = 8, S = 4096, T = NB * S, D = 1024, INW = 8192;
constexpr int NE = 32, TOPK = 4, FF = 1024;
constexpr size_t PO_RQ = 0, PO_RK = (size_t)T * 512, PO_RV = (size_t)T * 1024, PO_RG = (size_t)T * 2048, PO_DQ = (size_t)T * 3072, PO_DK = (size_t)T * 4096, PO_DV = (size_t)T * 5120, PO_MG = (size_t)T * 6144;
constexpr float EPS = 1e-6f;
constexpr float LOG2E = 1.4426950408889634f;
constexpr float C2 = 0.125f * LOG2E;
constexpr float LAMBDA_INIT = 0.2f;
#ifndef FP8_MOE
#define FP8_MOE 1
#endif
#ifndef FP8_IN
#define FP8_IN 0
#endif
#ifndef FP8_OUT
#define FP8_OUT 0
#endif
constexpr int W_SH = 5, A_SH = 2, E_SH = 3;
constexpr int NRB_MAX = 544;
constexpr int NR_MAX = NRB_MAX * 256;

constexpr size_t MiB = 1u << 20;
constexpr size_t WS_CTL = 0;
constexpr size_t WS_MOD = 1 * MiB;
constexpr size_t WS_WRT = 1 * MiB + 512 * 1024;
constexpr size_t WS_ROUTE = 2 * MiB;
constexpr size_t WS_LIST = 4 * MiB;
constexpr size_t WS_WIN = 8 * MiB;
constexpr size_t WS_WOUT = 24 * MiB;
constexpr size_t WS_W1 = 26 * MiB;
constexpr size_t WS_W2 = 154 * MiB;
constexpr size_t WS_H = 218 * MiB;
constexpr size_t WS_PROJ = 282 * MiB;
constexpr size_t WS_YRET = 794 * MiB;
constexpr size_t WS_ODIFF = 858 * MiB;
constexpr size_t WS_MERGED = 922 * MiB;
constexpr size_t WS_ACT = WS_PROJ;
constexpr size_t WS_EO = WS_PROJ + 272 * MiB;
#define IN_GATE_F8 1
#define MOE_W_IN_QUEUE 1
#define FUSE_MERGE 1
constexpr size_t WS_H8 = 858 * MiB;
constexpr size_t WS_WIN8 = 146 * MiB;
constexpr size_t WS_X1B = FUSE_MERGE ? 858 * MiB : 794 * MiB;
constexpr size_t WS_MRG = FUSE_MERGE ? 794 * MiB : 922 * MiB;
constexpr size_t WS_END = 986 * MiB;
constexpr int CW_CNT = 64;
constexpr int CW_ROWOFF = 128;
constexpr int CW_NRB = 192;
constexpr int CW_Q = 512;
constexpr int CW_RB2E = 256;

__device__ __forceinline__ float bf2f(bf16 v) { return __builtin_bit_cast(float, (unsigned)v << 16); }
__device__ __forceinline__ float rowsum16(float x) {
    x += __builtin_bit_cast(float, __builtin_amdgcn_update_dpp(0, __builtin_bit_cast(int, x), 0x128, 0xf, 0xf, false));
    x += __builtin_bit_cast(float, __builtin_amdgcn_update_dpp(0, __builtin_bit_cast(int, x), 0x124, 0xf, 0xf, false));
    x += __builtin_bit_cast(float, __builtin_amdgcn_update_dpp(0, __builtin_bit_cast(int, x), 0x122, 0xf, 0xf, false));
    x += __builtin_bit_cast(float, __builtin_amdgcn_update_dpp(0, __builtin_bit_cast(int, x), 0x121, 0xf, 0xf, false));
    return x; }
__device__ __forceinline__ bf16 f2bf(float f) { unsigned u = __builtin_bit_cast(unsigned, f); return (bf16)((u + 0x7fffu + ((u >> 16) & 1u)) >> 16); }
__host__ __device__ __forceinline__ int crow(int r, int hi) { return (r & 3) + 8 * (r >> 2) + 4 * hi; }
__device__ __forceinline__ float sigmoidf_(float x) { return 1.f / (1.f + __expf(-x)); }

__host__ __device__ __forceinline__ int tile_new2old(int t) { return t < 12 ? t : (t < 16 ? t + 12 : (t < 28 ? t - 4 : t)); }
__host__ __device__ __forceinline__ int in_p2l(int p) { const int tp = p >> 8, t = tile_new2old(tp), q = p & 255, bj = q >> 7, wc = (q >> 5) & 3, j = q & 31;
    if (tp >= 8 && tp < 16) return (bj ? 6144 : 2048) + (tp - 8) * 128 + (q & 127);
    return t * 256 + 64 * wc + 32 * bj + j; }
__host__ __device__ __forceinline__ int w1_p2l(int p) { const int t = p >> 8, q = p & 255, bj = q >> 7; return bj * 1024 + t * 128 + (q & 127); }

#define LAS __attribute__((address_space(3)))
#define GAS __attribute__((address_space(1)))
namespace pg8 {
constexpr int BM = 256, BK = 64, HALF = 128, HTB = HALF * BK * 2  , STAGE_BYTES = 8 * HTB, NXCD = 8, WGM = 8;

__host__ __device__ __forceinline__ int lds_byte(int r, int c) { const int st = (r >> 4) * 2 + (c >> 5), rr = r & 15, cc = c & 31, ob = rr * 64 + cc * 2; return st * 1024 + (ob ^ (((ob >> 9) & 1) << 5)); }
__host__ __device__ __forceinline__ void stage_rc(int b, int& R, int& C) { const int st = b / 1024, sb = b % 1024, swz = sb ^ (((sb >> 9) & 1) << 5); R = (st >> 1) * 16 + swz / 64; C = (st & 1) * 32 + (swz % 64) / 2; }
__host__ __device__ __forceinline__ int perm32(int rho) { const int n = rho >> 4, i = rho & 15; return 8 * (i >> 2) + 4 * n + (i & 3); }
struct GUnit { int pm, pn, e, g, s; };

struct StaticOrder {
    int nM, nN, nwg, G, c; const LAS unsigned* rb2e; const LAS unsigned* rbfirst;
    __device__ void init(int nM_, int nN_, int G_, int c_, const LAS unsigned* t, const LAS unsigned* f) { nM = nM_; nN = nN_; nwg = nM * nN; G = G_; c = c_; rb2e = t; rbfirst = f; }
    __device__ bool next(int i, GUnit& u) const {
        const long L = (long)i * G + c; if (L >= nwg) return false;
        int wgid = (int)L; { const int q = nwg / NXCD, r = nwg % NXCD, xcd = wgid % NXCD, off = wgid / NXCD; wgid = (xcd < r ? xcd * (q + 1) : r * (q + 1) + (xcd - r) * q) + off; }
        const int nig = WGM * nN, gid = wgid / nig, fm = gid * WGM, gsz = (nM - fm) < WGM ? (nM - fm) : WGM;
        u.pm = fm + ((wgid % nig) % gsz); u.pn = (wgid % nig) / gsz; u.e = rb2e ? __builtin_amdgcn_readfirstlane((int)rb2e[u.pm]) : 0; u.g = rb2e ? u.e * T + (u.pm - __builtin_amdgcn_readfirstlane((int)rbfirst[u.e])) * 256 : 0; return true;
    }
};

__device__ __forceinline__ unsigned cvt_pk_bf16(float lo, float hi) { unsigned r; asm volatile("v_cvt_pk_bf16_f32 %0, %1, %2" : "=v"(r) : "v"(lo), "v"(hi)); return r; }

template <class Epi, class Sched, bool GATHER, bool FP8 = false, int BIAS = 0, int BP = 0>
__device__ __forceinline__ void gemm_phase(LAS unsigned char* lds, const void* Aglob, const void* Bglob, const size_t bstride, const int K, const Sched& S, const Epi& E,
                                           const int* rowtok, LAS unsigned* gtab, const int sA = 127, const int sB = 127, const float* bias = nullptr, LAS float* btab = nullptr) {
    typedef int v4i_t __attribute__((ext_vector_type(4))); typedef int v8i_t __attribute__((ext_vector_type(8)));
    const int KB = FP8 ? K : 2 * K;
    const int tid = threadIdx.x, wid = __builtin_amdgcn_readfirstlane(tid >> 6), lane = tid & 63, wr = wid >> 2, wc = wid & 3, fr = lane & 15, fq = lane >> 4;
    const int nt = KB / 128;
    unsigned voffA[2], voffB[2];
#pragma unroll
    for (int i = 0; i < 2; ++i) { int R, C; stage_rc(tid * 16 + i * 8192, R, C);
        const int Rb = BP ? 64 * (R >> 5) + 16 * ((R >> 2) & 3) + 4 * ((R >> 4) & 1) + (R & 3) : (R & ~31) + perm32(R & 31);
        voffA[i] = (unsigned)(R * KB + C * 2); voffB[i] = (unsigned)(Rb * KB + C * 2); }
    constexpr unsigned kstep = 128u;
    const unsigned hstep = (unsigned)(HALF * KB);
    const unsigned hstepB = BP ? (unsigned)(8 * KB) : hstep;
    const unsigned tstep = 2u * hstep;
    const unsigned ldsw = (unsigned)wid * 1024u;
    const int aoff = lds_byte(wr * 64 + fr, fq * 8), boff = lds_byte(wc * 32 + fr, fq * 8);
#define PG8_SA(b, h) (((b) * 2 + (h)) * HTB)
#define PG8_SB(b, h) ((4 + (b) * 2 + (h)) * HTB)
#define PG8_STAGE(bufoff, gbase, voff) do { _Pragma("unroll") for (int _i = 0; _i < 2; ++_i) \
        __builtin_amdgcn_global_load_lds((const unsigned*)((const char*)(gbase) + (voff)[_i]), (LAS unsigned*)(lds + (bufoff) + ldsw + _i * 8192), 16, 0, 0); } while (0)
#define PG8_STAGE_A(b, h, kptr, VO) do { if constexpr (GATHER) { PG8_STAGE(PG8_SA(b, h), kptr, VO[h]); } else { PG8_STAGE(PG8_SA(b, h), (kptr) + (h) * hstep, voffA); } } while (0)
#define PG8_STAGE_A2(b, h, kptr) do { if constexpr (GATHER) { _Pragma("unroll") for (int _i = 0; _i < 2; ++_i) \
        __builtin_amdgcn_global_load_lds((const unsigned*)((const char*)(kptr) + (usen ? vN[h][_i] : vC[h][_i])), (LAS unsigned*)(lds + PG8_SA(b, h) + ldsw + _i * 8192), 16, 0, 0); } \
        else { PG8_STAGE(PG8_SA(b, h), (kptr) + (h) * hstep, voffA); } } while (0)
#define PG8_LD8(p_) __builtin_shufflevector(*(const LAS v4i_t*)(p_), *(const LAS v4i_t*)((p_) + 1024), 0, 1, 2, 3, 4, 5, 6, 7)
#define PG8_LDA(dst, b, h) do { if constexpr (FP8) { _Pragma("unroll") for (int m = 0; m < 4; ++m) dst##8[m] = PG8_LD8(lds + PG8_SA(b, h) + aoff + m * 2048); } \
        else { _Pragma("unroll") for (int m = 0; m < 4; ++m) _Pragma("unroll") for (int k = 0; k < 2; ++k) dst[m][k] = *(const LAS bf16x8*)(lds + PG8_SA(b, h) + aoff + m * 2048 + k * 1024); } } while (0)
#define PG8_LDB(dst, b, h) do { if constexpr (FP8) { _Pragma("unroll") for (int n = 0; n < 2; ++n) dst##8[n] = PG8_LD8(lds + PG8_SB(b, h) + boff + n * 2048); } \
        else { _Pragma("unroll") for (int n = 0; n < 2; ++n) _Pragma("unroll") for (int k = 0; k < 2; ++k) dst[n][k] = *(const LAS bf16x8*)(lds + PG8_SB(b, h) + boff + n * 2048 + k * 1024); } } while (0)
#define PG8_MMA(ai, bj, At, Bt) do { __builtin_amdgcn_s_setprio(1); \
        if constexpr (FP8) { _Pragma("unroll") for (int m = 0; m < 4; ++m) _Pragma("unroll") for (int n = 0; n < 2; ++n)   \
            asm volatile("v_mfma_scale_f32_16x16x128_f8f6f4 %0, %1, %2, %0, %3, %4 op_sel_hi:[0,0,0]" : "+v"(acc[ai][bj][m][n]) : "v"(Bt##8[n]), "v"(At##8[m]), "v"(sB), "v"(sA)); } \
        else { _Pragma("unroll") for (int m = 0; m < 4; ++m) _Pragma("unroll") for (int n = 0; n < 2; ++n) _Pragma("unroll") for (int k = 0; k < 2; ++k) \
            asm volatile("v_mfma_f32_16x16x32_bf16 %0, %1, %2, %0" : "+v"(acc[ai][bj][m][n]) : "v"(Bt[n][k]), "v"(At[m][k])); } \
        __builtin_amdgcn_s_setprio(0); } while (0)
#define PG8_MMA0(ai, bj, At, Bt) do { __builtin_amdgcn_s_setprio(1); \
        if constexpr (FP8) { _Pragma("unroll") for (int m = 0; m < 4; ++m) _Pragma("unroll") for (int n = 0; n < 2; ++n) \
            asm volatile("v_mfma_scale_f32_16x16x128_f8f6f4 %0, %1, %2, 0, %3, %4 op_sel_hi:[0,0,0]" : "=&v"(acc[ai][bj][m][n]) : "v"(Bt##8[n]), "v"(At##8[m]), "v"(sB), "v"(sA)); } \
        else { _Pragma("unroll") for (int m = 0; m < 4; ++m) _Pragma("unroll") for (int n = 0; n < 2; ++n) { \
            asm volatile("v_mfma_f32_16x16x32_bf16 %0, %1, %2, 0" : "=&v"(acc[ai][bj][m][n]) : "v"(Bt[n][0]), "v"(At[m][0])); \
            asm volatile("v_mfma_f32_16x16x32_bf16 %0, %1, %2, %0" : "+v"(acc[ai][bj][m][n]) : "v"(Bt[n][1]), "v"(At[m][1])); } } \
        __builtin_amdgcn_s_setprio(0); } while (0)
#define PG8_WAIT_V(n) asm volatile("s_waitcnt vmcnt(" #n ")" ::: "memory")
#define PG8_WAIT_L(n) asm volatile("s_waitcnt lgkmcnt(" #n ")" ::: "memory")
#define PG8_BAR __builtin_amdgcn_s_barrier()
#define PG8_SCHED __builtin_amdgcn_sched_barrier(0)
#define PG8_GTAB_DMA(g_, slot_) do { if (wid < 4) __builtin_amdgcn_global_load_lds((const unsigned*)(rowtok + (size_t)(g_) + tid), (LAS unsigned*)(gtab + (slot_) * 256 + wid * 64), 4, 0, 0); } while (0)
#define PG8_GOFF(dst, slot_) do { _Pragma("unroll") for (int _i = 0; _i < 2; ++_i) { int _R, _C; stage_rc(tid * 16 + _i * 8192, _R, _C); \
        _Pragma("unroll") for (int _h = 0; _h < 2; ++_h) dst[_h][_i] = gtab[(slot_) * 256 + _h * 128 + _R] * (unsigned)KB + (unsigned)(_C * 2); } } while (0)
#define PG8_BTAB_DMA(u_, slot_) do { if constexpr (BIAS != 0) { if (wid >= 4) { const int _i = tid - 256; \
        const float* _src = BIAS == 1 ? bias + (size_t)(u_).e * 2048 + (_i < 128 ? 128 * (u_).pn + _i : 1024 + 128 * (u_).pn + (_i - 128)) : bias + (size_t)(u_).e * 1024 + 256 * (u_).pn + _i; \
        __builtin_amdgcn_global_load_lds((const unsigned*)_src, (LAS unsigned*)(btab + (slot_) * 256 + (wid - 4) * 64), 4, 0, 0); } } } while (0)
    GUnit cur, nxt; int ui = 0;
    if (!S.next(0, cur)) return;
    cur.s = 0; PG8_BTAB_DMA(cur, 0);
    f32x4 acc[2][2][4][2];
    bf16x8 At[4][2], B0[2][2], B1[2][2]; v8i_t At8[4], B08[2], B18[2];
    unsigned vC[2][2], vN[2][2];
    if constexpr (GATHER) { PG8_GTAB_DMA(cur.g, 0); PG8_WAIT_V(0); PG8_BAR; PG8_GOFF(vC, 0); PG8_WAIT_L(0);
#pragma unroll
        for (int h = 0; h < 2; ++h)
#pragma unroll
            for (int i = 0; i < 2; ++i) vN[h][i] = vC[h][i]; }
    const char* cA = GATHER ? (const char*)Aglob : (const char*)Aglob + (size_t)cur.pm * tstep;
    const char* cB = (const char*)Bglob + (size_t)cur.e * bstride + (size_t)cur.pn * tstep;
    PG8_STAGE(PG8_SB(0, 0), cB, voffB); PG8_STAGE(PG8_SB(0, 1), cB + hstepB, voffB); PG8_STAGE_A(0, 0, cA, vC); PG8_STAGE_A(0, 1, cA, vC);
    if (wr == 1) PG8_BAR;
    PG8_WAIT_V(2); PG8_BAR;
    PG8_STAGE(PG8_SB(1, 0), cB + kstep, voffB); PG8_STAGE_A(1, 0, cA + kstep, vC); PG8_STAGE(PG8_SB(1, 1), cB + hstepB + kstep, voffB);
    PG8_WAIT_V(6); PG8_BAR;
    int sprev = 0;
    for (;;) {
        const bool has_next = S.next(ui + 1, nxt);
        if constexpr (GATHER) { if (has_next) PG8_GTAB_DMA(nxt.g, (ui + 1) & 1); }
        const char* nA = has_next ? (GATHER ? (const char*)Aglob : (const char*)Aglob + (size_t)nxt.pm * tstep) : cA;
        const char* nB = has_next ? (const char*)Bglob + (size_t)nxt.e * bstride + (size_t)nxt.pn * tstep : cB;
#define PG8_STEP(t, WV1, WV2, LASTOK, MM) do { \
            const bool last = (LASTOK) && ((t) == nt - 2); \
            const char* a1 = cA + (size_t)((t) + 1) * kstep; \
            const char* a2 = last ? nA : cA + (size_t)((t) + 2) * kstep; const char* b2 = last ? nB : cB + (size_t)((t) + 2) * kstep; \
            const char* a3 = a2 + kstep; const char* b3 = b2 + kstep; \
            if constexpr (GATHER) { if (last && has_next) { PG8_GOFF(vN, (ui + 1) & 1); } } \
            const bool usen = last && has_next; \
              \
            PG8_LDB(B0, 0, 0); PG8_LDB(B1, 0, 1); PG8_SCHED; PG8_LDA(At, 0, 0); PG8_STAGE_A(1, 1, a1, vC); \
            WV1; PG8_WAIT_L(0); PG8_BAR; MM(0, 0, At, B0); MM(0, 1, At, B1); PG8_BAR; PG8_SCHED; \
              \
            PG8_LDA(At, 0, 1); PG8_STAGE(PG8_SB(0, 0), b2, voffB); PG8_STAGE(PG8_SB(0, 1), b2 + hstepB, voffB); PG8_STAGE_A2(0, 0, a2); \
            WV2; PG8_WAIT_L(0); PG8_BAR; MM(1, 0, At, B0); MM(1, 1, At, B1); PG8_BAR; PG8_SCHED; \
              \
            PG8_LDB(B0, 1, 0); PG8_LDB(B1, 1, 1); PG8_SCHED; PG8_LDA(At, 1, 0); PG8_STAGE_A2(0, 1, a2); \
            PG8_WAIT_V(8); PG8_WAIT_L(0); PG8_BAR; PG8_MMA(0, 0, At, B0); PG8_MMA(0, 1, At, B1); PG8_BAR; PG8_SCHED; \
              \
            PG8_LDA(At, 1, 1); PG8_STAGE(PG8_SB(1, 0), b3, voffB); PG8_STAGE(PG8_SB(1, 1), b3 + hstepB, voffB); PG8_STAGE_A2(1, 0, a3); \
            PG8_WAIT_V(8); PG8_WAIT_L(0); PG8_BAR; PG8_MMA(1, 0, At, B0); PG8_MMA(1, 1, At, B1); PG8_BAR; PG8_SCHED; } while (0)
#define PG8_WAIT_VR() do { if (sprev >= 16) PG8_WAIT_V(24); else if (sprev >= 8) PG8_WAIT_V(16); else PG8_WAIT_V(8); } while (0)
        if constexpr (FP8) {
            PG8_STEP(0, PG8_WAIT_VR(), PG8_WAIT_VR(), false, PG8_MMA0);
            for (int t = 2; t < nt; t += 2) PG8_STEP(t, PG8_WAIT_V(8), PG8_WAIT_V(8), true, PG8_MMA);
        } else {
#define PG8_WAIT_VR2() do { if (sprev >= 8) PG8_WAIT_V(16); else PG8_WAIT_V(8); } while (0)
            PG8_STEP(0, PG8_WAIT_VR2(), PG8_WAIT_VR2(), false, PG8_MMA0);
            for (int t = 2; t < nt; t += 2) PG8_STEP(t, PG8_WAIT_V(8), PG8_WAIT_V(8), true, PG8_MMA);
        }
        if (wr == 0) PG8_BAR;
        asm volatile("s_nop 15\n\ts_nop 15\n\ts_nop 7" ::: "memory");
        E(acc, cur, wr, wc, fr, fq);
        sprev = Epi::nstores(cur);
        if (!has_next) break;
        cur = nxt; cA = nA; cB = nB; ++ui; cur.s = ui & 1;
        if constexpr (GATHER) {
#pragma unroll
            for (int h = 0; h < 2; ++h)
#pragma unroll
                for (int i = 0; i < 2; ++i) vC[h][i] = vN[h][i]; }
        if (wr == 1) PG8_BAR;
        PG8_BTAB_DMA(cur, ui & 1);
    }
    PG8_WAIT_V(0);
    PG8_BAR;
#undef PG8_SA
#undef PG8_SB
#undef PG8_STAGE
#undef PG8_STAGE_A
#undef PG8_STAGE_A2
#undef PG8_LDA
#undef PG8_LDB
#undef PG8_MMA
#undef PG8_MMA0
#undef PG8_LD8
#undef PG8_WAIT_V
#undef PG8_WAIT_VR
#undef PG8_STEP
#undef PG8_WAIT_L
#undef PG8_BAR
#undef PG8_SCHED
#undef PG8_GTAB_DMA
#undef PG8_BTAB_DMA
#undef PG8_GOFF
}
}

#define XB_TMO      128
#define XB_XCNT(j)  (256  + 64 * (j))
#define XB_XSUB(j)  (1280 + 64 * (j))
#define XB_XGEN(j)  (2304 + 64 * (j))
#define XB_TOP      3328
#define XB_TOPGEN   3392
#define XCD_BAR_WORDS 3456
#define XB_SPIN_CAP (1u << 24)

__device__ __forceinline__ unsigned xb_ld(unsigned* p)              { return __hip_atomic_load(p, __ATOMIC_RELAXED, __HIP_MEMORY_SCOPE_AGENT); }
__device__ __forceinline__ unsigned xb_add(unsigned* p, unsigned v) { return __hip_atomic_fetch_add(p, v, __ATOMIC_RELAXED, __HIP_MEMORY_SCOPE_AGENT); }
__device__ __forceinline__ unsigned xb_xcc_id() { return (unsigned)__builtin_amdgcn_s_getreg((3 << 11) | 20) & 0xFu; }
#define XB_SPIN(cond, bar) do { unsigned _sp = 0; while (cond) { __builtin_amdgcn_s_sleep(1); \
    if ((++_sp & 255u) == 0u) { if (xb_ld(&(bar)[XB_TMO])) break; if (_sp > XB_SPIN_CAP) { atomicAdd(&(bar)[XB_TMO], 1u); break; } } } } while (0)

struct XcdBarrier {
    unsigned* bar; unsigned x;
    volatile LAS unsigned* st;
};

__device__ __forceinline__ XcdBarrier xcd_barrier_post(unsigned* bar, volatile LAS unsigned* st) {
    XcdBarrier b; b.bar = bar; b.x = xb_xcc_id(); b.st = st;
    if (threadIdx.x == 0) (void)xb_add(&bar[XB_XCNT(b.x)], 1u);
    return b;
}
__device__ __forceinline__ void xcd_barrier_complete(unsigned* bar, unsigned x, unsigned& nloc, unsigned& nx) {
    const unsigned G = gridDim.x * gridDim.y * gridDim.z;
    unsigned sum, cnt, mine, sp = 0u;
    for (;;) {
        sum = 0u; cnt = 0u; mine = 0u;
#pragma unroll
        for (unsigned j = 0; j < 16; ++j) { const unsigned c = xb_ld(&bar[XB_XCNT(j)]); sum += c; cnt += (c > 0u) ? 1u : 0u; mine = (j == x) ? c : mine; }
        if (sum == G) break;
        __builtin_amdgcn_s_sleep(1);
        if ((++sp & 255u) == 0u) { if (xb_ld(&bar[XB_TMO])) break; if (sp > XB_SPIN_CAP) { atomicAdd(&bar[XB_TMO], 1u); break; } }
    }
    nloc = mine > 0u ? mine : 1u; nx = cnt > 0u ? cnt : 1u;
}

__device__ __forceinline__ void xcd_barrier(const XcdBarrier& b) {
    asm volatile("s_waitcnt vmcnt(0)" ::: "memory");
    __syncthreads();
    if (threadIdx.x == 0) {
        unsigned* bar = b.bar;
        __builtin_amdgcn_s_waitcnt(0);
        unsigned nloc = b.st[0], nx = b.st[1];
        if (nloc == 0u) { xcd_barrier_complete(bar, b.x, nloc, nx); b.st[0] = nloc; b.st[1] = nx; }
        const unsigned old = xb_add(&bar[XB_XSUB(b.x)], 1u);
        const unsigned gen = old / nloc;
        if (old + 1u == (gen + 1u) * nloc) {
            __builtin_amdgcn_fence(__ATOMIC_RELEASE, "agent");
            asm volatile("s_waitcnt vmcnt(0)" ::: "memory");
            const unsigned og = xb_add(&bar[XB_TOP], 1u);
            const unsigned tg = og / nx;
            if (og + 1u == (tg + 1u) * nx) xb_add(&bar[XB_TOPGEN], 1u);
            else XB_SPIN(xb_ld(&bar[XB_TOPGEN]) == tg, bar);
            __builtin_amdgcn_fence(__ATOMIC_ACQUIRE, "agent");
            xb_add(&bar[XB_XGEN(b.x)], 1u);
            asm volatile("s_waitcnt vmcnt(0)" ::: "memory");
        } else {
            XB_SPIN(xb_ld(&bar[XB_XGEN(b.x)]) == gen, bar);
            __builtin_amdgcn_fence(__ATOMIC_ACQUIRE, "agent");
            asm volatile("s_waitcnt vmcnt(0)" ::: "memory");
        }
    }
    __syncthreads();
}

__device__ __forceinline__ float fast_sigmoid(float x) { return __builtin_amdgcn_rcpf(1.f + __builtin_amdgcn_exp2f(-LOG2E * x)); }
__device__ __forceinline__ u32x4 pack8(const f32x4 a, const f32x4 b) { u32x4 w; w.x = pg8::cvt_pk_bf16(a[0], a[1]); w.y = pg8::cvt_pk_bf16(a[2], a[3]); w.z = pg8::cvt_pk_bf16(b[0], b[1]); w.w = pg8::cvt_pk_bf16(b[2], b[3]); return w; }

__device__ __forceinline__ unsigned pk4_fp8(float a, float b, float c, float d, float sc) {
    a = __builtin_amdgcn_fmed3f(a * sc, -448.f, 448.f); b = __builtin_amdgcn_fmed3f(b * sc, -448.f, 448.f); c = __builtin_amdgcn_fmed3f(c * sc, -448.f, 448.f); d = __builtin_amdgcn_fmed3f(d * sc, -448.f, 448.f);
    int v = __builtin_amdgcn_cvt_pk_fp8_f32(a, b, 0, false); v = __builtin_amdgcn_cvt_pk_fp8_f32(c, d, v, true); return (unsigned)v; }
__device__ __forceinline__ unsigned pk4_fp8_nc(float a, float b, float c, float d) {
    int v = __builtin_amdgcn_cvt_pk_fp8_f32(a, b, 0, false); v = __builtin_amdgcn_cvt_pk_fp8_f32(c, d, v, true); return (unsigned)v; }
struct EpiIn {
    bf16* proj; const LAS float* gqk;
    static __device__ __forceinline__ int nstores(const pg8::GUnit& u) { return (u.pn >= 8 && u.pn < 16) ? 8 : 16; }
    __device__ __forceinline__ void operator()(const f32x4 (&acc)[2][2][4][2], const pg8::GUnit& u, int wr, int wc, int fr, int fq) const {
        const int pn = tile_new2old(u.pn); const int bb = u.pm >> 4, s0 = (u.pm & 15) * 256 + wr * 64 + fr; const size_t t0 = (size_t)u.pm * 256 + wr * 64 + fr;
        bf16* base; size_t INWp;
        if (u.pn >= 8 && u.pn < 16) {
            bf16* gb = proj + PO_RG + t0 * 1024 + (u.pn - 8) * 128 + wc * 32 + fq * 8;
#pragma unroll
            for (int ai = 0; ai < 2; ++ai)
#pragma unroll
                for (int m = 0; m < 4; ++m) { f32x4 v[2];
#pragma unroll
                    for (int n = 0; n < 2; ++n) {
                        const f32x4 x = acc[ai][0][m][n], a = x * (-LOG2E), b = acc[ai][1][m][n] * (-LOG2E); f32x4 ex, ey, r;
#pragma unroll
                        for (int e = 0; e < 4; ++e) { ex[e] = __builtin_amdgcn_exp2f(a[e]); ey[e] = __builtin_amdgcn_exp2f(b[e]); }
                        const f32x4 d = (ex + 1.f) * (ey + 1.f);
#pragma unroll
                        for (int e = 0; e < 4; ++e) r[e] = __builtin_amdgcn_rcpf(d[e]);
                        v[n] = x * r; }
                    *(u32x4*)(gb + (size_t)(ai * 128 + m * 16) * 1024) = pack8(v[0], v[1]); }
            return;
        }
        if (pn < 4)       { const int h = 2 * (pn & 1) + (wc >> 1); base = proj + (pn < 2 ? PO_RQ : PO_RK) + ((size_t)(bb * 4 + h) * S + s0) * 128 + (wc & 1) * 64 + fq * 8; INWp = 128; }
        else if (pn < 8)  { base = proj + PO_RV + ((size_t)(bb * 4 + (pn - 4)) * S + s0) * 256 + wc * 64 + fq * 8; INWp = 256; }
        else if (pn < 12) { base = proj + PO_RG + t0 * 1024 + (pn - 8) * 256 + wc * 64 + fq * 8; INWp = 1024; }
        else if (pn < 24) { const int rg3 = (pn - 12) >> 2, h = 2 * ((pn - 12) & 3) + (wc >> 1); base = proj + (rg3 == 0 ? PO_DQ : (rg3 == 1 ? PO_DK : PO_DV)) + ((size_t)(bb * 8 + h) * S + s0) * 128 + (wc & 1) * 64 + fq * 8; INWp = 128; }
        else              { base = proj + PO_MG + (pn >= 28 ? (size_t)T * 1024 : 0) + t0 * 1024 + ((pn - 24) & 3) * 256 + wc * 64 + fq * 8; INWp = 1024; }
        if (pn < 8 || (pn >= 20 && pn < 24)) {
            float f[4];
#pragma unroll
            for (int m = 0; m < 4; ++m) f[m] = 1.f;
            if (pn < 4) { const int h = 2 * (pn & 1) + (wc >> 1); const float lg = __builtin_amdgcn_logf(1.f - __builtin_amdgcn_exp2f(-5.f - (float)h));
#pragma unroll
                for (int m = 0; m < 4; ++m) { const float pos = (float)(wr * 64 + m * 16 + fr); f[m] = pn < 2 ? __builtin_amdgcn_exp2f(lg * pos) : 0.08838834764831845f * __builtin_amdgcn_exp2f(-lg * pos); } }
#pragma unroll
            for (int ai = 0; ai < 2; ++ai)
#pragma unroll
                for (int m = 0; m < 4; ++m)
#pragma unroll
                    for (int bj = 0; bj < 2; ++bj) *(u32x4*)(base + (size_t)(ai * 128 + m * 16) * INWp + bj * 32) = pack8(acc[ai][bj][m][0] * f[m], acc[ai][bj][m][1] * f[m]);
        } else if (pn < 12 || pn >= 24) {
            const bool silu = pn < 12;
#pragma unroll
            for (int ai = 0; ai < 2; ++ai)
#pragma unroll
                for (int m = 0; m < 4; ++m)
#pragma unroll
                    for (int bj = 0; bj < 2; ++bj) { f32x4 v[2];
#pragma unroll
                        for (int n = 0; n < 2; ++n)
#pragma unroll
                            for (int e = 0; e < 4; ++e) { const float x = acc[ai][bj][m][n][e], s = fast_sigmoid(x); v[n][e] = silu ? x * s : s; }
                        *(u32x4*)(base + (size_t)(ai * 128 + m * 16) * INWp + bj * 32) = pack8(v[0], v[1]); }
        } else {
            const LAS float* g = gqk + (pn < 16 ? 0 : 64) + fq * 8;
            f32x4 gv[2][2];
#pragma unroll
            for (int bj = 0; bj < 2; ++bj)
#pragma unroll
                for (int n = 0; n < 2; ++n) gv[bj][n] = *(const LAS f32x4*)(g + bj * 32 + n * 4);
#pragma unroll
            for (int ai = 0; ai < 2; ++ai)
#pragma unroll
                for (int m = 0; m < 4; ++m) { float ss = 0.f;
#pragma unroll
                    for (int bj = 0; bj < 2; ++bj)
#pragma unroll
                        for (int n = 0; n < 2; ++n) { const f32x4 x = acc[ai][bj][m][n]; ss += (x[0] * x[0] + x[1] * x[1]) + (x[2] * x[2] + x[3] * x[3]); }
                    ss += __shfl_xor(ss, 16); ss += __shfl_xor(ss, 32);
                    const float r = __builtin_amdgcn_rsqf(ss * (1.f / 64) + EPS);
#pragma unroll
                    for (int bj = 0; bj < 2; ++bj) *(u32x4*)(base + (size_t)(ai * 128 + m * 16) * INWp + bj * 32) = pack8(acc[ai][bj][m][0] * gv[bj][0] * r, acc[ai][bj][m][1] * gv[bj][1] * r); }
        }
    }
};
struct EpiOutF {
    const float* x; const float* mod; bf16* x1b;
    static __device__ __forceinline__ int nstores(const pg8::GUnit&) { return 16; }
    __device__ __forceinline__ void operator()(const f32x4 (&acc)[2][2][4][2], const pg8::GUnit& u, int wr, int wc, int fr, int fq) const {
        const int row0 = u.pm * 256 + wr * 64 + fr, col0 = u.pn * 256 + wc * 32 + fq * 8, b = (u.pm * 256) / S;
        f32x4 gt[2][2];
#pragma unroll
        for (int bj = 0; bj < 2; ++bj)
#pragma unroll
            for (int n = 0; n < 2; ++n) gt[bj][n] = *(const f32x4*)(mod + b * 6144 + 2048 + col0 + bj * 128 + n * 4);
#pragma unroll
        for (int ai = 0; ai < 2; ++ai)
#pragma unroll
            for (int m = 0; m < 4; ++m) { const size_t ro = (size_t)(row0 + ai * 128 + m * 16) * D + col0;
#pragma unroll
                for (int bj = 0; bj < 2; ++bj) { const f32x4 x0 = *(const f32x4*)(x + ro + bj * 128), x1 = *(const f32x4*)(x + ro + bj * 128 + 4);
                    *(u32x4*)(x1b + ro + bj * 128) = pack8(x0 + gt[bj][0] * acc[ai][bj][m][0], x1 + gt[bj][1] * acc[ai][bj][m][1]); } }
    }
};
struct EpiActF {
    static __device__ __forceinline__ int nstores(const pg8::GUnit&) { return 8; }
    const LAS float* btab; bf16* act;
    __device__ __forceinline__ void operator()(const f32x4 (&acc)[2][2][4][2], const pg8::GUnit& u, int wr, int wc, int fr, int fq) const {
        const int row0 = u.pm * 256 + wr * 64 + fr, c0 = u.pn * 128 + wc * 32 + fq * 8;
        const LAS float* bt = btab + u.s * 256 + wc * 32 + fq * 8;
        constexpr float ASC = (float)(1 << A_SH);
        f32x4 bg[2], bu[2];
#pragma unroll
        for (int n = 0; n < 2; ++n) { bg[n] = *(const LAS f32x4*)(bt + n * 4); bu[n] = (*(const LAS f32x4*)(bt + 128 + n * 4) + 1.f) * ASC; }
#pragma unroll
        for (int ai = 0; ai < 2; ++ai)
#pragma unroll
            for (int m = 0; m < 4; ++m) { f32x4 v[2];
#pragma unroll
                for (int n = 0; n < 2; ++n) {
                    f32x4 g = acc[ai][0][m][n] + bg[n], up = acc[ai][1][m][n] * ASC + bu[n], ex, rc;
#pragma unroll
                    for (int e = 0; e < 4; ++e) { g[e] = fminf(g[e], 7.f); up[e] = __builtin_amdgcn_fmed3f(up[e], -6.f * ASC, 8.f * ASC); }
                    const f32x4 a = g * (-1.702f * LOG2E);
#pragma unroll
                    for (int e = 0; e < 4; ++e) ex[e] = __builtin_amdgcn_exp2f(a[e]);
                    const f32x4 d = ex + 1.f;
#pragma unroll
                    for (int e = 0; e < 4; ++e) rc[e] = __builtin_amdgcn_rcpf(d[e]);
                    v[n] = (g * up) * rc; }
                if (FP8_MOE) { u32x2 o; o.x = pk4_fp8_nc(v[0][0], v[0][1], v[0][2], v[0][3]); o.y = pk4_fp8_nc(v[1][0], v[1][1], v[1][2], v[1][3]);
                    *(u32x2*)((unsigned char*)act + (size_t)(row0 + ai * 128 + m * 16) * FF + c0) = o; }
                else *(u32x4*)(act + (size_t)(row0 + ai * 128 + m * 16) * FF + c0) = pack8(v[0] * (1.f / ASC), v[1] * (1.f / ASC)); }
    }
};
struct EpiEOF {
    static __device__ __forceinline__ int nstores(const pg8::GUnit&) { return 8; }
    const LAS float* btab; bf16* eo;
    __device__ __forceinline__ void operator()(const f32x4 (&acc)[2][2][4][2], const pg8::GUnit& u, int wr, int wc, int fr, int fq) const {
        const int row0 = u.pm * 256 + wr * 64 + fr, col0 = u.pn * 256 + wc * 64 + fq * 16;
        const LAS float* bt = btab + u.s * 256 + wc * 64 + fq * 16;
        constexpr float ESC = (float)(1 << E_SH);
        f32x4 bv[2][2];
#pragma unroll
        for (int bj = 0; bj < 2; ++bj)
#pragma unroll
            for (int n = 0; n < 2; ++n) bv[bj][n] = *(const LAS f32x4*)(bt + bj * 8 + n * 4) * ESC;
#pragma unroll
        for (int ai = 0; ai < 2; ++ai)
#pragma unroll
            for (int m = 0; m < 4; ++m) { u32x4 o; f32x4 v;
                v = acc[ai][0][m][0] * ESC + bv[0][0]; o.x = pk4_fp8(v[0], v[1], v[2], v[3], 1.f);
                v = acc[ai][0][m][1] * ESC + bv[0][1]; o.y = pk4_fp8(v[0], v[1], v[2], v[3], 1.f);
                v = acc[ai][1][m][0] * ESC + bv[1][0]; o.z = pk4_fp8(v[0], v[1], v[2], v[3], 1.f);
                v = acc[ai][1][m][1] * ESC + bv[1][1]; o.w = pk4_fp8(v[0], v[1], v[2], v[3], 1.f);
                *(u32x4*)((unsigned char*)eo + (size_t)(row0 + ai * 128 + m * 16) * D + col0) = o; }
    }
};

constexpr int LDS_STAGE = 0, LDS_STAGE_BYTES = 131072;
constexpr int LDS_GTAB = 131072;
constexpr int LDS_RB2E = LDS_GTAB + 2048;
constexpr int LDS_GQK = LDS_RB2E + 2176;
constexpr int LDS_RBF = LDS_GQK + 512;
constexpr int LDS_MISC = LDS_RBF + 256;
constexpr int LDS_BTAB = LDS_MISC + 256;
constexpr int LDS_BYTES = 147456;
static_assert(LDS_BTAB + 2048 <= LDS_BYTES, "LDS map");

namespace att {
constexpr int SLOT = 32768, KOFF = 0, VOFF = 16384, NSLOT = 4;
constexpr int LDS_WS = LDS_GTAB;
constexpr int LDS_X = 0;
constexpr int LDS_Y = 65536;
constexpr int LDS_XS = LDS_BTAB;
constexpr int LDS_GSUB = LDS_GQK;
constexpr float THR = 8.f;
typedef short v4i16 __attribute__((ext_vector_type(4)));
template <int OFF> __device__ __forceinline__ bf16x8 rd128(unsigned a) { bf16x8 v; asm volatile("ds_read_b128 %0, %1 offset:%2" : "=v"(v) : "v"(a), "n"(OFF)); return v; }
template <int OFF> __device__ __forceinline__ v4i16 rdtr(unsigned a) { v4i16 v; asm volatile("ds_read_b64_tr_b16 %0, %1 offset:%2" : "=v"(v) : "v"(a), "n"(OFF)); return v; }
__device__ __forceinline__ float max3(float a, float b, float c) { float r; asm("v_max3_f32 %0, %1, %2, %3" : "=v"(r) : "v"(a), "v"(b), "v"(c)); return r; }
#define ATT_WAITV(n) asm volatile("s_waitcnt vmcnt(" #n ")" ::: "memory")
#define ATT_BAR() asm volatile("s_waitcnt lgkmcnt(0)\n\ts_barrier" ::: "memory")
#define ATT_WAIT_TILE(k_, last_) do { const int _y = ((last_) < NTu - 1 ? (last_) : NTu - 1) - (k_); if (_y >= 2) ATT_WAITV(8); else if (_y == 1) ATT_WAITV(4); else ATT_WAITV(0); } while (0)
__device__ __forceinline__ void unit(const int b, const int h, const int qb, const int t_lo, const bf16* __restrict__ proj, bf16* __restrict__ odiff, LAS unsigned char* lds, const float lam, const float* __restrict__ gsub,
                                     const bool pre, const bool nvalid, const int nb, const int nh, const int nqb, bf16x8& qn0, bf16x8& qn1, bf16x8& qn2, bf16x8& qn3) {
    int tid = threadIdx.x; asm volatile("" : "+v"(tid));
    const int lane = tid & 63, r = lane & 31, hi = lane >> 5; const int wid = __builtin_amdgcn_readfirstlane(tid >> 6), c = wid >> 2, sb = wid & 3;
    const size_t rowb = (size_t)b * S; const int q0 = 128 * qb + 32 * sb;
    const size_t hrow = (size_t)(b * 8 + h) * S;
    const bf16* Kg = proj + PO_DK + hrow * 128; const bf16* Vg = proj + PO_DV + hrow * 128;
    const bf16* Qg = proj + PO_DQ + (hrow + q0 + r) * 128 + c * 64 + hi * 8;
    bf16x8 qf[4];
    if (pre) { qf[0] = qn0; qf[1] = qn1; qf[2] = qn2; qf[3] = qn3; }
    else {
#pragma unroll
        for (int ks = 0; ks < 4; ++ks) qf[ks] = *(const bf16x8*)(Qg + 16 * ks);
    }
    const float slope2 = __builtin_amdgcn_exp2f(-(float)(h + 1)) * LOG2E;
    const int t_hi = 2 * qb + 1, NTu = t_hi + 1 - t_lo;
    LAS float* wsf = (LAS float*)(lds + LDS_WS) + wid * 64;
    const unsigned lds0 = (unsigned)(uintptr_t)lds;
    unsigned kof[2], vof[2];
#pragma unroll
    for (int j = 0; j < 2; ++j) { const int pc = wid + 8 * j, key = 4 * pc + (lane >> 4); kof[j] = (unsigned)(key * 256 + (((lane & 15) ^ (key & 7)) << 4));
        const int blk = wid + 8 * j, d0 = blk >> 2, kk = blk & 3; vof[j] = (unsigned)((16 * kk + (lane >> 2)) * 256 + (32 * d0 + 8 * (lane & 3)) * 2); }
#define ATT_DMA(it_) do { const int _t = t_hi - (it_); LAS unsigned char* _s = lds + (((it_) + 3) & 3) * SLOT; \
        const char* _kb = (const char*)Kg + (size_t)_t * 16384; const char* _vb = (const char*)Vg + (size_t)_t * 16384; \
        _Pragma("unroll") for (int _j = 0; _j < 2; ++_j) __builtin_amdgcn_global_load_lds((const unsigned*)(_kb + kof[_j]), (LAS unsigned*)(_s + KOFF + (wid + 8 * _j) * 1024), 16, 0, 0); \
        _Pragma("unroll") for (int _j = 0; _j < 2; ++_j) __builtin_amdgcn_global_load_lds((const unsigned*)(_vb + vof[_j]), (LAS unsigned*)(_s + VOFF + (wid + 8 * _j) * 1024), 16, 0, 0); } while (0)
    if (!pre) ATT_DMA(0);
    ATT_DMA(1); if (NTu > 2) ATT_DMA(2);
    f32x16 o[4], ol;
#pragma unroll
    for (int q = 0; q < 16; ++q) { ol[q] = 0.f;
#pragma unroll
        for (int d = 0; d < 4; ++d) o[d][q] = 0.f; }
    float m = 0.f;
    unsigned kl[4];
#pragma unroll
    for (int ks = 0; ks < 4; ++ks) kl[ks] = lds0 + KOFF + r * 256 + (((8 * c + 2 * ks + hi) ^ (r & 7)) << 4);
    const unsigned vl = lds0 + VOFF + ((lane >> 4) & 1) * 32 + (lane & 3) * 8 + (4 * hi + ((lane & 15) >> 2)) * 64;
    f32x16 p0, p1;
    const bf16x8 ones = (bf16x8){0x3F80, 0x3F80, 0x3F80, 0x3F80, 0x3F80, 0x3F80, 0x3F80, 0x3F80};
#define ATT_PINIT(it_) do { const int _t = t_hi - (it_); const float cb = slope2 * (float)(64 * _t - (q0 + r) + 4 * hi) - m; \
        _Pragma("unroll") for (int q = 0; q < 16; ++q) { p0[q] = fmaf(slope2, (float)((q & 3) + 8 * (q >> 2)), cb); p1[q] = fmaf(slope2, (float)((q & 3) + 8 * (q >> 2) + 32), cb); } } while (0)
#define ATT_H1(it_, FIRST_) do { const int _t = t_hi - (it_); \
        if (64 * _t <= q0 + 31) { const unsigned so_ = (unsigned)(((it_) + 3) & 3) * SLOT; \
            bf16x8 k0 = rd128<0>(kl[0] + so_), k1 = rd128<0>(kl[1] + so_), k2 = rd128<0>(kl[2] + so_), k3 = rd128<0>(kl[3] + so_), k4 = rd128<8192>(kl[0] + so_), k5 = rd128<8192>(kl[1] + so_), k6 = rd128<8192>(kl[2] + so_), k7 = rd128<8192>(kl[3] + so_); \
            asm volatile("s_waitcnt lgkmcnt(0)" : "+v"(k0), "+v"(k1), "+v"(k2), "+v"(k3), "+v"(k4), "+v"(k5), "+v"(k6), "+v"(k7)); \
            p0 = __builtin_amdgcn_mfma_f32_32x32x16_bf16(k0, qf[0], p0, 0, 0, 0); p1 = __builtin_amdgcn_mfma_f32_32x32x16_bf16(k4, qf[0], p1, 0, 0, 0); \
            p0 = __builtin_amdgcn_mfma_f32_32x32x16_bf16(k1, qf[1], p0, 0, 0, 0); p1 = __builtin_amdgcn_mfma_f32_32x32x16_bf16(k5, qf[1], p1, 0, 0, 0); \
            p0 = __builtin_amdgcn_mfma_f32_32x32x16_bf16(k2, qf[2], p0, 0, 0, 0); p1 = __builtin_amdgcn_mfma_f32_32x32x16_bf16(k6, qf[2], p1, 0, 0, 0); \
            p0 = __builtin_amdgcn_mfma_f32_32x32x16_bf16(k3, qf[3], p0, 0, 0, 0); p1 = __builtin_amdgcn_mfma_f32_32x32x16_bf16(k7, qf[3], p1, 0, 0, 0); \
            if (64 * _t + 63 > q0) { \
                _Pragma("unroll") for (int q = 0; q < 16; ++q) { const int j = 64 * _t + crow(q, hi); if (j > q0 + r) p0[q] = -INFINITY; if (j + 32 > q0 + r) p1[q] = -INFINITY; } } \
            float rm = max3(p0[0], p0[1], p1[0]); rm = max3(rm, p1[1], p0[2]); rm = max3(rm, p0[3], p1[2]); rm = max3(rm, p1[3], p0[4]); \
            rm = max3(rm, p0[5], p1[4]); rm = max3(rm, p1[5], p0[6]); rm = max3(rm, p0[7], p1[6]); rm = max3(rm, p1[7], p0[8]); \
            rm = max3(rm, p0[9], p1[8]); rm = max3(rm, p1[9], p0[10]); rm = max3(rm, p0[11], p1[10]); rm = max3(rm, p1[11], p0[12]); \
            rm = max3(rm, p0[13], p1[12]); rm = max3(rm, p1[13], p0[14]); rm = max3(rm, p0[15], p1[14]); rm = max3(rm, p1[15], rm); \
            rm = fmaxf(rm, __shfl_xor(rm, 32)); \
            if (FIRST_) { m = rm;                                         \
                _Pragma("unroll") for (int q = 0; q < 16; ++q) { p0[q] -= rm; p1[q] -= rm; } } \
            else if (__any(rm > THR)) { \
                const float dl = fmaxf(rm, 0.f), alpha = __builtin_amdgcn_exp2f(-dl); m += dl; \
                _Pragma("unroll") for (int q = 0; q < 16; ++q) { p0[q] -= dl; p1[q] -= dl; } \
                if (hi == 0) wsf[r] = alpha; \
                asm volatile("s_waitcnt lgkmcnt(0)" ::: "memory"); \
                _Pragma("unroll") for (int g4 = 0; g4 < 4; ++g4) { const f32x4 a4 = *(const LAS f32x4*)(wsf + 8 * g4 + 4 * hi);     \
                    _Pragma("unroll") for (int e = 0; e < 4; ++e) { ol[4 * g4 + e] *= a4[e]; \
                        _Pragma("unroll") for (int d = 0; d < 4; ++d) o[d][4 * g4 + e] *= a4[e]; } \
                    __builtin_amdgcn_sched_barrier(0); } } \
            _Pragma("unroll") for (int q = 0; q < 16; ++q) { p0[q] = __builtin_amdgcn_exp2f(p0[q]); p1[q] = __builtin_amdgcn_exp2f(p1[q]); } } } while (0)
#define ATT_VRD(dst, s_) do { dst##0l = rdtr<(s_) * 2048>(va); dst##0h = rdtr<(s_) * 2048 + 512>(va); dst##1l = rdtr<(s_) * 2048 + 1024>(va); dst##1h = rdtr<(s_) * 2048 + 1536>(va); } while (0)
#define ATT_VWAIT(n, dst) asm volatile("s_waitcnt lgkmcnt(" #n ")" : "+v"(dst##0l), "+v"(dst##0h), "+v"(dst##1l), "+v"(dst##1h))
#define ATT_VF(dst, k) (bf16x8){dst##k##l[0], dst##k##l[1], dst##k##l[2], dst##k##l[3], dst##k##h[0], dst##k##h[1], dst##k##h[2], dst##k##h[3]}
#define ATT_PV(s_, dst, PA, PB) do { o[(s_) >> 1] = __builtin_amdgcn_mfma_f32_32x32x16_bf16(PA, ATT_VF(dst, 0), o[(s_) >> 1], 0, 0, 0); o[(s_) >> 1] = __builtin_amdgcn_mfma_f32_32x32x16_bf16(PB, ATT_VF(dst, 1), o[(s_) >> 1], 0, 0, 0); } while (0)
#define ATT_PACK(P, b8) __builtin_bit_cast(bf16x8, (u32x4){pg8::cvt_pk_bf16(P[b8 + 0], P[b8 + 1]), pg8::cvt_pk_bf16(P[b8 + 2], P[b8 + 3]), pg8::cvt_pk_bf16(P[b8 + 4], P[b8 + 5]), pg8::cvt_pk_bf16(P[b8 + 6], P[b8 + 7])})
#define ATT_H2(it_) do { const int _t = t_hi - (it_); \
        if (64 * _t <= q0 + 31) { const unsigned va = vl + (unsigned)(((it_) + 3) & 3) * SLOT; \
            v4i16 A0l, A0h, A1l, A1h, B0l, B0h, B1l, B1h; \
            ATT_VRD(A, 0); \
            const bf16x8 pa0 = ATT_PACK(p0, 0), pa1 = ATT_PACK(p0, 8), pa2 = ATT_PACK(p1, 0), pa3 = ATT_PACK(p1, 8); \
            ATT_VRD(B, 1); \
            ol = __builtin_amdgcn_mfma_f32_32x32x16_bf16(pa0, ones, ol, 0, 0, 0); ol = __builtin_amdgcn_mfma_f32_32x32x16_bf16(pa1, ones, ol, 0, 0, 0); \
            ol = __builtin_amdgcn_mfma_f32_32x32x16_bf16(pa2, ones, ol, 0, 0, 0); ol = __builtin_amdgcn_mfma_f32_32x32x16_bf16(pa3, ones, ol, 0, 0, 0); \
            ATT_VWAIT(4, A); ATT_PV(0, A, pa0, pa1); ATT_VRD(A, 2); ATT_VWAIT(4, B); ATT_PV(1, B, pa2, pa3); \
            ATT_VRD(B, 3); ATT_VWAIT(4, A); ATT_PV(2, A, pa0, pa1); ATT_VRD(A, 4); ATT_VWAIT(4, B); ATT_PV(3, B, pa2, pa3); \
            ATT_VRD(B, 5); ATT_VWAIT(4, A); ATT_PV(4, A, pa0, pa1); ATT_VRD(A, 6); ATT_VWAIT(4, B); ATT_PV(5, B, pa2, pa3); \
            ATT_VRD(B, 7); ATT_VWAIT(4, A); ATT_PV(6, A, pa0, pa1); ATT_VWAIT(0, B); ATT_PV(7, B, pa2, pa3); } \
        if ((it_) + 1 < NTu) ATT_PINIT((it_) + 1); } while (0)
    { const float m0 = m; (void)m0; ATT_PINIT(0); }
    if (c == 0) {
        ATT_WAIT_TILE(0, 2); ATT_BAR();
        ATT_H1(0, true);
        ATT_BAR();
        ATT_H2(0); if (3 < NTu) ATT_DMA(3);
        for (int it = 1; it < NTu; ++it) {
            ATT_WAIT_TILE(it, it + 2); ATT_BAR();
            ATT_H1(it, false);
            ATT_BAR();
            ATT_H2(it); if (it + 3 < NTu) ATT_DMA(it + 3);
        }
        ATT_BAR();
    } else {
        ATT_WAIT_TILE(0, 2); ATT_BAR();
        ATT_BAR();
        ATT_H1(0, true);
        ATT_WAIT_TILE(1, 2);
        ATT_BAR();
        ATT_H2(0); if (3 < NTu) ATT_DMA(3);
        for (int it = 1; it < NTu; ++it) {
            ATT_BAR();
            ATT_H1(it, false);
            if (it + 1 < NTu) ATT_WAIT_TILE(it + 1, it + 2);
            ATT_BAR();
            ATT_H2(it); if (it + 3 < NTu) ATT_DMA(it + 3);
        }
    }
    float rl[16];
#pragma unroll
    for (int q = 0; q < 16; ++q) rl[q] = (c == 1 ? lam : 1.f) * __builtin_amdgcn_rcpf(ol[q]);
#pragma unroll
    for (int d0 = 0; d0 < 4; ++d0)
#pragma unroll
        for (int q = 0; q < 16; ++q) o[d0][q] *= rl[q];
    ATT_BAR();
    if (nvalid) { const size_t nhrow = (size_t)(nb * 8 + nh) * S; LAS unsigned char* _s = lds + 3 * SLOT;
        const char* _kb = (const char*)(proj + PO_DK + nhrow * 128) + (size_t)(2 * nqb + 1) * 16384; const char* _vb = (const char*)(proj + PO_DV + nhrow * 128) + (size_t)(2 * nqb + 1) * 16384;
#pragma unroll
        for (int _j = 0; _j < 2; ++_j) __builtin_amdgcn_global_load_lds((const unsigned*)(_kb + kof[_j]), (LAS unsigned*)(_s + KOFF + (wid + 8 * _j) * 1024), 16, 0, 0);
#pragma unroll
        for (int _j = 0; _j < 2; ++_j) __builtin_amdgcn_global_load_lds((const unsigned*)(_vb + vof[_j]), (LAS unsigned*)(_s + VOFF + (wid + 8 * _j) * 1024), 16, 0, 0);
        const bf16* nQg = proj + PO_DQ + (nhrow + 128 * nqb + 32 * sb + r) * 128 + c * 64 + hi * 8;
        qn0 = *(const bf16x8*)(nQg); qn1 = *(const bf16x8*)(nQg + 16); qn2 = *(const bf16x8*)(nQg + 32); qn3 = *(const bf16x8*)(nQg + 48); }
    else { qn0 = (bf16x8){}; qn1 = (bf16x8){}; qn2 = (bf16x8){}; qn3 = (bf16x8){}; }
    { LAS f32x4* XE = (LAS f32x4*)(lds + LDS_X) + ((c * 4 + sb) * 8) * 64 + lane;
        if (c == 0) {
#pragma unroll
            for (int j = 0; j < 8; ++j) XE[j * 64] = (f32x4){o[2 + (j >> 2)][4 * (j & 3)], o[2 + (j >> 2)][4 * (j & 3) + 1], o[2 + (j >> 2)][4 * (j & 3) + 2], o[2 + (j >> 2)][4 * (j & 3) + 3]};
        } else {
#pragma unroll
            for (int j = 0; j < 8; ++j) XE[j * 64] = (f32x4){o[j >> 2][4 * (j & 3)], o[j >> 2][4 * (j & 3) + 1], o[j >> 2][4 * (j & 3) + 2], o[j >> 2][4 * (j & 3) + 3]};
        } }
    ATT_BAR();
    float v[2][16], ss[16];
    { const LAS f32x4* XR = (const LAS f32x4*)(lds + LDS_X) + (((c ^ 1) * 4 + sb) * 8) * 64 + lane;
        f32x4 pr[8];
#pragma unroll
        for (int j = 0; j < 8; ++j) pr[j] = XR[j * 64];
        if (c == 0) {
#pragma unroll
            for (int k = 0; k < 2; ++k)
#pragma unroll
                for (int q = 0; q < 16; ++q) v[k][q] = o[k][q] - pr[4 * k + (q >> 2)][q & 3];
        } else {
#pragma unroll
            for (int k = 0; k < 2; ++k)
#pragma unroll
                for (int q = 0; q < 16; ++q) v[k][q] = pr[4 * k + (q >> 2)][q & 3] - o[2 + k][q];
        } }
#pragma unroll
    for (int q = 0; q < 16; ++q) { ss[q] = rowsum16(v[0][q] * v[0][q] + v[1][q] * v[1][q]); ss[q] += __shfl_xor(ss[q], 16); }
    LAS f32x4* XS = (LAS f32x4*)(lds + LDS_XS);
    if (r == 0) {
#pragma unroll
        for (int j = 0; j < 4; ++j) XS[((c * 4 + sb) * 2 + hi) * 4 + j] = (f32x4){ss[4 * j], ss[4 * j + 1], ss[4 * j + 2], ss[4 * j + 3]}; }
    ATT_BAR();
    {
#pragma unroll
        for (int j = 0; j < 4; ++j) { const f32x4 ps = XS[(((c ^ 1) * 4 + sb) * 2 + hi) * 4 + j];
#pragma unroll
            for (int e = 0; e < 4; ++e) ss[4 * j + e] = __builtin_amdgcn_rsqf((ss[4 * j + e] + ps[e]) * (1.f / 128) + EPS) * (1.f - LAMBDA_INIT); } }
    LAS bf16* Y = (LAS bf16*)(lds + LDS_Y) + sb * 32 * 128;
    { const int dA = 2 * c; const LAS float* gL = (const LAS float*)(lds + LDS_GSUB);
#pragma unroll
        for (int k = 0; k < 2; ++k) { const float g = gL[32 * (dA + k) + r];
#pragma unroll
            for (int q = 0; q < 16; ++q) Y[crow(q, hi) * 128 + 32 * (dA + k) + r] = f2bf(v[k][q] * ss[q] * g); } }
    ATT_BAR();
    { bf16* Og = odiff + (rowb + q0) * D + h * 128;
#pragma unroll
        for (int i = 0; i < 4; ++i) { const int row = 16 * c + 4 * i + (lane >> 4), ch = lane & 15; *(u32x4*)(Og + (size_t)row * D + ch * 8) = *(const LAS u32x4*)(Y + row * 128 + ch * 8); } }
    ATT_BAR();
#undef ATT_DMA
#undef ATT_H1
#undef ATT_H2
#undef ATT_PINIT
}
}

namespace ret {
typedef short v4i16 __attribute__((ext_vector_type(4)));
constexpr int STG = 98304;
#define RET_BAR() do { asm volatile("s_waitcnt lgkmcnt(0)" ::: "memory"); __builtin_amdgcn_s_barrier(); asm volatile("" ::: "memory"); } while (0)
__device__ __forceinline__ bf16x8 trfrag(LAS unsigned char* p, int second_off) {
    const v4i16 lo = __builtin_amdgcn_ds_read_tr16_b64_v4i16((LAS v4i16*)p), hh = __builtin_amdgcn_ds_read_tr16_b64_v4i16((LAS v4i16*)(p + second_off));
    return (bf16x8){lo[0], lo[1], lo[2], lo[3], hh[0], hh[1], hh[2], hh[3]};
}
__device__ __forceinline__ void store_tile64(const f32x16& t0, const f32x16& t1, LAS unsigned char* stg, bf16* __restrict__ gdst, const size_t gpitch, const int lane) {
    const int r = lane & 31, hi = lane >> 5;
#pragma unroll
    for (int q = 0; q < 16; ++q) { const int row = crow(q, hi); *(LAS bf16*)(stg + row * 128 + r * 2) = f2bf(t0[q]); *(LAS bf16*)(stg + row * 128 + 64 + r * 2) = f2bf(t1[q]); }
    asm volatile("s_waitcnt lgkmcnt(0)" ::: "memory");
#pragma unroll
    for (int i = 0; i < 4; ++i) { const int row = 8 * i + (lane >> 3), ch = lane & 7; *(u32x4*)(gdst + (size_t)row * gpitch + ch * 8) = *(const LAS u32x4*)(stg + row * 128 + ch * 16); }
    asm volatile("s_waitcnt lgkmcnt(0)" ::: "memory");
}
__device__ __forceinline__ void r1_unit(const int b, const int h, const int j, const bf16* __restrict__ proj, bf16* __restrict__ ubuf, LAS unsigned char* lds) {
    constexpr int KV = 0, VV = 32768;
    int tid = threadIdx.x; asm volatile("" : "+v"(tid));
    const int lane = tid & 63, hi = lane >> 5; const int wid = __builtin_amdgcn_readfirstlane(tid >> 6), db = wid & 3, cg = wid >> 2;
    const size_t hrow = (size_t)(b * 4 + h) * S + (size_t)j * 128;
    const bf16* Kg = proj + PO_RK + hrow * 128; const bf16* Vg = proj + PO_RV + hrow * 256;
#pragma unroll
    for (int i = 0; i < 4; ++i) { const int blk = wid * 4 + i, d_b = blk >> 3, mg = blk & 7;
        __builtin_amdgcn_global_load_lds((const unsigned*)(Kg + (size_t)(16 * mg + (lane >> 2)) * 128 + 32 * d_b + 8 * (lane & 3)), (LAS unsigned*)(lds + KV + blk * 1024), 16, 0, 0); }
#pragma unroll
    for (int i = 0; i < 8; ++i) { const int blk = wid * 8 + i, cb = blk >> 3, mg = blk & 7;
        __builtin_amdgcn_global_load_lds((const unsigned*)(Vg + (size_t)(16 * mg + (lane >> 2)) * 256 + 32 * cb + 8 * (lane & 3)), (LAS unsigned*)(lds + VV + blk * 1024), 16, 0, 0); }
    const int vperm = ((lane >> 4) & 1) * 32 + (lane & 3) * 8 + (4 * hi + ((lane & 15) >> 2)) * 64;
    f32x16 u[4];
#pragma unroll
    for (int t = 0; t < 4; ++t)
#pragma unroll
        for (int q = 0; q < 16; ++q) u[t][q] = 0.f;
    asm volatile("s_waitcnt vmcnt(0)" ::: "memory");
    RET_BAR();
#pragma unroll
    for (int m2 = 0; m2 < 4; ++m2) {
        bf16x8 a[2], bv[2][4];
#pragma unroll
        for (int s = 0; s < 2; ++s) { const int mg = 2 * m2 + s; a[s] = trfrag(lds + KV + (db * 8 + mg) * 1024 + vperm, 512);
#pragma unroll
            for (int t = 0; t < 4; ++t) bv[s][t] = trfrag(lds + VV + ((4 * cg + t) * 8 + mg) * 1024 + vperm, 512); }
#pragma unroll
        for (int s = 0; s < 2; ++s)
#pragma unroll
            for (int t = 0; t < 4; ++t) u[t] = __builtin_amdgcn_mfma_f32_32x32x16_bf16(a[s], bv[s][t], u[t], 0, 0, 0);
    }
    bf16* Ug = ubuf + (((size_t)b * 4 + h) * 32 + j) * 32768 + (size_t)(32 * db) * 256 + 128 * cg;
    LAS unsigned char* stg = lds + STG + wid * 4096;
    store_tile64(u[0], u[1], stg, Ug, 256, lane);
    store_tile64(u[2], u[3], stg, Ug + 64, 256, lane);
    RET_BAR();
}
__device__ __forceinline__ void r3_unit(const int b, const int h, const int j, const int half, const bf16* __restrict__ proj, const bf16* __restrict__ rbbuf, bf16* __restrict__ yret, LAS unsigned char* lds) {
    constexpr int KK = 0, VV = 32768, RB = 65536;
    int tid = threadIdx.x; asm volatile("" : "+v"(tid));
    const int lane = tid & 63, r = lane & 31, hi = lane >> 5; const int wid = __builtin_amdgcn_readfirstlane(tid >> 6), sb = wid & 3, ch = wid >> 2;
    const size_t row0 = (size_t)b * S + (size_t)j * 128, hrow = (size_t)(b * 4 + h) * S + (size_t)j * 128;
    const bf16* Qg = proj + PO_RQ + hrow * 128; const bf16* Kg = proj + PO_RK + hrow * 128; const bf16* Vg = proj + PO_RV + hrow * 256 + half * 128;
    const bf16* Rg = rbbuf + (((size_t)b * 4 + h) * 32 + j) * 32768 + half * 128;
#pragma unroll
    for (int i = 0; i < 4; ++i) { const int pc = wid * 4 + i, cidx = pc >> 1, mh = pc & 1;
        __builtin_amdgcn_global_load_lds((const unsigned*)(Kg + (size_t)(64 * mh + lane) * 128 + cidx * 8), (LAS unsigned*)(lds + KK + cidx * 2048 + mh * 1024), 16, 0, 0); }
#pragma unroll
    for (int i = 0; i < 4; ++i) { const int blk = wid * 4 + i, cb = blk >> 3, mg = blk & 7;
        __builtin_amdgcn_global_load_lds((const unsigned*)(Vg + (size_t)(16 * mg + (lane >> 2)) * 256 + 32 * cb + 8 * (lane & 3)), (LAS unsigned*)(lds + VV + blk * 1024), 16, 0, 0);
        __builtin_amdgcn_global_load_lds((const unsigned*)(Rg + (size_t)(16 * mg + (lane >> 2)) * 256 + 32 * cb + 8 * (lane & 3)), (LAS unsigned*)(lds + RB + blk * 1024), 16, 0, 0); }
    bf16x8 qf[8];
#pragma unroll
    for (int ks = 0; ks < 8; ++ks) qf[ks] = *(const bf16x8*)(Qg + (size_t)(32 * sb + r) * 128 + 16 * ks + 8 * hi);
    const int vperm = ((lane >> 4) & 1) * 32 + (lane & 3) * 8 + (4 * hi + ((lane & 15) >> 2)) * 64;
    const int vnat  = ((lane >> 4) & 1) * 32 + (lane & 3) * 8 + (8 * hi + ((lane & 15) >> 2)) * 64;
    asm volatile("s_waitcnt vmcnt(0)" ::: "memory");
    RET_BAR();
    bf16x8 pa[8];
#pragma unroll
    for (int kb = 0; kb < 4; ++kb) {
        if (kb <= sb) {
            bf16x8 kf[8];
#pragma unroll
            for (int ks = 0; ks < 8; ++ks) kf[ks] = *(const LAS bf16x8*)(lds + KK + (2 * ks + hi) * 2048 + (32 * kb + r) * 16);
            f32x16 p;
#pragma unroll
            for (int q = 0; q < 16; ++q) p[q] = 0.f;
#pragma unroll
            for (int ks = 0; ks < 8; ++ks) p = __builtin_amdgcn_mfma_f32_32x32x16_bf16(kf[ks], qf[ks], p, 0, 0, 0);
            if (kb == sb) {
#pragma unroll
                for (int q = 0; q < 16; ++q) if (crow(q, hi) > r) p[q] = 0.f;
            }
#pragma unroll
            for (int b8 = 0; b8 < 2; ++b8) { u32x4 w;
                w.x = pg8::cvt_pk_bf16(p[8 * b8 + 0], p[8 * b8 + 1]); w.y = pg8::cvt_pk_bf16(p[8 * b8 + 2], p[8 * b8 + 3]); w.z = pg8::cvt_pk_bf16(p[8 * b8 + 4], p[8 * b8 + 5]); w.w = pg8::cvt_pk_bf16(p[8 * b8 + 6], p[8 * b8 + 7]);
                pa[2 * kb + b8] = __builtin_bit_cast(bf16x8, w); }
        }
    }
    f32x16 y[2];
#pragma unroll
    for (int d0 = 0; d0 < 2; ++d0) {
#pragma unroll
        for (int q = 0; q < 16; ++q) y[d0][q] = 0.f;
        const int cb = 2 * ch + d0;
        bf16x8 vf[8];
#pragma unroll
        for (int kk = 0; kk < 8; ++kk) if ((kk >> 1) <= sb) vf[kk] = trfrag(lds + VV + (cb * 8 + kk) * 1024 + vperm, 512);
#pragma unroll
        for (int kk = 0; kk < 8; ++kk) if ((kk >> 1) <= sb) y[d0] = __builtin_amdgcn_mfma_f32_32x32x16_bf16(pa[kk], vf[kk], y[d0], 0, 0, 0);
        bf16x8 rf[8];
#pragma unroll
        for (int ks = 0; ks < 8; ++ks) rf[ks] = trfrag(lds + RB + (cb * 8 + ks) * 1024 + vnat, 256);
#pragma unroll
        for (int ks = 0; ks < 8; ++ks) y[d0] = __builtin_amdgcn_mfma_f32_32x32x16_bf16(qf[ks], rf[ks], y[d0], 0, 0, 0);
    }
    bf16* Yg = yret + (row0 + 32 * sb) * D + h * 256 + half * 128 + 64 * ch;
    store_tile64(y[0], y[1], lds + STG + wid * 4096, Yg, D, lane);
    RET_BAR();
}
__device__ __forceinline__ float rbflo(unsigned u) { return __builtin_bit_cast(float, u << 16); }
__device__ __forceinline__ float rbfhi(unsigned u) { return __builtin_bit_cast(float, u & 0xffff0000u); }
__device__ __forceinline__ void r3m_unit(const int b, const int h, const int j, const bf16* __restrict__ proj, const bf16* __restrict__ rbbuf, const bf16* __restrict__ odiff, bf16* __restrict__ merged,
                                         const float* __restrict__ ggn, const float* __restrict__ bgn, LAS unsigned char* lds) {
    constexpr int KK = 0, VV = 32768, RB = 65536, XS = 98304;
    int tid = threadIdx.x; asm volatile("" : "+v"(tid));
    const int lane = tid & 63, r = lane & 31, hi = lane >> 5; const int wid = __builtin_amdgcn_readfirstlane(tid >> 6), sb = wid & 3, ch = wid >> 2;
    const size_t row0 = (size_t)b * S + (size_t)j * 128, hrow = (size_t)(b * 4 + h) * S + (size_t)j * 128;
    const bf16* Qg = proj + PO_RQ + hrow * 128; const bf16* Kg = proj + PO_RK + hrow * 128; const bf16* Vg = proj + PO_RV + hrow * 256;
    const bf16* Rg = rbbuf + (((size_t)b * 4 + h) * 32 + j) * 32768;
#pragma unroll
    for (int i = 0; i < 4; ++i) { const int pc = wid * 4 + i, cidx = pc >> 1, mh = pc & 1;
        __builtin_amdgcn_global_load_lds((const unsigned*)(Kg + (size_t)(64 * mh + lane) * 128 + cidx * 8), (LAS unsigned*)(lds + KK + cidx * 2048 + mh * 1024), 16, 0, 0); }
#define R3M_DMA_VR(half_) do { _Pragma("unroll") for (int i = 0; i < 4; ++i) { const int blk = wid * 4 + i, cb = blk >> 3, mg = blk & 7; \
        __builtin_amdgcn_global_load_lds((const unsigned*)(Vg + (half_) * 128 + (size_t)(16 * mg + (lane >> 2)) * 256 + 32 * cb + 8 * (lane & 3)), (LAS unsigned*)(lds + VV + blk * 1024), 16, 0, 0); \
        __builtin_amdgcn_global_load_lds((const unsigned*)(Rg + (half_) * 128 + (size_t)(16 * mg + (lane >> 2)) * 256 + 32 * cb + 8 * (lane & 3)), (LAS unsigned*)(lds + RB + blk * 1024), 16, 0, 0); } } while (0)
    R3M_DMA_VR(0);
    bf16x8 qf[8];
#pragma unroll
    for (int ks = 0; ks < 8; ++ks) qf[ks] = *(const bf16x8*)(Qg + (size_t)(32 * sb + r) * 128 + 16 * ks + 8 * hi);
    const int vperm = ((lane >> 4) & 1) * 32 + (lane & 3) * 8 + (4 * hi + ((lane & 15) >> 2)) * 64;
    const int vnat  = ((lane >> 4) & 1) * 32 + (lane & 3) * 8 + (8 * hi + ((lane & 15) >> 2)) * 64;
    asm volatile("s_waitcnt vmcnt(0)" ::: "memory");
    RET_BAR();
    bf16x8 pa[8];
#pragma unroll
    for (int kb = 0; kb < 4; ++kb) {
        if (kb <= sb) {
            bf16x8 kf[8];
#pragma unroll
            for (int ks = 0; ks < 8; ++ks) kf[ks] = *(const LAS bf16x8*)(lds + KK + (2 * ks + hi) * 2048 + (32 * kb + r) * 16);
            f32x16 p;
#pragma unroll
            for (int q = 0; q < 16; ++q) p[q] = 0.f;
#pragma unroll
            for (int ks = 0; ks < 8; ++ks) p = __builtin_amdgcn_mfma_f32_32x32x16_bf16(kf[ks], qf[ks], p, 0, 0, 0);
            if (kb == sb) {
#pragma unroll
                for (int q = 0; q < 16; ++q) if (crow(q, hi) > r) p[q] = 0.f;
            }
#pragma unroll
            for (int b8 = 0; b8 < 2; ++b8) { u32x4 w;
                w.x = pg8::cvt_pk_bf16(p[8 * b8 + 0], p[8 * b8 + 1]); w.y = pg8::cvt_pk_bf16(p[8 * b8 + 2], p[8 * b8 + 3]); w.z = pg8::cvt_pk_bf16(p[8 * b8 + 4], p[8 * b8 + 5]); w.w = pg8::cvt_pk_bf16(p[8 * b8 + 6], p[8 * b8 + 7]);
                pa[2 * kb + b8] = __builtin_bit_cast(bf16x8, w); }
        }
    }
    f32x16 y[2][2];
#define R3M_HALF(hf_) do { _Pragma("unroll") for (int d0 = 0; d0 < 2; ++d0) { \
        _Pragma("unroll") for (int q = 0; q < 16; ++q) y[hf_][d0][q] = 0.f; \
        const int cb = 2 * ch + d0; \
        bf16x8 vf[8]; \
        _Pragma("unroll") for (int kk = 0; kk < 8; ++kk) if ((kk >> 1) <= sb) vf[kk] = trfrag(lds + VV + (cb * 8 + kk) * 1024 + vperm, 512); \
        _Pragma("unroll") for (int kk = 0; kk < 8; ++kk) if ((kk >> 1) <= sb) y[hf_][d0] = __builtin_amdgcn_mfma_f32_32x32x16_bf16(pa[kk], vf[kk], y[hf_][d0], 0, 0, 0); \
        bf16x8 rf[8]; \
        _Pragma("unroll") for (int ks = 0; ks < 8; ++ks) rf[ks] = trfrag(lds + RB + (cb * 8 + ks) * 1024 + vnat, 256); \
        _Pragma("unroll") for (int ks = 0; ks < 8; ++ks) y[hf_][d0] = __builtin_amdgcn_mfma_f32_32x32x16_bf16(qf[ks], rf[ks], y[hf_][d0], 0, 0, 0); } } while (0)
    R3M_HALF(0);
    RET_BAR();
    R3M_DMA_VR(1);
    asm volatile("s_waitcnt vmcnt(0)" ::: "memory");
    RET_BAR();
    R3M_HALF(1);
    RET_BAR();
#undef R3M_DMA_VR
#undef R3M_HALF
    LAS unsigned char* stg = lds + wid * 8192;
#pragma unroll
    for (int hf = 0; hf < 2; ++hf)
#pragma unroll
        for (int d0 = 0; d0 < 2; ++d0)
#pragma unroll
            for (int q = 0; q < 16; ++q) *(LAS bf16*)(stg + crow(q, hi) * 256 + (hf * 64 + d0 * 32 + r) * 2) = f2bf(y[hf][d0][q]);
    asm volatile("s_waitcnt lgkmcnt(0)" ::: "memory");
    const int rs4 = lane >> 4, seg = lane & 15;
    u32x4 yv[8]; float sm[8], sq[8];
#pragma unroll
    for (int i = 0; i < 8; ++i) { yv[i] = *(const LAS u32x4*)(stg + (4 * i + rs4) * 256 + seg * 16);
        const float v0 = rbflo(yv[i].x), v1 = rbfhi(yv[i].x), v2 = rbflo(yv[i].y), v3 = rbfhi(yv[i].y), v4 = rbflo(yv[i].z), v5 = rbfhi(yv[i].z), v6 = rbflo(yv[i].w), v7 = rbfhi(yv[i].w);
        sm[i] = ((v0 + v1) + (v2 + v3)) + ((v4 + v5) + (v6 + v7)); sq[i] = ((v0 * v0 + v1 * v1) + (v2 * v2 + v3 * v3)) + ((v4 * v4 + v5 * v5) + (v6 * v6 + v7 * v7)); }
#pragma unroll
    for (int i = 0; i < 8; ++i) { sm[i] = rowsum16(sm[i]); sq[i] = rowsum16(sq[i]); }
    LAS float* xs = (LAS float*)(lds + XS);
    if (seg == 0) {
#pragma unroll
        for (int i = 0; i < 8; ++i) { xs[(wid * 32 + 4 * i + rs4) * 2] = sm[i]; xs[(wid * 32 + 4 * i + rs4) * 2 + 1] = sq[i]; } }
    RET_BAR();
    const int col = 256 * h + (seg < 8 ? 64 * ch + 8 * seg : 128 + 64 * ch + 8 * (seg - 8));
    const f32x4 g0 = *(const f32x4*)(ggn + col), g1 = *(const f32x4*)(ggn + col + 4), b0 = *(const f32x4*)(bgn + col), b1 = *(const f32x4*)(bgn + col + 4);
#pragma unroll
    for (int ib = 0; ib < 8; ib += 4) {
        u32x4 G1[4], G2[4], OD[4];
#pragma unroll
        for (int i = 0; i < 4; ++i) { const size_t tok = row0 + 32 * sb + 4 * (ib + i) + rs4;
            G1[i] = *(const u32x4*)(proj + PO_RG + tok * 1024 + col); G2[i] = *(const u32x4*)(proj + PO_MG + (size_t)T * 1024 + tok * 1024 + col); OD[i] = *(const u32x4*)(odiff + tok * D + col); }
#pragma unroll
        for (int i = 0; i < 4; ++i) { const int rw = 4 * (ib + i) + rs4; const size_t tok = row0 + 32 * sb + rw;
            const float ts = sm[ib + i] + xs[((wid ^ 4) * 32 + rw) * 2], tq = sq[ib + i] + xs[((wid ^ 4) * 32 + rw) * 2 + 1];
            const float mu = ts * (1.f / 256), rs = __builtin_amdgcn_rsqf(fmaxf(tq * (1.f / 256) - mu * mu, 0.f) + EPS);
            const unsigned yw[4] = {yv[ib + i].x, yv[ib + i].y, yv[ib + i].z, yv[ib + i].w}, g1w[4] = {G1[i].x, G1[i].y, G1[i].z, G1[i].w}, g2w[4] = {G2[i].x, G2[i].y, G2[i].z, G2[i].w}, odw[4] = {OD[i].x, OD[i].y, OD[i].z, OD[i].w};
            unsigned ow[4];
#pragma unroll
            for (int e = 0; e < 4; ++e) { const float gA = e < 2 ? g0[2 * e] : g1[2 * e - 4], gB = e < 2 ? g0[2 * e + 1] : g1[2 * e - 3], bA = e < 2 ? b0[2 * e] : b1[2 * e - 4], bB = e < 2 ? b0[2 * e + 1] : b1[2 * e - 3];
                const float mA = rbflo(g1w[e]) * ((rbflo(yw[e]) - mu) * rs * gA + bA) + rbflo(g2w[e]) * rbflo(odw[e]);
                const float mB = rbfhi(g1w[e]) * ((rbfhi(yw[e]) - mu) * rs * gB + bB) + rbfhi(g2w[e]) * rbfhi(odw[e]);
                ow[e] = pg8::cvt_pk_bf16(mA, mB); }
            *(u32x4*)(merged + tok * D + col) = (u32x4){ow[0], ow[1], ow[2], ow[3]}; }
    }
    RET_BAR();
}
}

struct Args { const float* in[23]; float* out; unsigned char* ws; int ph_lo, ph_hi; };
#define LDS_WAIT() asm volatile("s_waitcnt lgkmcnt(0)" ::: "memory")
__device__ __forceinline__ float wsum(float v) {
#pragma unroll
    for (int o = 1; o < 64; o <<= 1) v += __shfl_xor(v, o);
    return v;
}
__device__ __forceinline__ unsigned pk2(float lo, float hi) { return pg8::cvt_pk_bf16(lo, hi); }
__device__ __forceinline__ float bflo(unsigned u) { return __builtin_bit_cast(float, u << 16); }
__device__ __forceinline__ float bfhi(unsigned u) { return __builtin_bit_cast(float, u & 0xffff0000u); }

template <bool F8>
__device__ __forceinline__ void transpose_item(const float* __restrict__ W, int K, int N, bf16* __restrict__ WT, LAS float* scr, int k0, int n0, int l0, int lane) {
    float wv[32];
#pragma unroll
    for (int i = 0; i < 32; ++i) wv[i] = __builtin_nontemporal_load(W + (size_t)(k0 + 2 * i + (lane >> 5)) * N + l0 + (lane & 31));
#pragma unroll
    for (int i = 0; i < 32; ++i) scr[(2 * i + (lane >> 5)) * 33 + (lane & 31)] = wv[i];
    LDS_WAIT(); asm volatile("" ::: "memory");
    const int c = lane & 7;
#pragma unroll
    for (int j = 0; j < 4; ++j) { const int n = (lane >> 3) + 8 * j; const LAS float* s = scr + (8 * c) * 33 + n;
        if constexpr (F8) { u32x2 o; o.x = pk4_fp8(s[0 * 33], s[1 * 33], s[2 * 33], s[3 * 33], (float)(1 << W_SH)); o.y = pk4_fp8(s[4 * 33], s[5 * 33], s[6 * 33], s[7 * 33], (float)(1 << W_SH));
            *(u32x2*)((unsigned char*)WT + (size_t)(n0 + n) * K + k0 + 8 * c) = o; }
        else { u32x4 o; o.x = pk2(s[0 * 33], s[1 * 33]); o.y = pk2(s[2 * 33], s[3 * 33]); o.z = pk2(s[4 * 33], s[5 * 33]); o.w = pk2(s[6 * 33], s[7 * 33]);
            *(u32x4*)(WT + (size_t)(n0 + n) * K + k0 + 8 * c) = o; } }
    LDS_WAIT(); asm volatile("" ::: "memory");
}

__device__ __forceinline__ void transpose_pair_f8(const float* __restrict__ Wa, const float* __restrict__ Wb, int K, int N, unsigned char* __restrict__ WTa, unsigned char* __restrict__ WTb, LAS float* scr,
                                                  int k0a, int n0a, int l0a, int k0b, int n0b, int l0b, int lane) {
    float wa[32], wb[32];
#pragma unroll
    for (int i = 0; i < 32; ++i) wa[i] = __builtin_nontemporal_load(Wa + (size_t)(k0a + 2 * i + (lane >> 5)) * N + l0a + (lane & 31));
#pragma unroll
    for (int i = 0; i < 32; ++i) wb[i] = __builtin_nontemporal_load(Wb + (size_t)(k0b + 2 * i + (lane >> 5)) * N + l0b + (lane & 31));
    const int c = lane & 7;
#pragma unroll
    for (int p = 0; p < 2; ++p) {
#pragma unroll
        for (int i = 0; i < 32; ++i) scr[(2 * i + (lane >> 5)) * 33 + (lane & 31)] = p ? wb[i] : wa[i];
        LDS_WAIT(); asm volatile("" ::: "memory");
        unsigned char* WT = p ? WTb : WTa; const int k0 = p ? k0b : k0a, n0 = p ? n0b : n0a;
#pragma unroll
        for (int j = 0; j < 4; ++j) { const int n = (lane >> 3) + 8 * j; const LAS float* s = scr + (8 * c) * 33 + n;
            u32x2 o; o.x = pk4_fp8(s[0 * 33], s[1 * 33], s[2 * 33], s[3 * 33], (float)(1 << W_SH)); o.y = pk4_fp8(s[4 * 33], s[5 * 33], s[6 * 33], s[7 * 33], (float)(1 << W_SH));
            *(u32x2*)(WT + (size_t)(n0 + n) * K + k0 + 8 * c) = o; }
        LDS_WAIT(); asm volatile("" ::: "memory");
    }
}

__device__ __forceinline__ void phase_prologue(const Args& args, unsigned char* ws, LAS unsigned char* lds, int vcu, int G) {
    const int tid = threadIdx.x, lane = tid & 63, wave = __builtin_amdgcn_readfirstlane(tid >> 6);
    const float* c = args.in[1]; const float* w_ada = args.in[2]; const float* b_ada = args.in[3]; float* mod = (float*)(ws + WS_MOD);
    for (int blk = vcu; blk < 96; blk += G) {
        LAS float* sc = (LAS float*)lds;
        LAS float* part = (LAS float*)(lds + 32768);
        for (int i = tid; i < NB * D; i += 512) { const float v = c[i]; sc[i] = v * fast_sigmoid(v); }
        __syncthreads();
        float acc[NB];
#pragma unroll
        for (int b = 0; b < NB; ++b) acc[b] = 0.f;
        const float* wp = w_ada + (size_t)(wave * 128) * 6144 + blk * 64 + lane;
        for (int k0 = 0; k0 < 128; k0 += 32) { float wv[32];
#pragma unroll
            for (int k = 0; k < 32; ++k) wv[k] = __builtin_nontemporal_load(wp + (size_t)(k0 + k) * 6144);
#pragma unroll
            for (int k = 0; k < 32; ++k)
#pragma unroll
                for (int b = 0; b < NB; ++b) acc[b] += sc[b * D + wave * 128 + k0 + k] * wv[k]; }
#pragma unroll
        for (int b = 0; b < NB; ++b) part[(wave * NB + b) * 64 + lane] = acc[b];
        __syncthreads();
        { const int b = tid >> 6; float s = b_ada[blk * 64 + lane];
#pragma unroll
            for (int w = 0; w < 8; ++w) s += part[(w * NB + b) * 64 + lane];
            mod[b * 6144 + blk * 64 + lane] = s; }
        __syncthreads();
    }
    if (vcu == (96 % G)) {
        bf16* wrt = (bf16*)(ws + WS_WRT); const float* wr = args.in[17];
        for (int i = tid; i < NE * D; i += 512) { const int e = i >> 10, k = i & 1023; const float w = wr[(size_t)k * NE + e]; const bf16 hb_ = f2bf(w); wrt[i] = hb_; wrt[NE * D + i] = f2bf(w - bf2f(hb_)); }
    }
    LAS float* scr = (LAS float*)(lds + wave * 16384);
    const int gw = vcu * 8 + wave, NGW = G * 8;
    constexpr int I_IN = (D / 64) * (INW / 32), I_OUT = (D / 64) * (D / 32), I_W1 = (D / 64) * (2048 / 32), I_W2 = (FF / 64) * (D / 32);
    constexpr int I_IN8 = IN_GATE_F8 ? (D / 64) * (12 * 8) : 0;
    static_assert(MOE_W_IN_QUEUE == 1, "expert weights (and w_out) are transposed by items of the mixer work queue");
    constexpr int NV = I_IN8 + I_IN;
    const int ngem = G > 96 ? 96 : 0, own = ngem * 8;
    const int first = vcu < ngem ? vcu * 8 + wave : own + (vcu - ngem) * 8 + wave, step = vcu < ngem ? NV : (G - ngem) * 8;
    for (int v = first; v < NV; v += step) {
        if (v < I_IN8) { const int kb = v / 96, q = v % 96, tl = q >> 3, n0 = 256 * (tl < 8 ? 8 + tl : 20 + tl) + 32 * (q & 7);
            transpose_item<true>(args.in[5], D, INW, (bf16*)(ws + WS_WIN8), scr, 64 * kb, n0, in_p2l(n0), lane); }
        else { const int rr = v - I_IN8, nblk = INW / 32, kb = rr / nblk, nb = rr % nblk; transpose_item<FP8_IN != 0>(args.in[5], D, INW, (bf16*)(ws + WS_WIN), scr, 64 * kb, 32 * nb, in_p2l(32 * nb), lane); }
    }
    (void)gw; (void)NGW; (void)I_OUT; (void)I_W1; (void)I_W2;
}

__device__ __forceinline__ void wout_item(const Args& args, unsigned char* ws, LAS float* scr, int rr, int lane) {
    const int nblk = D / 32, kb = rr / nblk, nb = rr % nblk; transpose_item<FP8_OUT != 0>(args.in[15], D, D, (bf16*)(ws + WS_WOUT), scr, 64 * kb, 32 * nb, 32 * nb, lane);
}

__device__ __forceinline__ void moe_w_item(const Args& args, unsigned char* ws, LAS float* scr, int rr, int lane) {
    constexpr int I_W1 = (D / 64) * (2048 / 32), I_W2 = (FF / 64) * (D / 32);
    if (rr < NE * I_W1) { const int e = rr / I_W1, q = rr % I_W1, nblk = 2048 / 32, kb = q / nblk, nb = q % nblk;
        transpose_item<FP8_MOE != 0>(args.in[19] + (size_t)e * D * 2048, D, 2048, (bf16*)(ws + WS_W1 + (size_t)e * 2048 * D * (FP8_MOE ? 1 : 2)), scr, 64 * kb, 32 * nb, w1_p2l(32 * nb), lane); return; }
    rr -= NE * I_W1;
    { const int e = rr / I_W2, q = rr % I_W2, nblk = D / 32, kb = q / nblk, nb = q % nblk;
        transpose_item<FP8_MOE != 0>(args.in[21] + (size_t)e * FF * D, FF, D, (bf16*)(ws + WS_W2 + (size_t)e * D * FF * (FP8_MOE ? 1 : 2)), scr, 64 * kb, 32 * nb, 32 * nb, lane); }
}

__device__ __forceinline__ void moe_w_pair(const Args& args, unsigned char* ws, LAS float* scr, int pr, int lane) {
    constexpr int I_W1 = (D / 64) * (2048 / 32), I_W2 = (FF / 64) * (D / 32);
    int rr = 2 * pr;
    if (rr < NE * I_W1) { const int e = rr / I_W1, q = rr % I_W1, nblk = 2048 / 32, kb = q / nblk, nb = q % nblk; const float* W = args.in[19] + (size_t)e * D * 2048; unsigned char* WT = ws + WS_W1 + (size_t)e * 2048 * D;
        transpose_pair_f8(W, W, D, 2048, WT, WT, scr, 64 * kb, 32 * nb, w1_p2l(32 * nb), 64 * kb, 32 * (nb + 1), w1_p2l(32 * (nb + 1)), lane); return; }
    rr -= NE * I_W1;
    { const int e = rr / I_W2, q = rr % I_W2, nblk = D / 32, kb = q / nblk, nb = q % nblk; const float* W = args.in[21] + (size_t)e * FF * D; unsigned char* WT = ws + WS_W2 + (size_t)e * D * FF;
        transpose_pair_f8(W, W, FF, D, WT, WT, scr, 64 * kb, 32 * nb, 32 * nb, 64 * kb, 32 * (nb + 1), 32 * (nb + 1), lane); }
}

__device__ __forceinline__ void modnorm_row(const float* __restrict__ xrow, const float* __restrict__ g, const float* __restrict__ sc, const float* __restrict__ sh, bf16* __restrict__ orow, int lane, f32x4 (&v)[4]) {
    float ss = 0.f;
#pragma unroll
    for (int i = 0; i < 4; ++i) { v[i] = *(const f32x4*)(xrow + 4 * lane + 256 * i); ss += (v[i][0] * v[i][0] + v[i][1] * v[i][1]) + (v[i][2] * v[i][2] + v[i][3] * v[i][3]); }
    const float rs = __builtin_amdgcn_rsqf(wsum(ss) * (1.f / D) + EPS);
#pragma unroll
    for (int i = 0; i < 4; ++i) { const int cc = 4 * lane + 256 * i; const f32x4 gg = *(const f32x4*)(g + cc), s1 = *(const f32x4*)(sc + cc), s0 = *(const f32x4*)(sh + cc);
        v[i] = v[i] * rs * gg * (s1 + 1.f) + s0;
        u32x2 o; o.x = pk2(v[i][0], v[i][1]); o.y = pk2(v[i][2], v[i][3]); *(u32x2*)(orow + cc) = o; }
}
template <bool TILE, bool F8, bool XBF = false>
__device__ __forceinline__ void modnorm4(const float* __restrict__ xr, const float* __restrict__ g, const float* __restrict__ sc, const float* __restrict__ sh, bf16* __restrict__ orow, LAS unsigned char* tile, int rtp, int lane, unsigned char* __restrict__ orow8 = nullptr) {
    f32x4 v[4][4];
#pragma unroll
    for (int j = 0; j < 4; ++j)
#pragma unroll
        for (int i = 0; i < 4; ++i) { if constexpr (XBF) { const u32x2 w = *(const u32x2*)((const bf16*)xr + (size_t)j * D + 4 * lane + 256 * i); v[j][i] = (f32x4){bflo(w.x), bfhi(w.x), bflo(w.y), bfhi(w.y)}; }
            else v[j][i] = __builtin_nontemporal_load((const f32x4*)(xr + (size_t)j * D + 4 * lane + 256 * i)); }
    f32x4 gg[4], s1[4], s0[4];
#pragma unroll
    for (int i = 0; i < 4; ++i) { const int cc = 4 * lane + 256 * i; gg[i] = *(const f32x4*)(g + cc); s1[i] = *(const f32x4*)(sc + cc) + 1.f; s0[i] = *(const f32x4*)(sh + cc); gg[i] = gg[i] * s1[i]; }
#pragma unroll
    for (int j = 0; j < 4; ++j) { float ss = 0.f;
#pragma unroll
        for (int i = 0; i < 4; ++i) ss += (v[j][i][0] * v[j][i][0] + v[j][i][1] * v[j][i][1]) + (v[j][i][2] * v[j][i][2] + v[j][i][3] * v[j][i][3]);
        const float rs = __builtin_amdgcn_rsqf(wsum(ss) * (1.f / D) + EPS);
#pragma unroll
        for (int i = 0; i < 4; ++i) { const int cc = 4 * lane + 256 * i; const f32x4 o = v[j][i] * rs * gg[i] + s0[i];
            u32x2 pk; pk.x = pk2(o[0], o[1]); pk.y = pk2(o[2], o[3]);
            if constexpr (F8) *(unsigned*)((unsigned char*)orow + (size_t)j * D + cc) = pk4_fp8(o[0], o[1], o[2], o[3], (float)(1 << A_SH));
            else *(u32x2*)(orow + (size_t)j * D + cc) = pk;
            if (orow8) *(unsigned*)(orow8 + (size_t)j * D + cc) = pk4_fp8(o[0], o[1], o[2], o[3], (float)(1 << A_SH));
            if constexpr (TILE) *(LAS u32x2*)(tile + j * rtp + cc * 2) = pk; } }
}
__device__ __forceinline__ void phase_h1(const Args& args, unsigned char* ws, int vcu, int G) {
    const int lane = threadIdx.x & 63, wave = __builtin_amdgcn_readfirstlane(threadIdx.x >> 6); const float* mod = (const float*)(ws + WS_MOD); bf16* hb = (bf16*)(ws + WS_H);
    for (int t = (vcu * 8 + wave) * 4; t < T; t += G * 32) { const int b = t / S;
        modnorm4<false, FP8_IN != 0>(args.in[0] + (size_t)t * D, args.in[4], mod + b * 6144 + 1024, mod + b * 6144, (bf16*)((unsigned char*)hb + (size_t)t * D * (FP8_IN ? 1 : 2)), nullptr, 0, lane, IN_GATE_F8 ? ws + WS_H8 + (size_t)t * D : nullptr); }
}

__device__ __forceinline__ void phase_merge(const Args& args, unsigned char* ws, int vcu, int G) {
    const int lane = threadIdx.x & 63, wave = __builtin_amdgcn_readfirstlane(threadIdx.x >> 6);
    const bf16* proj = (const bf16*)(ws + WS_PROJ); const bf16* yret = (const bf16*)(ws + WS_YRET); const bf16* odiff = (const bf16*)(ws + WS_ODIFF); bf16* merged = (bf16*)(ws + WS_MRG);
    const float* ggn = args.in[6]; const float* bgn = args.in[7];
    f32x4 gg[4], bb[4];
#pragma unroll
    for (int i = 0; i < 4; ++i) { gg[i] = *(const f32x4*)(ggn + 4 * lane + 256 * i); bb[i] = *(const f32x4*)(bgn + 4 * lane + 256 * i); }
    constexpr int TB = 2;
    for (int t = (vcu * 8 + wave) * TB; t < T; t += G * 8 * TB) {
        u32x2 yy[TB][4], rg[TB][4], md[TB][4], od[TB][4];
#pragma unroll
        for (int j = 0; j < TB; ++j) { const bf16* prg = proj + PO_RG + (size_t)(t + j) * 1024; const bf16* pmg = proj + PO_MG + (size_t)(t + j) * 1024;
#pragma unroll
            for (int i = 0; i < 4; ++i) { const int cc = 4 * lane + 256 * i;
                yy[j][i] = *(const u32x2*)(yret + (size_t)(t + j) * D + cc); od[j][i] = *(const u32x2*)(odiff + (size_t)(t + j) * D + cc);
                rg[j][i] = *(const u32x2*)(prg + cc); md[j][i] = *(const u32x2*)(pmg + (size_t)T * 1024 + cc); } }
#pragma unroll
        for (int j = 0; j < TB; ++j)
#pragma unroll
            for (int i = 0; i < 4; ++i) { const int cc = 4 * lane + 256 * i;
                float y[4] = {bflo(yy[j][i].x), bfhi(yy[j][i].x), bflo(yy[j][i].y), bfhi(yy[j][i].y)};
                const float mu = wsum((y[0] + y[1]) + (y[2] + y[3])) * (1.f / 256);
                float vv = 0.f;
#pragma unroll
                for (int e = 0; e < 4; ++e) { y[e] -= mu; vv += y[e] * y[e]; }
                const float rs = __builtin_amdgcn_rsqf(wsum(vv) * (1.f / 256) + EPS);
                const float rgv[4] = {bflo(rg[j][i].x), bfhi(rg[j][i].x), bflo(rg[j][i].y), bfhi(rg[j][i].y)};
                const float mdv[4] = {bflo(md[j][i].x), bfhi(md[j][i].x), bflo(md[j][i].y), bfhi(md[j][i].y)}, odv[4] = {bflo(od[j][i].x), bfhi(od[j][i].x), bflo(od[j][i].y), bfhi(od[j][i].y)};
                float m[4];
#pragma unroll
                for (int e = 0; e < 4; ++e) m[e] = rgv[e] * (y[e] * rs * gg[i][e] + bb[i][e]) + mdv[e] * odv[e];
                if (FP8_OUT) *(unsigned*)((unsigned char*)merged + (size_t)(t + j) * D + cc) = pk4_fp8(m[0], m[1], m[2], m[3], (float)(1 << A_SH));
                else { u32x2 o; o.x = pk2(m[0], m[1]); o.y = pk2(m[2], m[3]); *(u32x2*)(merged + (size_t)(t + j) * D + cc) = o; } }
    }
}

constexpr int RT_PITCH = 2064;
constexpr int RT_H = 0, RT_P = 32 * RT_PITCH, RT_L = RT_P + 8 * 32 * 32 * 4, RT_CNT = RT_L + 128 * 33 * 4, RT_SEL = RT_CNT + 128;
static_assert(RT_SEL + 2048 <= LDS_STAGE_BYTES, "route LDS map");
__device__ __forceinline__ void phase_route(const Args& args, unsigned char* ws, LAS unsigned char* lds, int vcu, int G) {
    const int tid = threadIdx.x, lane = tid & 63, r = lane & 31, hi = lane >> 5, wave = __builtin_amdgcn_readfirstlane(tid >> 6);
    const float* mod = (const float*)(ws + WS_MOD); bf16* h2 = (bf16*)(ws + WS_H); unsigned* ctl = (unsigned*)(ws + WS_CTL);
    int* tok_e = (int*)(ws + WS_ROUTE); int* tok_pos = tok_e + T * 4; float* tok_w = (float*)(tok_pos + T * 4); int* list = (int*)(ws + WS_LIST);
    const bf16* wrt = (const bf16*)(ws + WS_WRT); const float* br = args.in[18];
    LAS unsigned* lcnt = (LAS unsigned*)(lds + RT_CNT); LAS unsigned* lsel = (LAS unsigned*)(lds + RT_SEL); LAS float* P = (LAS float*)(lds + RT_P); LAS float* L = (LAS float*)(lds + RT_L);
    bf16x8 bh[8], bl[8];
#pragma unroll
    for (int ks = 0; ks < 8; ++ks) { bh[ks] = *(const bf16x8*)(wrt + (size_t)r * D + 128 * wave + 16 * ks + 8 * hi); bl[ks] = *(const bf16x8*)(wrt + (size_t)(NE + r) * D + 128 * wave + 16 * ks + 8 * hi); }
    for (int t0 = vcu * 128; t0 < T; t0 += G * 128) {
        const int b = t0 / S;
        if (tid < NE) lcnt[tid] = 0u;
        const bf16* x1b = (const bf16*)(ws + WS_X1B); const float* sc2 = mod + b * 6144 + 4096; const float* sh2 = mod + b * 6144 + 3072;
        f32x4 gg[4], s0[4];
#pragma unroll
        for (int i = 0; i < 4; ++i) { const int cc = 4 * lane + 256 * i; gg[i] = *(const f32x4*)(args.in[16] + cc) * (*(const f32x4*)(sc2 + cc) + 1.f); s0[i] = *(const f32x4*)(sh2 + cc); }
        u32x2 xr[4][4];
#define RT_LOADX(sbi_) do { const size_t tr_ = (size_t)(t0 + 32 * (sbi_) + 4 * wave); _Pragma("unroll") for (int j = 0; j < 4; ++j) _Pragma("unroll") for (int i = 0; i < 4; ++i) \
            xr[j][i] = *(const u32x2*)(x1b + (tr_ + j) * D + 4 * lane + 256 * i); } while (0)
        RT_LOADX(0);
        for (int sbi = 0; sbi < 4; ++sbi) {
            { const int tl = 4 * wave; const size_t tr = (size_t)(t0 + 32 * sbi + tl);
#pragma unroll
                for (int j = 0; j < 4; ++j) { f32x4 v[4]; float ss = 0.f;
#pragma unroll
                    for (int i = 0; i < 4; ++i) { v[i] = (f32x4){bflo(xr[j][i].x), bfhi(xr[j][i].x), bflo(xr[j][i].y), bfhi(xr[j][i].y)};
                        ss += (v[i][0] * v[i][0] + v[i][1] * v[i][1]) + (v[i][2] * v[i][2] + v[i][3] * v[i][3]); }
                    const float rs = __builtin_amdgcn_rsqf(wsum(ss) * (1.f / D) + EPS);
#pragma unroll
                    for (int i = 0; i < 4; ++i) { const int cc = 4 * lane + 256 * i; const f32x4 o = v[i] * rs * gg[i] + s0[i];
                        u32x2 pk; pk.x = pk2(o[0], o[1]); pk.y = pk2(o[2], o[3]);
                        if (FP8_MOE) *(unsigned*)((unsigned char*)h2 + (tr + j) * D + cc) = pk4_fp8(o[0], o[1], o[2], o[3], (float)(1 << A_SH));
                        else *(u32x2*)(h2 + (tr + j) * D + cc) = pk;
                        *(LAS u32x2*)(lds + RT_H + (tl + j) * RT_PITCH + cc * 2) = pk; } } }
            if (sbi < 3) RT_LOADX(sbi + 1);
            __syncthreads();
            { f32x16 acc;
#pragma unroll
                for (int q = 0; q < 16; ++q) acc[q] = 0.f;
#pragma unroll
                for (int ks = 0; ks < 8; ++ks) { const bf16x8 a = *(const LAS bf16x8*)(lds + RT_H + r * RT_PITCH + (128 * wave + 16 * ks + 8 * hi) * 2);
                    acc = __builtin_amdgcn_mfma_f32_32x32x16_bf16(a, bh[ks], acc, 0, 0, 0); acc = __builtin_amdgcn_mfma_f32_32x32x16_bf16(a, bl[ks], acc, 0, 0, 0); }
#pragma unroll
                for (int q = 0; q < 16; ++q) P[(wave * 32 + crow(q, hi)) * 32 + r] = acc[q]; }
            __syncthreads();
#pragma unroll
            for (int u = 0; u < 2; ++u) { const int idx = tid + 512 * u, tk = idx >> 5, e = idx & 31; float s = br[e];
#pragma unroll
                for (int w = 0; w < 8; ++w) s += P[(w * 32 + tk) * 32 + e];
                L[(32 * sbi + tk) * 33 + e] = s; }
        }
#undef RT_LOADX
        __syncthreads();
        if (tid < 128) { const int t = t0 + tid;
            float lg[NE];
#pragma unroll
            for (int e = 0; e < NE; ++e) lg[e] = L[tid * 33 + e];
            unsigned used = 0u; float tv0 = 0.f, den = 0.f; float wv[TOPK]; int ev[TOPK];
#pragma unroll
            for (int k = 0; k < TOPK; ++k) { float best = -INFINITY; int bi = 0;
#pragma unroll
                for (int e = 0; e < NE; ++e) { const bool ok = !((used >> e) & 1u) && lg[e] > best; best = ok ? lg[e] : best; bi = ok ? e : bi; }
                used |= 1u << bi; if (k == 0) tv0 = best; wv[k] = __expf(best - tv0); den += wv[k]; ev[k] = bi; }
            const float rden = 1.f / den;
#pragma unroll
            for (int k = 0; k < TOPK; ++k) { const unsigned lp = atomicAdd((unsigned*)&lcnt[ev[k]], 1u);
                lsel[tid * 4 + k] = ((unsigned)ev[k] << 16) | lp; tok_e[t * 4 + k] = ev[k]; tok_w[t * 4 + k] = wv[k] * rden; } }
        __syncthreads();
        if (tid < NE) { const unsigned n = lcnt[tid]; lcnt[tid] = n ? atomicAdd(&ctl[CW_CNT + tid], n) : 0u; }
        __syncthreads();
        { const unsigned s = lsel[tid]; const int e = (int)(s >> 16); const int pos = (int)(lcnt[e] + (s & 0xffffu)); const int t = t0 + (tid >> 2);
            tok_pos[t * 4 + (tid & 3)] = pos; list[(size_t)e * T + pos] = t; }
        __syncthreads();
    }
}

__device__ __forceinline__ void phase_scan(unsigned char* ws, int vcu, int G) {
    const bf16* ubuf = (const bf16*)(ws + WS_H); bf16* rbbuf = (bf16*)(ws + WS_MERGED);
    for (int task = vcu * 512 + (int)threadIdx.x; task < 32 * 4096; task += G * 512) {
        const int bh = task >> 12, e8 = task & 4095, h = bh & 3;
        const float lg = __builtin_amdgcn_logf(1.f - __builtin_amdgcn_exp2f(-5.f - (float)h));
        const float gam = __builtin_amdgcn_exp2f(lg), gC = __builtin_amdgcn_exp2f(lg * 128.f), gC1 = __builtin_amdgcn_exp2f(lg * 127.f);
        const bf16* up = ubuf + (size_t)bh * 32 * 32768 + e8 * 8; bf16* rp = rbbuf + (size_t)bh * 32 * 32768 + e8 * 8;
        float R[8];
#pragma unroll
        for (int i = 0; i < 8; ++i) R[i] = 0.f;
        for (int j0 = 0; j0 < 32; j0 += 8) {
            u32x4 uv[8];
#pragma unroll
            for (int jj = 0; jj < 8; ++jj) uv[jj] = *(const u32x4*)(up + (size_t)(j0 + jj) * 32768);
#pragma unroll
            for (int jj = 0; jj < 8; ++jj) {
                u32x4 o; o.x = pk2(R[0] * gam, R[1] * gam); o.y = pk2(R[2] * gam, R[3] * gam); o.z = pk2(R[4] * gam, R[5] * gam); o.w = pk2(R[6] * gam, R[7] * gam);
                *(u32x4*)(rp + (size_t)(j0 + jj) * 32768) = o;
#pragma unroll
                for (int q = 0; q < 4; ++q) { R[2 * q] = gC * R[2 * q] + gC1 * bflo(uv[jj][q]); R[2 * q + 1] = gC * R[2 * q + 1] + gC1 * bfhi(uv[jj][q]); } }
        }
    }
}

__device__ __forceinline__ int build_expert_tables(const unsigned* ctl, LAS unsigned* rbtab, LAS unsigned* rbfirst) {
    if (threadIdx.x < 64) {
        const int e = threadIdx.x & 31; const unsigned c = __hip_atomic_load(&ctl[CW_CNT + e], __ATOMIC_RELAXED, __HIP_MEMORY_SCOPE_AGENT), nb = (c + 255u) >> 8;
        unsigned inc = nb;
#pragma unroll
        for (int o = 1; o < 32; o <<= 1) { const unsigned t = __shfl_up(inc, o, 32); inc += (e >= o) ? t : 0u; }
        const unsigned rb = inc - nb;
        if (threadIdx.x < 32) { rbfirst[e] = rb; if (e == NE - 1) rbfirst[NE] = inc; for (unsigned i = 0; i < nb; ++i) rbtab[rb + i] = (unsigned)e; } }
    __syncthreads();
    return __builtin_amdgcn_readfirstlane((int)rbfirst[NE]);
}

__device__ __forceinline__ void phase_combine(const Args& args, unsigned char* ws, const LAS unsigned* rbfirst, int vcu, int G) {
    const int lane = threadIdx.x & 63, wave = __builtin_amdgcn_readfirstlane(threadIdx.x >> 6);
    const float* mod = (const float*)(ws + WS_MOD); const unsigned char* eo = ws + WS_EO; const bf16* x1b = (const bf16*)(ws + WS_X1B);
    const int* tok_e = (const int*)(ws + WS_ROUTE); const int* tok_pos = tok_e + T * 4; const float* tok_w = (const float*)(tok_pos + T * 4);
    constexpr int TB = 2; constexpr float ESC = 1.f / (float)(1 << E_SH);
    typedef float f32x2_t __attribute__((ext_vector_type(2)));
    for (int t = (vcu * 8 + wave) * TB; t < T; t += G * 8 * TB) { const int b = t / S;
        const unsigned char* rp[TB][TOPK]; float w[TB][TOPK];
#pragma unroll
        for (int j = 0; j < TB; ++j)
#pragma unroll
            for (int k = 0; k < TOPK; ++k) { const int e = tok_e[(t + j) * 4 + k]; rp[j][k] = eo + ((size_t)rbfirst[e] * 256 + tok_pos[(t + j) * 4 + k]) * D; w[j][k] = tok_w[(t + j) * 4 + k] * ESC; }
        unsigned ev[TB][TOPK][4]; u32x2 xv[TB][4];
#pragma unroll
        for (int j = 0; j < TB; ++j)
#pragma unroll
            for (int i = 0; i < 4; ++i) { const int cc = 4 * lane + 256 * i; xv[j][i] = *(const u32x2*)(x1b + (size_t)(t + j) * D + cc);
#pragma unroll
                for (int k = 0; k < TOPK; ++k) ev[j][k][i] = *(const unsigned*)(rp[j][k] + cc); }
#pragma unroll
        for (int i = 0; i < 4; ++i) { const int cc = 4 * lane + 256 * i; const f32x4 gt = *(const f32x4*)(mod + b * 6144 + 5120 + cc);
#pragma unroll
            for (int j = 0; j < TB; ++j) { f32x4 y = {0.f, 0.f, 0.f, 0.f};
#pragma unroll
                for (int k = 0; k < TOPK; ++k) { const f32x2_t lo = __builtin_amdgcn_cvt_pk_f32_fp8((int)ev[j][k][i], false), hi2 = __builtin_amdgcn_cvt_pk_f32_fp8((int)ev[j][k][i], true);
                    y[0] += w[j][k] * lo[0]; y[1] += w[j][k] * lo[1]; y[2] += w[j][k] * hi2[0]; y[3] += w[j][k] * hi2[1]; }
                const f32x4 x1 = (f32x4){bflo(xv[j][i].x), bfhi(xv[j][i].x), bflo(xv[j][i].y), bfhi(xv[j][i].y)};
                *(f32x4*)(args.out + (size_t)(t + j) * D + cc) = x1 + gt * y; } }
    }
}

enum Phase { PH_PRO = 0, PH_H1 = 1, PH_INPROJ = 2, PH_MIX = 3, PH_MERGE = 4, PH_OUTPROJ = 5, PH_ROUTE = 6, PH_MOE1 = 7, PH_MOE2 = 8, PH_COMB = 9, PH_END = 10 };
constexpr int CW_BAR = 4096;
__global__ void __launch_bounds__(512, 2) mk_fwd(Args args) {
    extern __shared__ __attribute__((aligned(16))) unsigned char lds_raw[];
    LAS unsigned char* lds = (LAS unsigned char*)lds_raw;
    volatile LAS unsigned* MISC = (volatile LAS unsigned*)(lds + LDS_MISC);
    const int tid = threadIdx.x, G = gridDim.x;
    const int vcu = (G % 8 == 0) ? ((int)blockIdx.x % 8) * (G / 8) + (int)blockIdx.x / 8 : (int)blockIdx.x;
    unsigned char* ws = args.ws; unsigned* ctl = (unsigned*)(ws + WS_CTL);
    const float* mod = (const float*)(ws + WS_MOD);
    bf16* hb = (bf16*)(ws + WS_H); bf16* proj = (bf16*)(ws + WS_PROJ); bf16* merged = (bf16*)(ws + WS_MRG);
    bf16* win_t = (bf16*)(ws + WS_WIN); bf16* wout_t = (bf16*)(ws + WS_WOUT); bf16* w1t = (bf16*)(ws + WS_W1); bf16* w2t = (bf16*)(ws + WS_W2);
    bf16* act = (bf16*)(ws + WS_ACT); bf16* eo = (bf16*)(ws + WS_EO); const int* list = (const int*)(ws + WS_LIST);
    for (int u = tid; u < 64; u += 512) MISC[u] = 0u;
    __syncthreads();
    const int lo = args.ph_lo, hi = args.ph_hi;
    XcdBarrier bar = xcd_barrier_post(ctl + CW_BAR, MISC + 8);
#define IN(k) (lo <= (k) && (k) < hi)
#define SEAM(k) do { if (IN(k) && IN((k) + 1)) xcd_barrier(bar); } while (0)
    LAS unsigned* gtab = (LAS unsigned*)(lds + LDS_GTAB); LAS unsigned* rbtab = (LAS unsigned*)(lds + LDS_RB2E); LAS float* gqk = (LAS float*)(lds + LDS_GQK); LAS unsigned* rbfirst = (LAS unsigned*)(lds + LDS_RBF);

    if (IN(PH_PRO)) { phase_prologue(args, ws, lds, vcu, G); __syncthreads(); }
    SEAM(PH_PRO);
    if (IN(PH_H1)) phase_h1(args, ws, vcu, G);
    SEAM(PH_H1);
    if (IN(PH_INPROJ)) {
        if (tid < 64) gqk[tid] = args.in[8][tid] * C2; else if (tid < 128) gqk[tid] = args.in[9][tid - 64];
        __syncthreads();
        EpiIn E{proj, gqk};
        if (IN_GATE_F8) {
            struct MapOrder { pg8::StaticOrder s; int split, add0, add1;
                __device__ bool next(int i, pg8::GUnit& u) const { const bool r = s.next(i, u); u.pn += u.pn < split ? add0 : add1; return r; } };
            MapOrder Sa; Sa.s.init(T / 256, 20, G, (int)blockIdx.x, nullptr, nullptr); Sa.split = 8; Sa.add0 = 0; Sa.add1 = 8;
            pg8::gemm_phase<EpiIn, MapOrder, false, false>(lds + LDS_STAGE, hb, win_t, 0, D, Sa, E, nullptr, gtab, 127 - A_SH, 127 - W_SH);
            MapOrder Sb; Sb.s.init(T / 256, 12, G, (int)blockIdx.x, nullptr, nullptr); Sb.split = 8; Sb.add0 = 8; Sb.add1 = 20;
            pg8::gemm_phase<EpiIn, MapOrder, false, true>(lds + LDS_STAGE, ws + WS_H8, ws + WS_WIN8, 0, D, Sb, E, nullptr, gtab, 127 - A_SH, 127 - W_SH);
        } else {
        pg8::StaticOrder So; So.init(T / 256, INW / 256, G, (int)blockIdx.x, nullptr, nullptr);
        pg8::gemm_phase<EpiIn, pg8::StaticOrder, false, FP8_IN != 0>(lds + LDS_STAGE, hb, win_t, 0, D, So, E, nullptr, gtab, 127 - A_SH, 127 - W_SH);
        }
    }
    SEAM(PH_INPROJ);
    if (IN(PH_MIX)) {
        float a1 = 0.f, a2 = 0.f, gm = 0.f;
        for (int d = 0; d < 64; ++d) { a1 += args.in[10][d] * args.in[11][d]; a2 += args.in[12][d] * args.in[13][d]; gm = fmaxf(gm, fabsf(args.in[8][d] * args.in[9][d])); }
        const float lam = __expf(a1) - __expf(a2) + LAMBDA_INIT;
        bf16* odiff = (bf16*)(ws + WS_ODIFF);
        const float w2 = 2.f * 8.f * gm * LOG2E * 1.03f + 32.f;
        LAS unsigned* cost = (LAS unsigned*)(lds + LDS_RB2E); LAS unsigned* order = cost + 256;
        if (tid >= 256 && tid < 384) ((LAS float*)(lds + att::LDS_GSUB))[tid - 256] = args.in[14][tid - 256];
        if (tid < 256) { const int h = tid >> 5, qb = tid & 31; const float slope2 = __builtin_amdgcn_exp2f(-(float)(h + 1)) * LOG2E;
            const float x = (float)(128 * qb - 63) - w2 / slope2; const int t_lo = x <= 0.f ? 0 : (int)ceilf(x * (1.f / 64.f));
            cost[tid] = (unsigned)(2 * qb + 2 - t_lo) | ((unsigned)t_lo << 16); }
        __syncthreads();
        if (tid < 256) { const unsigned mine = cost[tid] & 0xffffu; int rank = 0;
            for (int k = 0; k < 256; ++k) { const unsigned ck = cost[k] & 0xffffu; rank += (ck > mine || (ck == mine && k < tid)) ? 1 : 0; }
            order[rank] = (unsigned)tid | (cost[tid] & 0xffff0000u); }
        __syncthreads();
        static_assert(MOE_W_IN_QUEUE == 1, "the mixer queue carries the expert-weight items");
        constexpr unsigned NR1 = 1024u, NITEMS = NR1 + 2048u;
#ifndef MIX_REPS
#define MIX_REPS 1
#endif
        for (int rep = 0; rep < MIX_REPS; ++rep) {
        if (rep) xcd_barrier(bar);
        unsigned* qhead = &ctl[CW_Q + 64 * rep];
        unsigned n1 = 0u, n2 = 0u; bool prev_att = false; bf16x8 qn0 = {}, qn1 = {}, qn2 = {}, qn3 = {};
        if (tid == 0) { n1 = atomicAdd(qhead, 1u); n2 = atomicAdd(qhead, 1u); }
        for (;;) {
            if (tid == 0) { MISC[16] = n1; MISC[17] = n2; }
            __syncthreads();
            const unsigned item = MISC[16], nitem = MISC[17];
            if (item >= NITEMS) break;
            if (tid == 0) { n1 = n2; n2 = atomicAdd(qhead, 1u); }
            if (item < NR1) { ret::r1_unit((int)(item >> 7), (int)((item >> 5) & 3u), (int)(item & 31u), proj, (bf16*)(ws + WS_H), lds); prev_att = false; qn0 = (bf16x8){}; qn1 = (bf16x8){}; qn2 = (bf16x8){}; qn3 = (bf16x8){}; }
            else { const unsigned u = item - NR1, c0 = 3u * (u >> 1) + (u & 1u), nc = 1u + (u & 1u);
                if (u < 64u) wout_item(args, ws, (LAS float*)(lds + (tid >> 6) * 12288), (int)(u * 8u + (unsigned)(tid >> 6)), tid & 63);
                for (unsigned k = 0; k < nc; ++k) moe_w_pair(args, ws, (LAS float*)(lds + (tid >> 6) * 12288), (int)((c0 + k) * 8u + (unsigned)(tid >> 6)), tid & 63);
                __syncthreads();
                const unsigned oc = order[u >> 3]; const int cls = (int)(oc & 0xffffu);
                const bool nvalid = nitem >= NR1 && nitem < NITEMS; const unsigned nu = nvalid ? nitem - NR1 : 0u; const int ncls = (int)(order[nu >> 3] & 0xffffu);
                att::unit((int)(u & 7u), cls >> 5, cls & 31, (int)(oc >> 16), proj, odiff, lds, lam, args.in[14], prev_att, nvalid, (int)(nu & 7u), ncls >> 5, ncls & 31, qn0, qn1, qn2, qn3);
                prev_att = nvalid; }
        }
        __syncthreads();
        xcd_barrier(bar);
        phase_scan(ws, vcu, G);
        xcd_barrier(bar);
        if (FUSE_MERGE) {
            for (int u = vcu * 4; u < 1024; u += G * 4)
                for (int k = 0; k < 4; ++k) { const int id = u + k; ret::r3m_unit(id >> 7, (id >> 5) & 3, id & 31, proj, (const bf16*)(ws + WS_MERGED), odiff, (bf16*)(ws + WS_MRG), args.in[6], args.in[7], lds); }
        } else
        for (int u = vcu * 8; u < 2048; u += G * 8)
            for (int k = 0; k < 8; ++k) { const int id = u + k; ret::r3_unit(id >> 8, (id >> 6) & 3, (id >> 1) & 31, id & 1, proj, (const bf16*)(ws + WS_MERGED), (bf16*)(ws + WS_YRET), lds); }
        }
    }
    SEAM(PH_MIX);
    if (!FUSE_MERGE) { if (IN(PH_MERGE)) phase_merge(args, ws, vcu, G);
        SEAM(PH_MERGE); }
    if (IN(PH_OUTPROJ)) {
        pg8::StaticOrder So; So.init(T / 256, D / 256, G, (int)blockIdx.x, nullptr, nullptr);
        EpiOutF E{args.in[0], mod, (bf16*)(ws + WS_X1B)};
        pg8::gemm_phase<EpiOutF, pg8::StaticOrder, false, FP8_OUT != 0>(lds + LDS_STAGE, merged, wout_t, 0, D, So, E, nullptr, gtab, 127 - A_SH, 127 - W_SH);
    }
    SEAM(PH_OUTPROJ);
    if (IN(PH_ROUTE)) { phase_route(args, ws, lds, vcu, G); }
    SEAM(PH_ROUTE);
    if (IN(PH_MOE1)) {
        const int nrb = build_expert_tables(ctl, rbtab, rbfirst);
        pg8::StaticOrder So; So.init(nrb, 2048 / 256, G, (int)blockIdx.x, rbtab, rbfirst);
        LAS float* btab = (LAS float*)(lds + LDS_BTAB);
        EpiActF E{btab, act};
        pg8::gemm_phase<EpiActF, pg8::StaticOrder, true, FP8_MOE != 0, 1>(lds + LDS_STAGE, hb, w1t, (size_t)2048 * D * (FP8_MOE ? 1 : 2), D, So, E, list, gtab, 127 - A_SH, 127 - W_SH, args.in[20], btab);
    }
    SEAM(PH_MOE1);
    if (IN(PH_MOE2)) {
        const int nrb = build_expert_tables(ctl, rbtab, rbfirst);
        pg8::StaticOrder So; So.init(nrb, D / 256, G, (int)blockIdx.x, rbtab, rbfirst);
        LAS float* btab = (LAS float*)(lds + LDS_BTAB);
        EpiEOF E{btab, eo};
        pg8::gemm_phase<EpiEOF, pg8::StaticOrder, false, FP8_MOE != 0, 2, 1>(lds + LDS_STAGE, act, w2t, (size_t)D * FF * (FP8_MOE ? 1 : 2), FF, So, E, nullptr, gtab, 127 - A_SH, 127 - W_SH, args.in[22], btab);
    }
    SEAM(PH_MOE2);
    if (IN(PH_COMB)) { (void)build_expert_tables(ctl, rbtab, rbfirst); phase_combine(args, ws, rbfirst, vcu, G); }
#undef IN
#undef SEAM
}

static int g_grid = 0;
static void launch_phases(Args a, int lo, int hi, hipStream_t stream) {
    a.ph_lo = lo; a.ph_hi = hi;
    hipLaunchKernelGGL(mk_fwd, dim3(g_grid), dim3(512), LDS_BYTES, stream, a);
}
extern "C" void kernel_launch(void* const* d_in, const int* in_sizes, int n_in, void* d_out, int out_size, void* d_ws, size_t ws_size, hipStream_t stream) {
    if (n_in != 23 || ws_size < WS_END) { fprintf(stderr, "kernel_launch: unexpected inputs/workspace (%d, %zu)\n", n_in, ws_size); }
    unsigned char* ws = (unsigned char*)d_ws; float* out = (float*)d_out;

    if (g_grid == 0) {
        int dev = 0, cus = 0;
        if (hipGetDevice(&dev) != hipSuccess || hipDeviceGetAttribute(&cus, hipDeviceAttributeMultiprocessorCount, dev) != hipSuccess) { fprintf(stderr, "kernel_launch: device query failed\n"); g_grid = -1; return; }
        if (hipFuncSetAttribute((const void*)mk_fwd, hipFuncAttributeMaxDynamicSharedMemorySize, LDS_BYTES) != hipSuccess) { fprintf(stderr, "kernel_launch: hipFuncSetAttribute failed\n"); g_grid = -1; return; }
        g_grid = cus;
    }
    if (g_grid < 0) return;
    Args a{};
    for (int i = 0; i < 23; ++i) a.in[i] = (const float*)d_in[i];
    a.out = out; a.ws = ws;
    (void)hipMemsetAsync(ws, 0, 8 * MiB, stream);
    launch_phases(a, 0, PH_END, stream);
}
```

```cpp
#include <hip/hip_runtime.h>
#include <cstdio>
#include <cstdint>

typedef unsigned short bf16;
typedef short bf16x8 __attribute__((ext_vector_type(8)));
typedef float f32x4 __attribute__((ext_vector_type(4)));
typedef float f32x16 __attribute__((ext_vector_type(16)));
typedef unsigned u32x4 __attribute__((ext_vector_type(4)));
typedef unsigned u32x2 __attribute__((ext_vector_type(2)));

constexpr int NB = 8, S = 4096, T = NB * S, D = 1024, INW = 8192;
constexpr int NE = 32, TOPK = 4, FF = 1024;
constexpr size_t PO_RQ = 0, PO_RK = (size_t)T * 512, PO_RV = (size_t)T * 1024, PO_RG = (size_t)T * 2048, PO_DQ = (size_t)T * 3072, PO_DK = (size_t)T * 4096, PO_DV = (size_t)T * 5120, PO_MG = (size_t)T * 6144;
constexpr float EPS = 1e-6f;
constexpr float LOG2E = 1.4426950408889634f;
constexpr float C2 = 0.125f * LOG2E;
constexpr float LAMBDA_INIT = 0.2f;
#ifndef FP8_MOE
#define FP8_MOE 1
#endif
#ifndef FP8_IN
#define FP8_IN 0
#endif
#ifndef FP8_OUT
#define FP8_OUT 0
#endif
constexpr int W_SH = 5, A_SH = 2, E_SH = 3;
constexpr int NRB_MAX = 544;
constexpr int NR_MAX = NRB_MAX * 256;

constexpr size_t MiB = 1u << 20;
constexpr size_t WS_CTL = 0;
constexpr size_t WS_MOD = 1 * MiB;
constexpr size_t WS_WRT = 1 * MiB + 512 * 1024;
constexpr size_t WS_ROUTE = 2 * MiB;
constexpr size_t WS_LIST = 4 * MiB;
constexpr size_t WS_WIN = 8 * MiB;
constexpr size_t WS_WOUT = 24 * MiB;
constexpr size_t WS_W1 = 26 * MiB;
constexpr size_t WS_W2 = 154 * MiB;
constexpr size_t WS_H = 218 * MiB;
constexpr size_t WS_PROJ = 282 * MiB;
constexpr size_t WS_YRET = 794 * MiB;
constexpr size_t WS_ODIFF = 858 * MiB;
constexpr size_t WS_MERGED = 922 * MiB;
constexpr size_t WS_ACT = WS_PROJ;
constexpr size_t WS_EO = WS_PROJ + 272 * MiB;
#define IN_GATE_F8 1
#define MOE_W_IN_QUEUE 1
#define FUSE_MERGE 1
constexpr size_t WS_H8 = 858 * MiB;
constexpr size_t WS_WIN8 = 146 * MiB;
constexpr size_t WS_X1B = FUSE_MERGE ? 858 * MiB : 794 * MiB;
constexpr size_t WS_MRG = FUSE_MERGE ? 794 * MiB : 922 * MiB;
constexpr size_t WS_END = 986 * MiB;
constexpr int CW_CNT = 64;
constexpr int CW_ROWOFF = 128;
constexpr int CW_NRB = 192;
constexpr int CW_Q = 512;
constexpr int CW_CONV = 1152;
constexpr int CW_MOD = 1024;
constexpr int CW_RB2E = 256;

__device__ __forceinline__ float bf2f(bf16 v) { return __builtin_bit_cast(float, (unsigned)v << 16); }
__device__ __forceinline__ float rowsum16(float x) {
    x += __builtin_bit_cast(float, __builtin_amdgcn_update_dpp(0, __builtin_bit_cast(int, x), 0x128, 0xf, 0xf, false));
    x += __builtin_bit_cast(float, __builtin_amdgcn_update_dpp(0, __builtin_bit_cast(int, x), 0x124, 0xf, 0xf, false));
    x += __builtin_bit_cast(float, __builtin_amdgcn_update_dpp(0, __builtin_bit_cast(int, x), 0x122, 0xf, 0xf, false));
    x += __builtin_bit_cast(float, __builtin_amdgcn_update_dpp(0, __builtin_bit_cast(int, x), 0x121, 0xf, 0xf, false));
    return x; }
__device__ __forceinline__ bf16 f2bf(float f) { unsigned u = __builtin_bit_cast(unsigned, f); return (bf16)((u + 0x7fffu + ((u >> 16) & 1u)) >> 16); }
__host__ __device__ __forceinline__ int crow(int r, int hi) { return (r & 3) + 8 * (r >> 2) + 4 * hi; }
__device__ __forceinline__ float sigmoidf_(float x) { return 1.f / (1.f + __expf(-x)); }

__host__ __device__ __forceinline__ int tile_new2old(int t) { return t < 12 ? t : (t < 16 ? t + 12 : (t < 28 ? t - 4 : t)); }
__host__ __device__ __forceinline__ int in_p2l(int p) { const int tp = p >> 8, t = tile_new2old(tp), q = p & 255, bj = q >> 7, wc = (q >> 5) & 3, j = q & 31;
    if (tp >= 8 && tp < 16) return (bj ? 6144 : 2048) + (tp - 8) * 128 + (q & 127);
    return t * 256 + 64 * wc + 32 * bj + j; }
__host__ __device__ __forceinline__ int w1_p2l(int p) { const int t = p >> 8, q = p & 255, bj = q >> 7; return bj * 1024 + t * 128 + (q & 127); }

#define LAS __attribute__((address_space(3)))
#define GAS __attribute__((address_space(1)))
namespace pg8 {
constexpr int BM = 256, BK = 64, HALF = 128, HTB = HALF * BK * 2  , STAGE_BYTES = 8 * HTB, NXCD = 8, WGM = 8;

__host__ __device__ __forceinline__ int lds_byte(int r, int c) { const int st = (r >> 4) * 2 + (c >> 5), rr = r & 15, cc = c & 31, ob = rr * 64 + cc * 2; return st * 1024 + (ob ^ (((ob >> 9) & 1) << 5)); }
__host__ __device__ __forceinline__ void stage_rc(int b, int& R, int& C) { const int st = b / 1024, sb = b % 1024, swz = sb ^ (((sb >> 9) & 1) << 5); R = (st >> 1) * 16 + swz / 64; C = (st & 1) * 32 + (swz % 64) / 2; }
__host__ __device__ __forceinline__ int perm32(int rho) { const int n = rho >> 4, i = rho & 15; return 8 * (i >> 2) + 4 * n + (i & 3); }
struct GUnit { int pm, pn, e, g, s; };

struct StaticOrder {
    int nM, nN, nwg, G, c; const LAS unsigned* rb2e; const LAS unsigned* rbfirst;
    __device__ void init(int nM_, int nN_, int G_, int c_, const LAS unsigned* t, const LAS unsigned* f) { nM = nM_; nN = nN_; nwg = nM * nN; G = G_; c = c_; rb2e = t; rbfirst = f; }
    __device__ bool next(int i, GUnit& u) const {
        const long L = (long)i * G + c; if (L >= nwg) return false;
        int wgid = (int)L; { const int q = nwg / NXCD, r = nwg % NXCD, xcd = wgid % NXCD, off = wgid / NXCD; wgid = (xcd < r ? xcd * (q + 1) : r * (q + 1) + (xcd - r) * q) + off; }
        const int nig = WGM * nN, gid = wgid / nig, fm = gid * WGM, gsz = (nM - fm) < WGM ? (nM - fm) : WGM;
        u.pm = fm + ((wgid % nig) % gsz); u.pn = (wgid % nig) / gsz; u.e = rb2e ? __builtin_amdgcn_readfirstlane((int)rb2e[u.pm]) : 0; u.g = rb2e ? u.e * T + (u.pm - __builtin_amdgcn_readfirstlane((int)rbfirst[u.e])) * 256 : 0; return true;
    }
};

__device__ __forceinline__ unsigned cvt_pk_bf16(float lo, float hi) { unsigned r; asm volatile("v_cvt_pk_bf16_f32 %0, %1, %2" : "=v"(r) : "v"(lo), "v"(hi)); return r; }

template <class Epi, class Sched, bool GATHER, bool FP8 = false, int BIAS = 0, int BP = 0>
__device__ __forceinline__ void gemm_phase(LAS unsigned char* lds, const void* Aglob, const void* Bglob, const size_t bstride, const int K, const Sched& S, const Epi& E,
                                           const int* rowtok, LAS unsigned* gtab, const int sA = 127, const int sB = 127, const float* bias = nullptr, LAS float* btab = nullptr) {
    typedef int v4i_t __attribute__((ext_vector_type(4))); typedef int v8i_t __attribute__((ext_vector_type(8)));
    const int KB = FP8 ? K : 2 * K;
    const int tid = threadIdx.x, wid = __builtin_amdgcn_readfirstlane(tid >> 6), lane = tid & 63, wr = wid >> 2, wc = wid & 3, fr = lane & 15, fq = lane >> 4;
    const int nt = KB / 128;
    unsigned voffA[2], voffB[2];
#pragma unroll
    for (int i = 0; i < 2; ++i) { int R, C; stage_rc(tid * 16 + i * 8192, R, C);
        const int Rb = BP ? 64 * (R >> 5) + 16 * ((R >> 2) & 3) + 4 * ((R >> 4) & 1) + (R & 3) : (R & ~31) + perm32(R & 31);
        voffA[i] = (unsigned)(R * KB + C * 2); voffB[i] = (unsigned)(Rb * KB + C * 2); }
    constexpr unsigned kstep = 128u;
    const unsigned hstep = (unsigned)(HALF * KB);
    const unsigned hstepB = BP ? (unsigned)(8 * KB) : hstep;
    const unsigned tstep = 2u * hstep;
    const unsigned ldsw = (unsigned)wid * 1024u;
    const int aoff = lds_byte(wr * 64 + fr, fq * 8), boff = lds_byte(wc * 32 + fr, fq * 8);
#define PG8_SA(b, h) (((b) * 2 + (h)) * HTB)
#define PG8_SB(b, h) ((4 + (b) * 2 + (h)) * HTB)
#define PG8_STAGE(bufoff, gbase, voff) do { _Pragma("unroll") for (int _i = 0; _i < 2; ++_i) \
        __builtin_amdgcn_global_load_lds((const unsigned*)((const char*)(gbase) + (voff)[_i]), (LAS unsigned*)(lds + (bufoff) + ldsw + _i * 8192), 16, 0, 0); } while (0)
#define PG8_STAGE_A(b, h, kptr, VO) do { if constexpr (GATHER) { PG8_STAGE(PG8_SA(b, h), kptr, VO[h]); } else { PG8_STAGE(PG8_SA(b, h), (kptr) + (h) * hstep, voffA); } } while (0)
#define PG8_STAGE_A2(b, h, kptr) do { if constexpr (GATHER) { _Pragma("unroll") for (int _i = 0; _i < 2; ++_i) \
        __builtin_amdgcn_global_load_lds((const unsigned*)((const char*)(kptr) + (usen ? vN[h][_i] : vC[h][_i])), (LAS unsigned*)(lds + PG8_SA(b, h) + ldsw + _i * 8192), 16, 0, 0); } \
        else { PG8_STAGE(PG8_SA(b, h), (kptr) + (h) * hstep, voffA); } } while (0)
#define PG8_LD8(p_) __builtin_shufflevector(*(const LAS v4i_t*)(p_), *(const LAS v4i_t*)((p_) + 1024), 0, 1, 2, 3, 4, 5, 6, 7)
#define PG8_LDA(dst, b, h) do { if constexpr (FP8) { _Pragma("unroll") for (int m = 0; m < 4; ++m) dst##8[m] = PG8_LD8(lds + PG8_SA(b, h) + aoff + m * 2048); } \
        else { _Pragma("unroll") for (int m = 0; m < 4; ++m) _Pragma("unroll") for (int k = 0; k < 2; ++k) dst[m][k] = *(const LAS bf16x8*)(lds + PG8_SA(b, h) + aoff + m * 2048 + k * 1024); } } while (0)
#define PG8_LDB(dst, b, h) do { if constexpr (FP8) { _Pragma("unroll") for (int n = 0; n < 2; ++n) dst##8[n] = PG8_LD8(lds + PG8_SB(b, h) + boff + n * 2048); } \
        else { _Pragma("unroll") for (int n = 0; n < 2; ++n) _Pragma("unroll") for (int k = 0; k < 2; ++k) dst[n][k] = *(const LAS bf16x8*)(lds + PG8_SB(b, h) + boff + n * 2048 + k * 1024); } } while (0)
#define PG8_MMA(ai, bj, At, Bt) do { __builtin_amdgcn_s_setprio(1); \
        if constexpr (FP8) { _Pragma("unroll") for (int m = 0; m < 4; ++m) _Pragma("unroll") for (int n = 0; n < 2; ++n)   \
            asm volatile("v_mfma_scale_f32_16x16x128_f8f6f4 %0, %1, %2, %0, %3, %4 op_sel_hi:[0,0,0]" : "+v"(acc[ai][bj][m][n]) : "v"(Bt##8[n]), "v"(At##8[m]), "v"(sB), "v"(sA)); } \
        else { _Pragma("unroll") for (int m = 0; m < 4; ++m) _Pragma("unroll") for (int n = 0; n < 2; ++n) _Pragma("unroll") for (int k = 0; k < 2; ++k) \
            asm volatile("v_mfma_f32_16x16x32_bf16 %0, %1, %2, %0" : "+v"(acc[ai][bj][m][n]) : "v"(Bt[n][k]), "v"(At[m][k])); } \
        __builtin_amdgcn_s_setprio(0); } while (0)
#define PG8_MMA0(ai, bj, At, Bt) do { __builtin_amdgcn_s_setprio(1); \
        if constexpr (FP8) { _Pragma("unroll") for (int m = 0; m < 4; ++m) _Pragma("unroll") for (int n = 0; n < 2; ++n) \
            asm volatile("v_mfma_scale_f32_16x16x128_f8f6f4 %0, %1, %2, 0, %3, %4 op_sel_hi:[0,0,0]" : "=&v"(acc[ai][bj][m][n]) : "v"(Bt##8[n]), "v"(At##8[m]), "v"(sB), "v"(sA)); } \
        else { _Pragma("unroll") for (int m = 0; m < 4; ++m) _Pragma("unroll") for (int n = 0; n < 2; ++n) { \
            asm volatile("v_mfma_f32_16x16x32_bf16 %0, %1, %2, 0" : "=&v"(acc[ai][bj][m][n]) : "v"(Bt[n][0]), "v"(At[m][0])); \
            asm volatile("v_mfma_f32_16x16x32_bf16 %0, %1, %2, %0" : "+v"(acc[ai][bj][m][n]) : "v"(Bt[n][1]), "v"(At[m][1])); } } \
        __builtin_amdgcn_s_setprio(0); } while (0)
#define PG8_WAIT_V(n) asm volatile("s_waitcnt vmcnt(" #n ")" ::: "memory")
#define PG8_WAIT_L(n) asm volatile("s_waitcnt lgkmcnt(" #n ")" ::: "memory")
#define PG8_BAR __builtin_amdgcn_s_barrier()
#define PG8_SCHED __builtin_amdgcn_sched_barrier(0)
#define PG8_GTAB_DMA(g_, slot_) do { if (wid < 4) __builtin_amdgcn_global_load_lds((const unsigned*)(rowtok + (size_t)(g_) + tid), (LAS unsigned*)(gtab + (slot_) * 256 + wid * 64), 4, 0, 0); } while (0)
#define PG8_GOFF(dst, slot_) do { _Pragma("unroll") for (int _i = 0; _i < 2; ++_i) { int _R, _C; stage_rc(tid * 16 + _i * 8192, _R, _C); \
        _Pragma("unroll") for (int _h = 0; _h < 2; ++_h) dst[_h][_i] = min(gtab[(slot_) * 256 + _h * 128 + _R], (unsigned)(T - 1)) * (unsigned)KB + (unsigned)(_C * 2); } } while (0)
#define PG8_BTAB_DMA(u_, slot_) do { if constexpr (BIAS != 0) { if (wid >= 4) { const int _i = tid - 256; \
        const float* _src = BIAS == 1 ? bias + (size_t)(u_).e * 2048 + (_i < 128 ? 128 * (u_).pn + _i : 1024 + 128 * (u_).pn + (_i - 128)) : bias + (size_t)(u_).e * 1024 + 256 * (u_).pn + _i; \
        __builtin_amdgcn_global_load_lds((const unsigned*)_src, (LAS unsigned*)(btab + (slot_) * 256 + (wid - 4) * 64), 4, 0, 0); } } } while (0)
    GUnit cur, nxt; int ui = 0;
    if (!S.next(0, cur)) return;
    cur.s = 0; PG8_BTAB_DMA(cur, 0);
    f32x4 acc[2][2][4][2];
    bf16x8 At[4][2], B0[2][2], B1[2][2]; v8i_t At8[4], B08[2], B18[2];
    unsigned vC[2][2], vN[2][2];
    if constexpr (GATHER) { PG8_GTAB_DMA(cur.g, 0); PG8_WAIT_V(0); PG8_BAR; PG8_GOFF(vC, 0); PG8_WAIT_L(0);
#pragma unroll
        for (int h = 0; h < 2; ++h)
#pragma unroll
            for (int i = 0; i < 2; ++i) vN[h][i] = vC[h][i]; }
    const char* cA = GATHER ? (const char*)Aglob : (const char*)Aglob + (size_t)cur.pm * tstep;
    const char* cB = (const char*)Bglob + (size_t)cur.e * bstride + (size_t)cur.pn * tstep;
    PG8_STAGE(PG8_SB(0, 0), cB, voffB); PG8_STAGE(PG8_SB(0, 1), cB + hstepB, voffB); PG8_STAGE_A(0, 0, cA, vC); PG8_STAGE_A(0, 1, cA, vC);
    if (wr == 1) PG8_BAR;
    PG8_WAIT_V(2); PG8_BAR;
    PG8_STAGE(PG8_SB(1, 0), cB + kstep, voffB); PG8_STAGE_A(1, 0, cA + kstep, vC); PG8_STAGE(PG8_SB(1, 1), cB + hstepB + kstep, voffB);
    PG8_WAIT_V(6); PG8_BAR;
    int sprev = 0;
    for (;;) {
        const bool has_next = S.next(ui + 1, nxt);
        if constexpr (GATHER) { if (has_next) PG8_GTAB_DMA(nxt.g, (ui + 1) & 1); }
        const char* nA = has_next ? (GATHER ? (const char*)Aglob : (const char*)Aglob + (size_t)nxt.pm * tstep) : cA;
        const char* nB = has_next ? (const char*)Bglob + (size_t)nxt.e * bstride + (size_t)nxt.pn * tstep : cB;
#define PG8_STEP(t, WV1, WV2, LASTOK, MM) do { \
            const bool last = (LASTOK) && ((t) == nt - 2); \
            const char* a1 = cA + (size_t)((t) + 1) * kstep; \
            const char* a2 = last ? nA : cA + (size_t)((t) + 2) * kstep; const char* b2 = last ? nB : cB + (size_t)((t) + 2) * kstep; \
            const char* a3 = a2 + kstep; const char* b3 = b2 + kstep; \
            if constexpr (GATHER) { if (last && has_next) { PG8_GOFF(vN, (ui + 1) & 1); } } \
            const bool usen = last && has_next; \
              \
            PG8_LDB(B0, 0, 0); PG8_LDB(B1, 0, 1); PG8_SCHED; PG8_LDA(At, 0, 0); PG8_STAGE_A(1, 1, a1, vC); \
            WV1; PG8_WAIT_L(0); PG8_BAR; MM(0, 0, At, B0); MM(0, 1, At, B1); PG8_BAR; PG8_SCHED; \
              \
            PG8_LDA(At, 0, 1); PG8_STAGE(PG8_SB(0, 0), b2, voffB); PG8_STAGE(PG8_SB(0, 1), b2 + hstepB, voffB); PG8_STAGE_A2(0, 0, a2); \
            WV2; PG8_WAIT_L(0); PG8_BAR; MM(1, 0, At, B0); MM(1, 1, At, B1); PG8_BAR; PG8_SCHED; \
              \
            PG8_LDB(B0, 1, 0); PG8_LDB(B1, 1, 1); PG8_SCHED; PG8_LDA(At, 1, 0); PG8_STAGE_A2(0, 1, a2); \
            PG8_WAIT_V(8); PG8_WAIT_L(0); PG8_BAR; PG8_MMA(0, 0, At, B0); PG8_MMA(0, 1, At, B1); PG8_BAR; PG8_SCHED; \
              \
            PG8_LDA(At, 1, 1); PG8_STAGE(PG8_SB(1, 0), b3, voffB); PG8_STAGE(PG8_SB(1, 1), b3 + hstepB, voffB); PG8_STAGE_A2(1, 0, a3); \
            PG8_WAIT_V(8); PG8_WAIT_L(0); PG8_BAR; PG8_MMA(1, 0, At, B0); PG8_MMA(1, 1, At, B1); PG8_BAR; PG8_SCHED; } while (0)
#define PG8_WAIT_VR() do { if (sprev >= 16) PG8_WAIT_V(24); else if (sprev >= 8) PG8_WAIT_V(16); else PG8_WAIT_V(8); } while (0)
        if constexpr (FP8) {
            PG8_STEP(0, PG8_WAIT_VR(), PG8_WAIT_VR(), false, PG8_MMA0);
            for (int t = 2; t < nt; t += 2) PG8_STEP(t, PG8_WAIT_V(8), PG8_WAIT_V(8), true, PG8_MMA);
        } else {
#define PG8_WAIT_VR2() do { if (sprev >= 8) PG8_WAIT_V(16); else PG8_WAIT_V(8); } while (0)
            PG8_STEP(0, PG8_WAIT_VR(), PG8_WAIT_VR(), false, PG8_MMA0);
            for (int t = 2; t < nt; t += 2) PG8_STEP(t, PG8_WAIT_V(8), PG8_WAIT_V(8), true, PG8_MMA);
        }
        if (wr == 0) PG8_BAR;
        asm volatile("s_nop 15\n\ts_nop 15\n\ts_nop 7" ::: "memory");
        E(acc, cur, wr, wc, fr, fq);
        sprev = Epi::nstores(cur);
        if (!has_next) break;
        cur = nxt; cA = nA; cB = nB; ++ui; cur.s = ui & 1;
        if constexpr (GATHER) {
#pragma unroll
            for (int h = 0; h < 2; ++h)
#pragma unroll
                for (int i = 0; i < 2; ++i) vC[h][i] = vN[h][i]; }
        if (wr == 1) PG8_BAR;
        PG8_BTAB_DMA(cur, ui & 1);
    }
    PG8_WAIT_V(0);
    PG8_BAR;
#undef PG8_SA
#undef PG8_SB
#undef PG8_STAGE
#undef PG8_STAGE_A
#undef PG8_STAGE_A2
#undef PG8_LDA
#undef PG8_LDB
#undef PG8_MMA
#undef PG8_MMA0
#undef PG8_LD8
#undef PG8_WAIT_V
#undef PG8_WAIT_VR
#undef PG8_STEP
#undef PG8_WAIT_L
#undef PG8_BAR
#undef PG8_SCHED
#undef PG8_GTAB_DMA
#undef PG8_BTAB_DMA
#undef PG8_GOFF
}
}

#define XB_TMO      128
#define XB_XCNT(j)  (256  + 64 * (j))
#define XB_XSUB(j)  (1280 + 64 * (j))
#define XB_XGEN(j)  (2304 + 64 * (j))
#define XB_TOP      3328
#define XB_TOPGEN   3392
#define XCD_BAR_WORDS 3456
#define XB_SPIN_CAP (1u << 24)

__device__ __forceinline__ unsigned xb_ld(unsigned* p)              { return __hip_atomic_load(p, __ATOMIC_RELAXED, __HIP_MEMORY_SCOPE_AGENT); }
__device__ __forceinline__ unsigned xb_add(unsigned* p, unsigned v) { return __hip_atomic_fetch_add(p, v, __ATOMIC_RELAXED, __HIP_MEMORY_SCOPE_AGENT); }
__device__ __forceinline__ unsigned xb_xcc_id() { return (unsigned)__builtin_amdgcn_s_getreg((3 << 11) | 20) & 0xFu; }
#define XB_SPIN(cond, bar) do { unsigned _sp = 0; while (cond) { __builtin_amdgcn_s_sleep(1); \
    if ((++_sp & 255u) == 0u) { if (xb_ld(&(bar)[XB_TMO])) break; if (_sp > XB_SPIN_CAP) { atomicAdd(&(bar)[XB_TMO], 1u); break; } } } } while (0)

struct XcdBarrier {
    unsigned* bar; unsigned x;
    volatile LAS unsigned* st;
};

__device__ __forceinline__ XcdBarrier xcd_barrier_post(unsigned* bar, volatile LAS unsigned* st) {
    XcdBarrier b; b.bar = bar; b.x = xb_xcc_id(); b.st = st;
    if (threadIdx.x == 0) (void)xb_add(&bar[XB_XCNT(b.x)], 1u);
    return b;
}
__device__ __forceinline__ void xcd_barrier_complete(unsigned* bar, unsigned x, unsigned& nloc, unsigned& nx) {
    const unsigned G = gridDim.x * gridDim.y * gridDim.z;
    unsigned sum, cnt, mine, sp = 0u;
    for (;;) {
        sum = 0u; cnt = 0u; mine = 0u;
#pragma unroll
        for (unsigned j = 0; j < 16; ++j) { const unsigned c = xb_ld(&bar[XB_XCNT(j)]); sum += c; cnt += (c > 0u) ? 1u : 0u; mine = (j == x) ? c : mine; }
        if (sum == G) break;
        __builtin_amdgcn_s_sleep(1);
        if ((++sp & 255u) == 0u) { if (xb_ld(&bar[XB_TMO])) break; if (sp > XB_SPIN_CAP) { atomicAdd(&bar[XB_TMO], 1u); break; } }
    }
    nloc = mine > 0u ? mine : 1u; nx = cnt > 0u ? cnt : 1u;
}

__device__ __forceinline__ void xcd_barrier(const XcdBarrier& b) {
    asm volatile("s_waitcnt vmcnt(0)" ::: "memory");
    __syncthreads();
    if (threadIdx.x == 0) {
        unsigned* bar = b.bar;
        __builtin_amdgcn_s_waitcnt(0);
        unsigned nloc = b.st[0], nx = b.st[1];
        if (nloc == 0u) { xcd_barrier_complete(bar, b.x, nloc, nx); b.st[0] = nloc; b.st[1] = nx; }
        const unsigned old = xb_add(&bar[XB_XSUB(b.x)], 1u);
        const unsigned gen = old / nloc;
        if (old + 1u == (gen + 1u) * nloc) {
            __builtin_amdgcn_fence(__ATOMIC_RELEASE, "agent");
            asm volatile("s_waitcnt vmcnt(0)" ::: "memory");
            const unsigned og = xb_add(&bar[XB_TOP], 1u);
            const unsigned tg = og / nx;
            if (og + 1u == (tg + 1u) * nx) xb_add(&bar[XB_TOPGEN], 1u);
            else XB_SPIN(xb_ld(&bar[XB_TOPGEN]) == tg, bar);
            __builtin_amdgcn_fence(__ATOMIC_ACQUIRE, "agent");
            xb_add(&bar[XB_XGEN(b.x)], 1u);
            asm volatile("s_waitcnt vmcnt(0)" ::: "memory");
        } else {
            XB_SPIN(xb_ld(&bar[XB_XGEN(b.x)]) == gen, bar);
            __builtin_amdgcn_fence(__ATOMIC_ACQUIRE, "agent");
            asm volatile("s_waitcnt vmcnt(0)" ::: "memory");
        }
    }
    __syncthreads();
}

template <class F>
__device__ __forceinline__ void xcd_barrier_work(const XcdBarrier& b, F work) {
    asm volatile("s_waitcnt vmcnt(0)" ::: "memory");
    __syncthreads();
    if (threadIdx.x == 0) {
        unsigned* bar = b.bar;
        __builtin_amdgcn_s_waitcnt(0);
        unsigned nloc = b.st[0], nx = b.st[1];
        if (nloc == 0u) { xcd_barrier_complete(bar, b.x, nloc, nx); b.st[0] = nloc; b.st[1] = nx; }
        const unsigned old = xb_add(&bar[XB_XSUB(b.x)], 1u);
        const unsigned gen = old / nloc;
        if (old + 1u == (gen + 1u) * nloc) {
            __builtin_amdgcn_fence(__ATOMIC_RELEASE, "agent");
            asm volatile("s_waitcnt vmcnt(0)" ::: "memory");
            const unsigned og = xb_add(&bar[XB_TOP], 1u);
            const unsigned tg = og / nx;
            if (og + 1u == (tg + 1u) * nx) xb_add(&bar[XB_TOPGEN], 1u);
            else XB_SPIN(xb_ld(&bar[XB_TOPGEN]) == tg, bar);
            __builtin_amdgcn_fence(__ATOMIC_ACQUIRE, "agent");
            xb_add(&bar[XB_XGEN(b.x)], 1u);
            asm volatile("s_waitcnt vmcnt(0)" ::: "memory");
            b.st[4] = 1u;
        } else { b.st[4] = 0u; b.st[5] = gen; }
    }
    __syncthreads();
    if (b.st[4] == 0u) {
        bool more = true;
        for (;;) {
            if (threadIdx.x == 0) { unsigned* bar = b.bar; const unsigned gen = b.st[5]; unsigned rel = xb_ld(&bar[XB_XGEN(b.x)]) != gen ? 1u : 0u;
                if (!rel && !more) { XB_SPIN(xb_ld(&bar[XB_XGEN(b.x)]) == gen, bar); rel = 1u; }
                b.st[4] = rel; }
            __syncthreads();
            if (b.st[4]) break;
            more = work();
        }
        if (threadIdx.x == 0) { __builtin_amdgcn_fence(__ATOMIC_ACQUIRE, "agent"); asm volatile("s_waitcnt vmcnt(0)" ::: "memory"); }
    }
    __syncthreads();
}

__device__ __forceinline__ float fast_sigmoid(float x) { return __builtin_amdgcn_rcpf(1.f + __builtin_amdgcn_exp2f(-LOG2E * x)); }
__device__ __forceinline__ u32x4 pack8(const f32x4 a, const f32x4 b) { u32x4 w; w.x = pg8::cvt_pk_bf16(a[0], a[1]); w.y = pg8::cvt_pk_bf16(a[2], a[3]); w.z = pg8::cvt_pk_bf16(b[0], b[1]); w.w = pg8::cvt_pk_bf16(b[2], b[3]); return w; }

__device__ __forceinline__ unsigned pk4_fp8(float a, float b, float c, float d, float sc) {
    a = __builtin_amdgcn_fmed3f(a * sc, -448.f, 448.f); b = __builtin_amdgcn_fmed3f(b * sc, -448.f, 448.f); c = __builtin_amdgcn_fmed3f(c * sc, -448.f, 448.f); d = __builtin_amdgcn_fmed3f(d * sc, -448.f, 448.f);
    int v = __builtin_amdgcn_cvt_pk_fp8_f32(a, b, 0, false); v = __builtin_amdgcn_cvt_pk_fp8_f32(c, d, v, true); return (unsigned)v; }
__device__ __forceinline__ unsigned pk4_fp8_nc(float a, float b, float c, float d) {
    int v = __builtin_amdgcn_cvt_pk_fp8_f32(a, b, 0, false); v = __builtin_amdgcn_cvt_pk_fp8_f32(c, d, v, true); return (unsigned)v; }
struct EpiIn {
    bf16* proj; const LAS float* gqk;
    static __device__ __forceinline__ int nstores(const pg8::GUnit& u) { return (u.pn >= 8 && u.pn < 16) ? 8 : 16; }
    __device__ __forceinline__ void operator()(const f32x4 (&acc)[2][2][4][2], const pg8::GUnit& u, int wr, int wc, int fr, int fq) const {
        const int pn = tile_new2old(u.pn); const int bb = u.pm >> 4, s0 = (u.pm & 15) * 256 + wr * 64 + fr; const size_t t0 = (size_t)u.pm * 256 + wr * 64 + fr;
        bf16* base; size_t INWp;
        if (u.pn >= 8 && u.pn < 16) {
            bf16* gb = proj + PO_RG + t0 * 1024 + (u.pn - 8) * 128 + wc * 32 + fq * 8;
#pragma unroll
            for (int ai = 0; ai < 2; ++ai)
#pragma unroll
                for (int m = 0; m < 4; ++m) { f32x4 v[2];
#pragma unroll
                    for (int n = 0; n < 2; ++n) {
                        const f32x4 x = acc[ai][0][m][n], a = x * (-LOG2E), b = acc[ai][1][m][n] * (-LOG2E); f32x4 ex, ey, r;
#pragma unroll
                        for (int e = 0; e < 4; ++e) { ex[e] = __builtin_amdgcn_exp2f(a[e]); ey[e] = __builtin_amdgcn_exp2f(b[e]); }
                        const f32x4 d = (ex + 1.f) * (ey + 1.f);
#pragma unroll
                        for (int e = 0; e < 4; ++e) r[e] = __builtin_amdgcn_rcpf(d[e]);
                        v[n] = x * r; }
                    *(u32x4*)(gb + (size_t)(ai * 128 + m * 16) * 1024) = pack8(v[0], v[1]); }
            return;
        }
        if (pn < 4)       { const int h = 2 * (pn & 1) + (wc >> 1); base = proj + (pn < 2 ? PO_RQ : PO_RK) + ((size_t)(bb * 4 + h) * S + s0) * 128 + (wc & 1) * 64 + fq * 8; INWp = 128; }
        else if (pn < 8)  { base = proj + PO_RV + ((size_t)(bb * 4 + (pn - 4)) * S + s0) * 256 + wc * 64 + fq * 8; INWp = 256; }
        else if (pn < 12) { base = proj + PO_RG + t0 * 1024 + (pn - 8) * 256 + wc * 64 + fq * 8; INWp = 1024; }
        else if (pn < 24) { const int rg3 = (pn - 12) >> 2, h = 2 * ((pn - 12) & 3) + (wc >> 1); base = proj + (rg3 == 0 ? PO_DQ : (rg3 == 1 ? PO_DK : PO_DV)) + ((size_t)(bb * 8 + h) * S + s0) * 128 + (wc & 1) * 64 + fq * 8; INWp = 128; }
        else              { base = proj + PO_MG + (pn >= 28 ? (size_t)T * 1024 : 0) + t0 * 1024 + ((pn - 24) & 3) * 256 + wc * 64 + fq * 8; INWp = 1024; }
        if (pn < 8 || (pn >= 20 && pn < 24)) {
            float f[4];
#pragma unroll
            for (int m = 0; m < 4; ++m) f[m] = 1.f;
            if (pn < 4) { const int h = 2 * (pn & 1) + (wc >> 1); const float lg = __builtin_amdgcn_logf(1.f - __builtin_amdgcn_exp2f(-5.f - (float)h));
#pragma unroll
                for (int m = 0; m < 4; ++m) { const float pos = (float)(wr * 64 + m * 16 + fr); f[m] = pn < 2 ? __builtin_amdgcn_exp2f(lg * pos) : 0.08838834764831845f * __builtin_amdgcn_exp2f(-lg * pos); } }
#pragma unroll
            for (int ai = 0; ai < 2; ++ai)
#pragma unroll
                for (int m = 0; m < 4; ++m)
#pragma unroll
                    for (int bj = 0; bj < 2; ++bj) *(u32x4*)(base + (size_t)(ai * 128 + m * 16) * INWp + bj * 32) = pack8(acc[ai][bj][m][0] * f[m], acc[ai][bj][m][1] * f[m]);
        } else if (pn < 12 || pn >= 24) {
            const bool silu = pn < 12;
#pragma unroll
            for (int ai = 0; ai < 2; ++ai)
#pragma unroll
                for (int m = 0; m < 4; ++m)
#pragma unroll
                    for (int bj = 0; bj < 2; ++bj) { f32x4 v[2];
#pragma unroll
                        for (int n = 0; n < 2; ++n)
#pragma unroll
                            for (int e = 0; e < 4; ++e) { const float x = acc[ai][bj][m][n][e], s = fast_sigmoid(x); v[n][e] = silu ? x * s : s; }
                        *(u32x4*)(base + (size_t)(ai * 128 + m * 16) * INWp + bj * 32) = pack8(v[0], v[1]); }
        } else {
            const LAS float* g = gqk + (pn < 16 ? 0 : 64) + fq * 8;
            f32x4 gv[2][2];
#pragma unroll
            for (int bj = 0; bj < 2; ++bj)
#pragma unroll
                for (int n = 0; n < 2; ++n) gv[bj][n] = *(const LAS f32x4*)(g + bj * 32 + n * 4);
#pragma unroll
            for (int ai = 0; ai < 2; ++ai)
#pragma unroll
                for (int m = 0; m < 4; ++m) { float ss = 0.f;
#pragma unroll
                    for (int bj = 0; bj < 2; ++bj)
#pragma unroll
                        for (int n = 0; n < 2; ++n) { const f32x4 x = acc[ai][bj][m][n]; ss += (x[0] * x[0] + x[1] * x[1]) + (x[2] * x[2] + x[3] * x[3]); }
                    ss += __shfl_xor(ss, 16); ss += __shfl_xor(ss, 32);
                    const float r = __builtin_amdgcn_rsqf(ss * (1.f / 64) + EPS);
#pragma unroll
                    for (int bj = 0; bj < 2; ++bj) *(u32x4*)(base + (size_t)(ai * 128 + m * 16) * INWp + bj * 32) = pack8(acc[ai][bj][m][0] * gv[bj][0] * r, acc[ai][bj][m][1] * gv[bj][1] * r); }
        }
    }
};
struct EpiOutF {
    const float* x; const float* mod; bf16* x1b;
    static __device__ __forceinline__ int nstores(const pg8::GUnit&) { return 16; }
    __device__ __forceinline__ void operator()(const f32x4 (&acc)[2][2][4][2], const pg8::GUnit& u, int wr, int wc, int fr, int fq) const {
        const int row0 = u.pm * 256 + wr * 64 + fr, col0 = u.pn * 256 + wc * 32 + fq * 8, b = (u.pm * 256) / S;
        f32x4 gt[2][2];
#pragma unroll
        for (int bj = 0; bj < 2; ++bj)
#pragma unroll
            for (int n = 0; n < 2; ++n) gt[bj][n] = *(const f32x4*)(mod + b * 6144 + 2048 + col0 + bj * 128 + n * 4);
#pragma unroll
        for (int ai = 0; ai < 2; ++ai)
#pragma unroll
            for (int m = 0; m < 4; ++m) { const size_t ro = (size_t)(row0 + ai * 128 + m * 16) * D + col0;
#pragma unroll
                for (int bj = 0; bj < 2; ++bj) { const f32x4 x0 = __builtin_nontemporal_load((const f32x4*)(x + ro + bj * 128)), x1 = __builtin_nontemporal_load((const f32x4*)(x + ro + bj * 128 + 4));
                    *(u32x4*)(x1b + ro + bj * 128) = pack8(x0 + gt[bj][0] * acc[ai][bj][m][0], x1 + gt[bj][1] * acc[ai][bj][m][1]); } }
    }
};
struct EpiActF {
    static __device__ __forceinline__ int nstores(const pg8::GUnit&) { return 8; }
    const LAS float* btab; bf16* act;
    __device__ __forceinline__ void operator()(const f32x4 (&acc)[2][2][4][2], const pg8::GUnit& u, int wr, int wc, int fr, int fq) const {
        const int row0 = u.pm * 256 + wr * 64 + fr, c0 = u.pn * 128 + wc * 32 + fq * 8;
        const LAS float* bt = btab + u.s * 256 + wc * 32 + fq * 8;
        constexpr float ASC = (float)(1 << A_SH);
        f32x4 bg[2], bu[2];
#pragma unroll
        for (int n = 0; n < 2; ++n) { bg[n] = *(const LAS f32x4*)(bt + n * 4); bu[n] = (*(const LAS f32x4*)(bt + 128 + n * 4) + 1.f) * ASC; }
#pragma unroll
        for (int ai = 0; ai < 2; ++ai)
#pragma unroll
            for (int m = 0; m < 4; ++m) { f32x4 v[2];
#pragma unroll
                for (int n = 0; n < 2; ++n) {
                    f32x4 g = acc[ai][0][m][n] + bg[n], up = acc[ai][1][m][n] * ASC + bu[n], ex, rc;
#pragma unroll
                    for (int e = 0; e < 4; ++e) { g[e] = fminf(g[e], 7.f); up[e] = __builtin_amdgcn_fmed3f(up[e], -6.f * ASC, 8.f * ASC); }
                    const f32x4 a = g * (-1.702f * LOG2E);
#pragma unroll
                    for (int e = 0; e < 4; ++e) ex[e] = __builtin_amdgcn_exp2f(a[e]);
                    const f32x4 d = ex + 1.f;
#pragma unroll
                    for (int e = 0; e < 4; ++e) rc[e] = __builtin_amdgcn_rcpf(d[e]);
                    v[n] = (g * up) * rc; }
                if (FP8_MOE) { u32x2 o; o.x = pk4_fp8_nc(v[0][0], v[0][1], v[0][2], v[0][3]); o.y = pk4_fp8_nc(v[1][0], v[1][1], v[1][2], v[1][3]);
                    *(u32x2*)((unsigned char*)act + (size_t)(row0 + ai * 128 + m * 16) * FF + c0) = o; }
                else *(u32x4*)(act + (size_t)(row0 + ai * 128 + m * 16) * FF + c0) = pack8(v[0] * (1.f / ASC), v[1] * (1.f / ASC)); }
    }
};
struct EpiEOF {
    static __device__ __forceinline__ int nstores(const pg8::GUnit&) { return 8; }
    const LAS float* btab; bf16* eo;
    __device__ __forceinline__ void operator()(const f32x4 (&acc)[2][2][4][2], const pg8::GUnit& u, int wr, int wc, int fr, int fq) const {
        const int row0 = u.pm * 256 + wr * 64 + fr, col0 = u.pn * 256 + wc * 64 + fq * 16;
        const LAS float* bt = btab + u.s * 256 + wc * 64 + fq * 16;
        constexpr float ESC = (float)(1 << E_SH);
        f32x4 bv[2][2];
#pragma unroll
        for (int bj = 0; bj < 2; ++bj)
#pragma unroll
            for (int n = 0; n < 2; ++n) bv[bj][n] = *(const LAS f32x4*)(bt + bj * 8 + n * 4) * ESC;
#pragma unroll
        for (int ai = 0; ai < 2; ++ai)
#pragma unroll
            for (int m = 0; m < 4; ++m) { u32x4 o; f32x4 v;
                v = acc[ai][0][m][0] * ESC + bv[0][0]; o.x = pk4_fp8(v[0], v[1], v[2], v[3], 1.f);
                v = acc[ai][0][m][1] * ESC + bv[0][1]; o.y = pk4_fp8(v[0], v[1], v[2], v[3], 1.f);
                v = acc[ai][1][m][0] * ESC + bv[1][0]; o.z = pk4_fp8(v[0], v[1], v[2], v[3], 1.f);
                v = acc[ai][1][m][1] * ESC + bv[1][1]; o.w = pk4_fp8(v[0], v[1], v[2], v[3], 1.f);
                *(u32x4*)((unsigned char*)eo + (size_t)(row0 + ai * 128 + m * 16) * D + col0) = o; }
    }
};

constexpr int LDS_STAGE = 0, LDS_STAGE_BYTES = 131072;
constexpr int LDS_GTAB = 131072;
constexpr int LDS_RB2E = LDS_GTAB + 2048;
constexpr int LDS_GQK = LDS_RB2E + 2176;
constexpr int LDS_RBF = LDS_GQK + 512;
constexpr int LDS_MISC = LDS_RBF + 256;
constexpr int LDS_BTAB = LDS_MISC + 256;
constexpr int LDS_BYTES = 147456;
static_assert(LDS_BTAB + 2048 <= LDS_BYTES, "LDS map");

namespace att {
constexpr int SLOT = 32768, KOFF = 0, VOFF = 16384, NSLOT = 4;
constexpr int LDS_WS = LDS_GTAB;
constexpr int LDS_X = 0;
constexpr int LDS_Y = 65536;
constexpr int LDS_XS = LDS_BTAB;
constexpr int LDS_GSUB = LDS_GQK;
constexpr float THR = 8.f;
typedef short v4i16 __attribute__((ext_vector_type(4)));
template <int OFF> __device__ __forceinline__ bf16x8 rd128(unsigned a) { bf16x8 v; asm volatile("ds_read_b128 %0, %1 offset:%2" : "=v"(v) : "v"(a), "n"(OFF)); return v; }
template <int OFF> __device__ __forceinline__ v4i16 rdtr(unsigned a) { v4i16 v; asm volatile("ds_read_b64_tr_b16 %0, %1 offset:%2" : "=v"(v) : "v"(a), "n"(OFF)); return v; }
__device__ __forceinline__ float max3(float a, float b, float c) { float r; asm("v_max3_f32 %0, %1, %2, %3" : "=v"(r) : "v"(a), "v"(b), "v"(c)); return r; }
#define ATT_WAITV(n) asm volatile("s_waitcnt vmcnt(" #n ")" ::: "memory")
#define ATT_BAR() asm volatile("s_waitcnt lgkmcnt(0)\n\ts_barrier" ::: "memory")
#define ATT_WAIT_TILE(k_, last_) do { const int _y = ((last_) < NTu - 1 ? (last_) : NTu - 1) - (k_); if (_y >= 2) ATT_WAITV(8); else if (_y == 1) ATT_WAITV(4); else ATT_WAITV(0); } while (0)
__device__ __forceinline__ void unit(const int b, const int h, const int qb, const int t_lo, const bf16* __restrict__ proj, bf16* __restrict__ odiff, LAS unsigned char* lds, const float lam, const float* __restrict__ gsub,
                                     const bool pre, const bool nvalid, const int nb, const int nh, const int nqb, bf16x8& qn0, bf16x8& qn1, bf16x8& qn2, bf16x8& qn3) {
    int tid = threadIdx.x; asm volatile("" : "+v"(tid));
    const int lane = tid & 63, r = lane & 31, hi = lane >> 5; const int wid = __builtin_amdgcn_readfirstlane(tid >> 6), c = wid >> 2, sb = wid & 3;
    const size_t rowb = (size_t)b * S; const int q0 = 128 * qb + 32 * sb;
    const size_t hrow = (size_t)(b * 8 + h) * S;
    const bf16* Kg = proj + PO_DK + hrow * 128; const bf16* Vg = proj + PO_DV + hrow * 128;
    const bf16* Qg = proj + PO_DQ + (hrow + q0 + r) * 128 + c * 64 + hi * 8;
    bf16x8 qf[4];
    if (pre) { qf[0] = qn0; qf[1] = qn1; qf[2] = qn2; qf[3] = qn3; }
    else {
#pragma unroll
        for (int ks = 0; ks < 4; ++ks) qf[ks] = *(const bf16x8*)(Qg + 16 * ks);
    }
    const float slope2 = __builtin_amdgcn_exp2f(-(float)(h + 1)) * LOG2E;
    const int t_hi = 2 * qb + 1, NTu = t_hi + 1 - t_lo;
    LAS float* wsf = (LAS float*)(lds + LDS_WS) + wid * 64;
    const unsigned lds0 = (unsigned)(uintptr_t)lds;
    unsigned kof[2], vof[2];
#pragma unroll
    for (int j = 0; j < 2; ++j) { const int pc = wid + 8 * j, key = 4 * pc + (lane >> 4); kof[j] = (unsigned)(key * 256 + (((lane & 15) ^ (key & 7)) << 4));
        const int blk = wid + 8 * j, d0 = blk >> 2, kk = blk & 3; vof[j] = (unsigned)((16 * kk + (lane >> 2)) * 256 + (32 * d0 + 8 * (lane & 3)) * 2); }
#define ATT_DMA(it_) do { const int _t = t_hi - (it_); LAS unsigned char* _s = lds + (((it_) + 3) & 3) * SLOT; \
        const char* _kb = (const char*)Kg + (size_t)_t * 16384; const char* _vb = (const char*)Vg + (size_t)_t * 16384; \
        _Pragma("unroll") for (int _j = 0; _j < 2; ++_j) __builtin_amdgcn_global_load_lds((const unsigned*)(_kb + kof[_j]), (LAS unsigned*)(_s + KOFF + (wid + 8 * _j) * 1024), 16, 0, 0); \
        _Pragma("unroll") for (int _j = 0; _j < 2; ++_j) __builtin_amdgcn_global_load_lds((const unsigned*)(_vb + vof[_j]), (LAS unsigned*)(_s + VOFF + (wid + 8 * _j) * 1024), 16, 0, 0); } while (0)
    if (!pre) ATT_DMA(0);
    ATT_DMA(1); if (NTu > 2) ATT_DMA(2);
    f32x16 o[4], ol;
#pragma unroll
    for (int q = 0; q < 16; ++q) { ol[q] = 0.f;
#pragma unroll
        for (int d = 0; d < 4; ++d) o[d][q] = 0.f; }
    float m = 0.f;
    unsigned kl[4];
#pragma unroll
    for (int ks = 0; ks < 4; ++ks) kl[ks] = lds0 + KOFF + r * 256 + (((8 * c + 2 * ks + hi) ^ (r & 7)) << 4);
    const unsigned vl = lds0 + VOFF + ((lane >> 4) & 1) * 32 + (lane & 3) * 8 + (4 * hi + ((lane & 15) >> 2)) * 64;
    f32x16 p0, p1;
    const bf16x8 ones = (bf16x8){0x3F80, 0x3F80, 0x3F80, 0x3F80, 0x3F80, 0x3F80, 0x3F80, 0x3F80};
#define ATT_PINIT(it_) do { const int _t = t_hi - (it_); const float cb = slope2 * (float)(64 * _t - (q0 + r) + 4 * hi) - m; \
        _Pragma("unroll") for (int q = 0; q < 16; ++q) { p0[q] = fmaf(slope2, (float)((q & 3) + 8 * (q >> 2)), cb); p1[q] = fmaf(slope2, (float)((q & 3) + 8 * (q >> 2) + 32), cb); } } while (0)
#define ATT_H1(it_, FIRST_) do { const int _t = t_hi - (it_); \
        if (64 * _t <= q0 + 31) { const unsigned so_ = (unsigned)(((it_) + 3) & 3) * SLOT; \
            bf16x8 k0 = rd128<0>(kl[0] + so_), k1 = rd128<0>(kl[1] + so_), k2 = rd128<0>(kl[2] + so_), k3 = rd128<0>(kl[3] + so_), k4 = rd128<8192>(kl[0] + so_), k5 = rd128<8192>(kl[1] + so_), k6 = rd128<8192>(kl[2] + so_), k7 = rd128<8192>(kl[3] + so_); \
            asm volatile("s_waitcnt lgkmcnt(0)" : "+v"(k0), "+v"(k1), "+v"(k2), "+v"(k3), "+v"(k4), "+v"(k5), "+v"(k6), "+v"(k7)); \
            p0 = __builtin_amdgcn_mfma_f32_32x32x16_bf16(k0, qf[0], p0, 0, 0, 0); p1 = __builtin_amdgcn_mfma_f32_32x32x16_bf16(k4, qf[0], p1, 0, 0, 0); \
            p0 = __builtin_amdgcn_mfma_f32_32x32x16_bf16(k1, qf[1], p0, 0, 0, 0); p1 = __builtin_amdgcn_mfma_f32_32x32x16_bf16(k5, qf[1], p1, 0, 0, 0); \
            p0 = __builtin_amdgcn_mfma_f32_32x32x16_bf16(k2, qf[2], p0, 0, 0, 0); p1 = __builtin_amdgcn_mfma_f32_32x32x16_bf16(k6, qf[2], p1, 0, 0, 0); \
            p0 = __builtin_amdgcn_mfma_f32_32x32x16_bf16(k3, qf[3], p0, 0, 0, 0); p1 = __builtin_amdgcn_mfma_f32_32x32x16_bf16(k7, qf[3], p1, 0, 0, 0); \
            if (64 * _t + 63 > q0) { \
                _Pragma("unroll") for (int q = 0; q < 16; ++q) { const int j = 64 * _t + crow(q, hi); if (j > q0 + r) p0[q] = -INFINITY; if (j + 32 > q0 + r) p1[q] = -INFINITY; } } \
            float rm = max3(p0[0], p0[1], p1[0]); rm = max3(rm, p1[1], p0[2]); rm = max3(rm, p0[3], p1[2]); rm = max3(rm, p1[3], p0[4]); \
            rm = max3(rm, p0[5], p1[4]); rm = max3(rm, p1[5], p0[6]); rm = max3(rm, p0[7], p1[6]); rm = max3(rm, p1[7], p0[8]); \
            rm = max3(rm, p0[9], p1[8]); rm = max3(rm, p1[9], p0[10]); rm = max3(rm, p0[11], p1[10]); rm = max3(rm, p1[11], p0[12]); \
            rm = max3(rm, p0[13], p1[12]); rm = max3(rm, p1[13], p0[14]); rm = max3(rm, p0[15], p1[14]); rm = max3(rm, p1[15], rm); \
            { const auto sw_ = __builtin_amdgcn_permlane32_swap(__builtin_bit_cast(unsigned, rm), __builtin_bit_cast(unsigned, rm), false, false);     \
              rm = fmaxf(__builtin_bit_cast(float, sw_[0]), __builtin_bit_cast(float, sw_[1])); } \
            if (FIRST_) { m = rm;                                         \
                _Pragma("unroll") for (int q = 0; q < 16; ++q) { p0[q] -= rm; p1[q] -= rm; } } \
            else if (__any(rm > THR)) { \
                const float dl = fmaxf(rm, 0.f), alpha = __builtin_amdgcn_exp2f(-dl); m += dl; \
                _Pragma("unroll") for (int q = 0; q < 16; ++q) { p0[q] -= dl; p1[q] -= dl; } \
                if (hi == 0) wsf[r] = alpha; \
                asm volatile("s_waitcnt lgkmcnt(0)" ::: "memory"); \
                _Pragma("unroll") for (int g4 = 0; g4 < 4; ++g4) { const f32x4 a4 = *(const LAS f32x4*)(wsf + 8 * g4 + 4 * hi);     \
                    _Pragma("unroll") for (int e = 0; e < 4; ++e) { ol[4 * g4 + e] *= a4[e]; \
                        _Pragma("unroll") for (int d = 0; d < 4; ++d) o[d][4 * g4 + e] *= a4[e]; } \
                    __builtin_amdgcn_sched_barrier(0); } } \
            _Pragma("unroll") for (int q = 0; q < 16; ++q) { p0[q] = __builtin_amdgcn_exp2f(p0[q]); p1[q] = __builtin_amdgcn_exp2f(p1[q]); } } } while (0)
#define ATT_VRD(dst, s_) do { dst##0l = rdtr<(s_) * 2048>(va); dst##0h = rdtr<(s_) * 2048 + 512>(va); dst##1l = rdtr<(s_) * 2048 + 1024>(va); dst##1h = rdtr<(s_) * 2048 + 1536>(va); } while (0)
#define ATT_VWAIT(n, dst) asm volatile("s_waitcnt lgkmcnt(" #n ")" : "+v"(dst##0l), "+v"(dst##0h), "+v"(dst##1l), "+v"(dst##1h))
#define ATT_VF(dst, k) (bf16x8){dst##k##l[0], dst##k##l[1], dst##k##l[2], dst##k##l[3], dst##k##h[0], dst##k##h[1], dst##k##h[2], dst##k##h[3]}
#define ATT_PV(s_, dst, PA, PB) do { o[(s_) >> 1] = __builtin_amdgcn_mfma_f32_32x32x16_bf16(PA, ATT_VF(dst, 0), o[(s_) >> 1], 0, 0, 0); o[(s_) >> 1] = __builtin_amdgcn_mfma_f32_32x32x16_bf16(PB, ATT_VF(dst, 1), o[(s_) >> 1], 0, 0, 0); } while (0)
#define ATT_PACK(P, b8) __builtin_bit_cast(bf16x8, (u32x4){pg8::cvt_pk_bf16(P[b8 + 0], P[b8 + 1]), pg8::cvt_pk_bf16(P[b8 + 2], P[b8 + 3]), pg8::cvt_pk_bf16(P[b8 + 4], P[b8 + 5]), pg8::cvt_pk_bf16(P[b8 + 6], P[b8 + 7])})
#define ATT_H2(it_) do { const int _t = t_hi - (it_); \
        if (64 * _t <= q0 + 31) { const unsigned va = vl + (unsigned)(((it_) + 3) & 3) * SLOT; \
            v4i16 A0l, A0h, A1l, A1h, B0l, B0h, B1l, B1h; \
            ATT_VRD(A, 0); \
            const bf16x8 pa0 = ATT_PACK(p0, 0), pa1 = ATT_PACK(p0, 8), pa2 = ATT_PACK(p1, 0), pa3 = ATT_PACK(p1, 8); \
            ATT_VRD(B, 1); \
            ol = __builtin_amdgcn_mfma_f32_32x32x16_bf16(pa0, ones, ol, 0, 0, 0); ol = __builtin_amdgcn_mfma_f32_32x32x16_bf16(pa1, ones, ol, 0, 0, 0); \
            ol = __builtin_amdgcn_mfma_f32_32x32x16_bf16(pa2, ones, ol, 0, 0, 0); ol = __builtin_amdgcn_mfma_f32_32x32x16_bf16(pa3, ones, ol, 0, 0, 0); \
            ATT_VWAIT(4, A); ATT_PV(0, A, pa0, pa1); ATT_VRD(A, 2); ATT_VWAIT(4, B); ATT_PV(1, B, pa2, pa3); \
            ATT_VRD(B, 3); ATT_VWAIT(4, A); ATT_PV(2, A, pa0, pa1); ATT_VRD(A, 4); ATT_VWAIT(4, B); ATT_PV(3, B, pa2, pa3); \
            ATT_VRD(B, 5); ATT_VWAIT(4, A); ATT_PV(4, A, pa0, pa1); ATT_VRD(A, 6); ATT_VWAIT(4, B); ATT_PV(5, B, pa2, pa3); \
            ATT_VRD(B, 7); ATT_VWAIT(4, A); ATT_PV(6, A, pa0, pa1); ATT_VWAIT(0, B); ATT_PV(7, B, pa2, pa3); } \
        if ((it_) + 1 < NTu) ATT_PINIT((it_) + 1); } while (0)
    { const float m0 = m; (void)m0; ATT_PINIT(0); }
    if (c == 0) {
        ATT_WAIT_TILE(0, 2); ATT_BAR();
        ATT_H1(0, true);
        ATT_BAR();
        ATT_H2(0); if (3 < NTu) ATT_DMA(3);
        for (int it = 1; it < NTu; ++it) {
            ATT_WAIT_TILE(it, it + 2); ATT_BAR();
            ATT_H1(it, false);
            ATT_BAR();
            ATT_H2(it); if (it + 3 < NTu) ATT_DMA(it + 3);
        }
        ATT_BAR();
    } else {
        ATT_WAIT_TILE(0, 2); ATT_BAR();
        ATT_BAR();
        ATT_H1(0, true);
        ATT_WAIT_TILE(1, 2);
        ATT_BAR();
        ATT_H2(0); if (3 < NTu) ATT_DMA(3);
        for (int it = 1; it < NTu; ++it) {
            ATT_BAR();
            ATT_H1(it, false);
            if (it + 1 < NTu) ATT_WAIT_TILE(it + 1, it + 2);
            ATT_BAR();
            ATT_H2(it); if (it + 3 < NTu) ATT_DMA(it + 3);
        }
    }
    float rl[16];
#pragma unroll
    for (int q = 0; q < 16; ++q) rl[q] = (c == 1 ? lam : 1.f) * __builtin_amdgcn_rcpf(ol[q]);
#pragma unroll
    for (int d0 = 0; d0 < 4; ++d0)
#pragma unroll
        for (int q = 0; q < 16; ++q) o[d0][q] *= rl[q];
    ATT_BAR();
    if (nvalid) { const size_t nhrow = (size_t)(nb * 8 + nh) * S; LAS unsigned char* _s = lds + 3 * SLOT;
        const char* _kb = (const char*)(proj + PO_DK + nhrow * 128) + (size_t)(2 * nqb + 1) * 16384; const char* _vb = (const char*)(proj + PO_DV + nhrow * 128) + (size_t)(2 * nqb + 1) * 16384;
#pragma unroll
        for (int _j = 0; _j < 2; ++_j) __builtin_amdgcn_global_load_lds((const unsigned*)(_kb + kof[_j]), (LAS unsigned*)(_s + KOFF + (wid + 8 * _j) * 1024), 16, 0, 0);
#pragma unroll
        for (int _j = 0; _j < 2; ++_j) __builtin_amdgcn_global_load_lds((const unsigned*)(_vb + vof[_j]), (LAS unsigned*)(_s + VOFF + (wid + 8 * _j) * 1024), 16, 0, 0);
        const bf16* nQg = proj + PO_DQ + (nhrow + 128 * nqb + 32 * sb + r) * 128 + c * 64 + hi * 8;
        qn0 = *(const bf16x8*)(nQg); qn1 = *(const bf16x8*)(nQg + 16); qn2 = *(const bf16x8*)(nQg + 32); qn3 = *(const bf16x8*)(nQg + 48); }
    else { qn0 = (bf16x8){}; qn1 = (bf16x8){}; qn2 = (bf16x8){}; qn3 = (bf16x8){}; }
    { LAS f32x4* XE = (LAS f32x4*)(lds + LDS_X) + ((c * 4 + sb) * 8) * 64 + lane;
        if (c == 0) {
#pragma unroll
            for (int j = 0; j < 8; ++j) XE[j * 64] = (f32x4){o[2 + (j >> 2)][4 * (j & 3)], o[2 + (j >> 2)][4 * (j & 3) + 1], o[2 + (j >> 2)][4 * (j & 3) + 2], o[2 + (j >> 2)][4 * (j & 3) + 3]};
        } else {
#pragma unroll
            for (int j = 0; j < 8; ++j) XE[j * 64] = (f32x4){o[j >> 2][4 * (j & 3)], o[j >> 2][4 * (j & 3) + 1], o[j >> 2][4 * (j & 3) + 2], o[j >> 2][4 * (j & 3) + 3]};
        } }
    ATT_BAR();
    float v[2][16], ss[16];
    { const LAS f32x4* XR = (const LAS f32x4*)(lds + LDS_X) + (((c ^ 1) * 4 + sb) * 8) * 64 + lane;
        f32x4 pr[8];
#pragma unroll
        for (int j = 0; j < 8; ++j) pr[j] = XR[j * 64];
        if (c == 0) {
#pragma unroll
            for (int k = 0; k < 2; ++k)
#pragma unroll
                for (int q = 0; q < 16; ++q) v[k][q] = o[k][q] - pr[4 * k + (q >> 2)][q & 3];
        } else {
#pragma unroll
            for (int k = 0; k < 2; ++k)
#pragma unroll
                for (int q = 0; q < 16; ++q) v[k][q] = pr[4 * k + (q >> 2)][q & 3] - o[2 + k][q];
        } }
#pragma unroll
    for (int q = 0; q < 16; ++q) { ss[q] = rowsum16(v[0][q] * v[0][q] + v[1][q] * v[1][q]); ss[q] += __shfl_xor(ss[q], 16); }
    LAS f32x4* XS = (LAS f32x4*)(lds + LDS_XS);
    if (r == 0) {
#pragma unroll
        for (int j = 0; j < 4; ++j) XS[((c * 4 + sb) * 2 + hi) * 4 + j] = (f32x4){ss[4 * j], ss[4 * j + 1], ss[4 * j + 2], ss[4 * j + 3]}; }
    ATT_BAR();
    {
#pragma unroll
        for (int j = 0; j < 4; ++j) { const f32x4 ps = XS[(((c ^ 1) * 4 + sb) * 2 + hi) * 4 + j];
#pragma unroll
            for (int e = 0; e < 4; ++e) ss[4 * j + e] = __builtin_amdgcn_rsqf((ss[4 * j + e] + ps[e]) * (1.f / 128) + EPS) * (1.f - LAMBDA_INIT); } }
    LAS bf16* Y = (LAS bf16*)(lds + LDS_Y) + sb * 32 * 128;
    { const int dA = 2 * c; const LAS float* gL = (const LAS float*)(lds + LDS_GSUB);
#pragma unroll
        for (int k = 0; k < 2; ++k) { const float g = gL[32 * (dA + k) + r];
#pragma unroll
            for (int q = 0; q < 16; ++q) Y[crow(q, hi) * 128 + 32 * (dA + k) + r] = f2bf(v[k][q] * ss[q] * g); } }
    ATT_BAR();
    { bf16* Og = odiff + (rowb + q0) * D + h * 128;
#pragma unroll
        for (int i = 0; i < 4; ++i) { const int row = 16 * c + 4 * i + (lane >> 4), ch = lane & 15; *(u32x4*)(Og + (size_t)row * D + ch * 8) = *(const LAS u32x4*)(Y + row * 128 + ch * 8); } }
    ATT_BAR();
#undef ATT_DMA
#undef ATT_H1
#undef ATT_H2
#undef ATT_PINIT
}
}

namespace ret {
typedef short v4i16 __attribute__((ext_vector_type(4)));
constexpr int STG = 98304;
#define RET_BAR() do { asm volatile("s_waitcnt lgkmcnt(0)" ::: "memory"); __builtin_amdgcn_s_barrier(); asm volatile("" ::: "memory"); } while (0)
__device__ __forceinline__ bf16x8 trfrag(LAS unsigned char* p, int second_off) {
    const v4i16 lo = __builtin_amdgcn_ds_read_tr16_b64_v4i16((LAS v4i16*)p), hh = __builtin_amdgcn_ds_read_tr16_b64_v4i16((LAS v4i16*)(p + second_off));
    return (bf16x8){lo[0], lo[1], lo[2], lo[3], hh[0], hh[1], hh[2], hh[3]};
}
__device__ __forceinline__ void store_tile64(const f32x16& t0, const f32x16& t1, LAS unsigned char* stg, bf16* __restrict__ gdst, const size_t gpitch, const int lane) {
    const int r = lane & 31, hi = lane >> 5;
#pragma unroll
    for (int q = 0; q < 16; ++q) { const int row = crow(q, hi); *(LAS bf16*)(stg + row * 128 + r * 2) = f2bf(t0[q]); *(LAS bf16*)(stg + row * 128 + 64 + r * 2) = f2bf(t1[q]); }
    asm volatile("s_waitcnt lgkmcnt(0)" ::: "memory");
#pragma unroll
    for (int i = 0; i < 4; ++i) { const int row = 8 * i + (lane >> 3), ch = lane & 7; *(u32x4*)(gdst + (size_t)row * gpitch + ch * 8) = *(const LAS u32x4*)(stg + row * 128 + ch * 16); }
    asm volatile("s_waitcnt lgkmcnt(0)" ::: "memory");
}
__device__ __forceinline__ void r1_unit(const int b, const int h, const int j, const bf16* __restrict__ proj, bf16* __restrict__ ubuf, LAS unsigned char* lds) {
    constexpr int KV = 0, VV = 32768;
    int tid = threadIdx.x; asm volatile("" : "+v"(tid));
    const int lane = tid & 63, hi = lane >> 5; const int wid = __builtin_amdgcn_readfirstlane(tid >> 6), db = wid & 3, cg = wid >> 2;
    const size_t hrow = (size_t)(b * 4 + h) * S + (size_t)j * 128;
    const bf16* Kg = proj + PO_RK + hrow * 128; const bf16* Vg = proj + PO_RV + hrow * 256;
#pragma unroll
    for (int i = 0; i < 4; ++i) { const int blk = wid * 4 + i, d_b = blk >> 3, mg = blk & 7;
        __builtin_amdgcn_global_load_lds((const unsigned*)(Kg + (size_t)(16 * mg + (lane >> 2)) * 128 + 32 * d_b + 8 * (lane & 3)), (LAS unsigned*)(lds + KV + blk * 1024), 16, 0, 2); }
#pragma unroll
    for (int i = 0; i < 8; ++i) { const int blk = wid * 8 + i, cb = blk >> 3, mg = blk & 7;
        __builtin_amdgcn_global_load_lds((const unsigned*)(Vg + (size_t)(16 * mg + (lane >> 2)) * 256 + 32 * cb + 8 * (lane & 3)), (LAS unsigned*)(lds + VV + blk * 1024), 16, 0, 2); }
    const int vperm = ((lane >> 4) & 1) * 32 + (lane & 3) * 8 + (4 * hi + ((lane & 15) >> 2)) * 64;
    f32x16 u[4];
#pragma unroll
    for (int t = 0; t < 4; ++t)
#pragma unroll
        for (int q = 0; q < 16; ++q) u[t][q] = 0.f;
    asm volatile("s_waitcnt vmcnt(0)" ::: "memory");
    RET_BAR();
#pragma unroll
    for (int m2 = 0; m2 < 4; ++m2) {
        bf16x8 a[2], bv[2][4];
#pragma unroll
        for (int s = 0; s < 2; ++s) { const int mg = 2 * m2 + s; a[s] = trfrag(lds + KV + (db * 8 + mg) * 1024 + vperm, 512);
#pragma unroll
            for (int t = 0; t < 4; ++t) bv[s][t] = trfrag(lds + VV + ((4 * cg + t) * 8 + mg) * 1024 + vperm, 512); }
#pragma unroll
        for (int s = 0; s < 2; ++s)
#pragma unroll
            for (int t = 0; t < 4; ++t) u[t] = __builtin_amdgcn_mfma_f32_32x32x16_bf16(a[s], bv[s][t], u[t], 0, 0, 0);
    }
    bf16* Ug = ubuf + (((size_t)b * 4 + h) * 32 + j) * 32768 + (size_t)(32 * db) * 256 + 128 * cg;
    LAS unsigned char* stg = lds + STG + wid * 4096;
    store_tile64(u[0], u[1], stg, Ug, 256, lane);
    store_tile64(u[2], u[3], stg, Ug + 64, 256, lane);
    RET_BAR();
}
__device__ __forceinline__ void r3_unit(const int b, const int h, const int j, const int half, const bf16* __restrict__ proj, const bf16* __restrict__ rbbuf, bf16* __restrict__ yret, LAS unsigned char* lds) {
    constexpr int KK = 0, VV = 32768, RB = 65536;
    int tid = threadIdx.x; asm volatile("" : "+v"(tid));
    const int lane = tid & 63, r = lane & 31, hi = lane >> 5; const int wid = __builtin_amdgcn_readfirstlane(tid >> 6), sb = wid & 3, ch = wid >> 2;
    const size_t row0 = (size_t)b * S + (size_t)j * 128, hrow = (size_t)(b * 4 + h) * S + (size_t)j * 128;
    const bf16* Qg = proj + PO_RQ + hrow * 128; const bf16* Kg = proj + PO_RK + hrow * 128; const bf16* Vg = proj + PO_RV + hrow * 256 + half * 128;
    const bf16* Rg = rbbuf + (((size_t)b * 4 + h) * 32 + j) * 32768 + half * 128;
#pragma unroll
    for (int i = 0; i < 4; ++i) { const int pc = wid * 4 + i, cidx = pc >> 1, mh = pc & 1;
        __builtin_amdgcn_global_load_lds((const unsigned*)(Kg + (size_t)(64 * mh + lane) * 128 + cidx * 8), (LAS unsigned*)(lds + KK + cidx * 2048 + mh * 1024), 16, 0, 0); }
#pragma unroll
    for (int i = 0; i < 4; ++i) { const int blk = wid * 4 + i, cb = blk >> 3, mg = blk & 7;
        __builtin_amdgcn_global_load_lds((const unsigned*)(Vg + (size_t)(16 * mg + (lane >> 2)) * 256 + 32 * cb + 8 * (lane & 3)), (LAS unsigned*)(lds + VV + blk * 1024), 16, 0, 0);
        __builtin_amdgcn_global_load_lds((const unsigned*)(Rg + (size_t)(16 * mg + (lane >> 2)) * 256 + 32 * cb + 8 * (lane & 3)), (LAS unsigned*)(lds + RB + blk * 1024), 16, 0, 0); }
    bf16x8 qf[8];
#pragma unroll
    for (int ks = 0; ks < 8; ++ks) qf[ks] = *(const bf16x8*)(Qg + (size_t)(32 * sb + r) * 128 + 16 * ks + 8 * hi);
    const int vperm = ((lane >> 4) & 1) * 32 + (lane & 3) * 8 + (4 * hi + ((lane & 15) >> 2)) * 64;
    const int vnat  = ((lane >> 4) & 1) * 32 + (lane & 3) * 8 + (8 * hi + ((lane & 15) >> 2)) * 64;
    asm volatile("s_waitcnt vmcnt(0)" ::: "memory");
    RET_BAR();
    bf16x8 pa[8];
#pragma unroll
    for (int kb = 0; kb < 4; ++kb) {
        if (kb <= sb) {
            bf16x8 kf[8];
#pragma unroll
            for (int ks = 0; ks < 8; ++ks) kf[ks] = *(const LAS bf16x8*)(lds + KK + (2 * ks + hi) * 2048 + (32 * kb + r) * 16);
            f32x16 p;
#pragma unroll
            for (int q = 0; q < 16; ++q) p[q] = 0.f;
#pragma unroll
            for (int ks = 0; ks < 8; ++ks) p = __builtin_amdgcn_mfma_f32_32x32x16_bf16(kf[ks], qf[ks], p, 0, 0, 0);
            if (kb == sb) {
#pragma unroll
                for (int q = 0; q < 16; ++q) if (crow(q, hi) > r) p[q] = 0.f;
            }
#pragma unroll
            for (int b8 = 0; b8 < 2; ++b8) { u32x4 w;
                w.x = pg8::cvt_pk_bf16(p[8 * b8 + 0], p[8 * b8 + 1]); w.y = pg8::cvt_pk_bf16(p[8 * b8 + 2], p[8 * b8 + 3]); w.z = pg8::cvt_pk_bf16(p[8 * b8 + 4], p[8 * b8 + 5]); w.w = pg8::cvt_pk_bf16(p[8 * b8 + 6], p[8 * b8 + 7]);
                pa[2 * kb + b8] = __builtin_bit_cast(bf16x8, w); }
        }
    }
    f32x16 y[2];
#pragma unroll
    for (int d0 = 0; d0 < 2; ++d0) {
#pragma unroll
        for (int q = 0; q < 16; ++q) y[d0][q] = 0.f;
        const int cb = 2 * ch + d0;
        bf16x8 vf[8];
#pragma unroll
        for (int kk = 0; kk < 8; ++kk) if ((kk >> 1) <= sb) vf[kk] = trfrag(lds + VV + (cb * 8 + kk) * 1024 + vperm, 512);
#pragma unroll
        for (int kk = 0; kk < 8; ++kk) if ((kk >> 1) <= sb) y[d0] = __builtin_amdgcn_mfma_f32_32x32x16_bf16(pa[kk], vf[kk], y[d0], 0, 0, 0);
        bf16x8 rf[8];
#pragma unroll
        for (int ks = 0; ks < 8; ++ks) rf[ks] = trfrag(lds + RB + (cb * 8 + ks) * 1024 + vnat, 256);
#pragma unroll
        for (int ks = 0; ks < 8; ++ks) y[d0] = __builtin_amdgcn_mfma_f32_32x32x16_bf16(qf[ks], rf[ks], y[d0], 0, 0, 0);
    }
    bf16* Yg = yret + (row0 + 32 * sb) * D + h * 256 + half * 128 + 64 * ch;
    store_tile64(y[0], y[1], lds + STG + wid * 4096, Yg, D, lane);
    RET_BAR();
}
__device__ __forceinline__ float rbflo(unsigned u) { return __builtin_bit_cast(float, u << 16); }
__device__ __forceinline__ float rbfhi(unsigned u) { return __builtin_bit_cast(float, u & 0xffff0000u); }
__device__ __forceinline__ void r3m_unit(const int b, const int h, const int j, const bf16* __restrict__ proj, const bf16* __restrict__ rbbuf, const bf16* __restrict__ odiff, bf16* __restrict__ merged,
                                         const float* __restrict__ ggn, const float* __restrict__ bgn, LAS unsigned char* lds) {
    constexpr int KK = 0, VV = 32768, RB = 65536, XS = 98304;
    int tid = threadIdx.x; asm volatile("" : "+v"(tid));
    const int lane = tid & 63, r = lane & 31, hi = lane >> 5; const int wid = __builtin_amdgcn_readfirstlane(tid >> 6), sb = wid & 3, ch = wid >> 2;
    const size_t row0 = (size_t)b * S + (size_t)j * 128, hrow = (size_t)(b * 4 + h) * S + (size_t)j * 128;
    const bf16* Qg = proj + PO_RQ + hrow * 128; const bf16* Kg = proj + PO_RK + hrow * 128; const bf16* Vg = proj + PO_RV + hrow * 256;
    const bf16* Rg = rbbuf + (((size_t)b * 4 + h) * 32 + j) * 32768;
#pragma unroll
    for (int i = 0; i < 4; ++i) { const int pc = wid * 4 + i, cidx = pc >> 1, mh = pc & 1;
        __builtin_amdgcn_global_load_lds((const unsigned*)(Kg + (size_t)(64 * mh + lane) * 128 + cidx * 8), (LAS unsigned*)(lds + KK + cidx * 2048 + mh * 1024), 16, 0, 2); }
#define R3M_DMA_VR(half_) do { _Pragma("unroll") for (int i = 0; i < 4; ++i) { const int blk = wid * 4 + i, cb = blk >> 3, mg = blk & 7; \
        __builtin_amdgcn_global_load_lds((const unsigned*)(Vg + (half_) * 128 + (size_t)(16 * mg + (lane >> 2)) * 256 + 32 * cb + 8 * (lane & 3)), (LAS unsigned*)(lds + VV + blk * 1024), 16, 0, 2); \
        __builtin_amdgcn_global_load_lds((const unsigned*)(Rg + (half_) * 128 + (size_t)(16 * mg + (lane >> 2)) * 256 + 32 * cb + 8 * (lane & 3)), (LAS unsigned*)(lds + RB + blk * 1024), 16, 0, 2); } } while (0)
    R3M_DMA_VR(0);
    bf16x8 qf[8];
#pragma unroll
    for (int ks = 0; ks < 8; ++ks) qf[ks] = *(const bf16x8*)(Qg + (size_t)(32 * sb + r) * 128 + 16 * ks + 8 * hi);
    const int vperm = ((lane >> 4) & 1) * 32 + (lane & 3) * 8 + (4 * hi + ((lane & 15) >> 2)) * 64;
    const int vnat  = ((lane >> 4) & 1) * 32 + (lane & 3) * 8 + (8 * hi + ((lane & 15) >> 2)) * 64;
    asm volatile("s_waitcnt vmcnt(0)" ::: "memory");
    RET_BAR();
    bf16x8 pa[8];
#pragma unroll
    for (int kb = 0; kb < 4; ++kb) {
        if (kb <= sb) {
            bf16x8 kf[8];
#pragma unroll
            for (int ks = 0; ks < 8; ++ks) kf[ks] = *(const LAS bf16x8*)(lds + KK + (2 * ks + hi) * 2048 + (32 * kb + r) * 16);
            f32x16 p;
#pragma unroll
            for (int q = 0; q < 16; ++q) p[q] = 0.f;
#pragma unroll
            for (int ks = 0; ks < 8; ++ks) p = __builtin_amdgcn_mfma_f32_32x32x16_bf16(kf[ks], qf[ks], p, 0, 0, 0);
            if (kb == sb) {
#pragma unroll
                for (int q = 0; q < 16; ++q) if (crow(q, hi) > r) p[q] = 0.f;
            }
#pragma unroll
            for (int b8 = 0; b8 < 2; ++b8) { u32x4 w;
                w.x = pg8::cvt_pk_bf16(p[8 * b8 + 0], p[8 * b8 + 1]); w.y = pg8::cvt_pk_bf16(p[8 * b8 + 2], p[8 * b8 + 3]); w.z = pg8::cvt_pk_bf16(p[8 * b8 + 4], p[8 * b8 + 5]); w.w = pg8::cvt_pk_bf16(p[8 * b8 + 6], p[8 * b8 + 7]);
                pa[2 * kb + b8] = __builtin_bit_cast(bf16x8, w); }
        }
    }
    f32x16 y[2][2];
#define R3M_HALF(hf_) do { _Pragma("unroll") for (int d0 = 0; d0 < 2; ++d0) { \
        _Pragma("unroll") for (int q = 0; q < 16; ++q) y[hf_][d0][q] = 0.f; \
        const int cb = 2 * ch + d0; \
        bf16x8 vf[8]; \
        _Pragma("unroll") for (int kk = 0; kk < 8; ++kk) if ((kk >> 1) <= sb) vf[kk] = trfrag(lds + VV + (cb * 8 + kk) * 1024 + vperm, 512); \
        _Pragma("unroll") for (int kk = 0; kk < 8; ++kk) if ((kk >> 1) <= sb) y[hf_][d0] = __builtin_amdgcn_mfma_f32_32x32x16_bf16(pa[kk], vf[kk], y[hf_][d0], 0, 0, 0); \
        bf16x8 rf[8]; \
        _Pragma("unroll") for (int ks = 0; ks < 8; ++ks) rf[ks] = trfrag(lds + RB + (cb * 8 + ks) * 1024 + vnat, 256); \
        _Pragma("unroll") for (int ks = 0; ks < 8; ++ks) y[hf_][d0] = __builtin_amdgcn_mfma_f32_32x32x16_bf16(qf[ks], rf[ks], y[hf_][d0], 0, 0, 0); } } while (0)
    R3M_HALF(0);
    RET_BAR();
    R3M_DMA_VR(1);
    asm volatile("s_waitcnt vmcnt(0)" ::: "memory");
    RET_BAR();
    R3M_HALF(1);
    RET_BAR();
#undef R3M_DMA_VR
#undef R3M_HALF
    LAS unsigned char* stg = lds + wid * 8192;
#pragma unroll
    for (int hf = 0; hf < 2; ++hf)
#pragma unroll
        for (int d0 = 0; d0 < 2; ++d0)
#pragma unroll
            for (int q = 0; q < 16; ++q) *(LAS bf16*)(stg + crow(q, hi) * 256 + (hf * 64 + d0 * 32 + r) * 2) = f2bf(y[hf][d0][q]);
    asm volatile("s_waitcnt lgkmcnt(0)" ::: "memory");
    const int rs4 = lane >> 4, seg = lane & 15;
    u32x4 yv[8]; float sm[8], sq[8];
#pragma unroll
    for (int i = 0; i < 8; ++i) { yv[i] = *(const LAS u32x4*)(stg + (4 * i + rs4) * 256 + seg * 16);
        const float v0 = rbflo(yv[i].x), v1 = rbfhi(yv[i].x), v2 = rbflo(yv[i].y), v3 = rbfhi(yv[i].y), v4 = rbflo(yv[i].z), v5 = rbfhi(yv[i].z), v6 = rbflo(yv[i].w), v7 = rbfhi(yv[i].w);
        sm[i] = ((v0 + v1) + (v2 + v3)) + ((v4 + v5) + (v6 + v7)); sq[i] = ((v0 * v0 + v1 * v1) + (v2 * v2 + v3 * v3)) + ((v4 * v4 + v5 * v5) + (v6 * v6 + v7 * v7)); }
#pragma unroll
    for (int i = 0; i < 8; ++i) { sm[i] = rowsum16(sm[i]); sq[i] = rowsum16(sq[i]); }
    LAS float* xs = (LAS float*)(lds + XS);
    if (seg == 0) {
#pragma unroll
        for (int i = 0; i < 8; ++i) { xs[(wid * 32 + 4 * i + rs4) * 2] = sm[i]; xs[(wid * 32 + 4 * i + rs4) * 2 + 1] = sq[i]; } }
    RET_BAR();
    const int col = 256 * h + (seg < 8 ? 64 * ch + 8 * seg : 128 + 64 * ch + 8 * (seg - 8));
    const f32x4 g0 = *(const f32x4*)(ggn + col), g1 = *(const f32x4*)(ggn + col + 4), b0 = *(const f32x4*)(bgn + col), b1 = *(const f32x4*)(bgn + col + 4);
#pragma unroll
    for (int ib = 0; ib < 8; ib += 4) {
        u32x4 G1[4], G2[4], OD[4];
#pragma unroll
        for (int i = 0; i < 4; ++i) { const size_t tok = row0 + 32 * sb + 4 * (ib + i) + rs4;
            G1[i] = __builtin_nontemporal_load((const u32x4*)(proj + PO_RG + tok * 1024 + col)); G2[i] = __builtin_nontemporal_load((const u32x4*)(proj + PO_MG + (size_t)T * 1024 + tok * 1024 + col)); OD[i] = __builtin_nontemporal_load((const u32x4*)(odiff + tok * D + col)); }
#pragma unroll
        for (int i = 0; i < 4; ++i) { const int rw = 4 * (ib + i) + rs4; const size_t tok = row0 + 32 * sb + rw;
            const float ts = sm[ib + i] + xs[((wid ^ 4) * 32 + rw) * 2], tq = sq[ib + i] + xs[((wid ^ 4) * 32 + rw) * 2 + 1];
            const float mu = ts * (1.f / 256), rs = __builtin_amdgcn_rsqf(fmaxf(tq * (1.f / 256) - mu * mu, 0.f) + EPS);
            const unsigned yw[4] = {yv[ib + i].x, yv[ib + i].y, yv[ib + i].z, yv[ib + i].w}, g1w[4] = {G1[i].x, G1[i].y, G1[i].z, G1[i].w}, g2w[4] = {G2[i].x, G2[i].y, G2[i].z, G2[i].w}, odw[4] = {OD[i].x, OD[i].y, OD[i].z, OD[i].w};
            unsigned ow[4];
#pragma unroll
            for (int e = 0; e < 4; ++e) { const float gA = e < 2 ? g0[2 * e] : g1[2 * e - 4], gB = e < 2 ? g0[2 * e + 1] : g1[2 * e - 3], bA = e < 2 ? b0[2 * e] : b1[2 * e - 4], bB = e < 2 ? b0[2 * e + 1] : b1[2 * e - 3];
                const float mA = rbflo(g1w[e]) * ((rbflo(yw[e]) - mu) * rs * gA + bA) + rbflo(g2w[e]) * rbflo(odw[e]);
                const float mB = rbfhi(g1w[e]) * ((rbfhi(yw[e]) - mu) * rs * gB + bB) + rbfhi(g2w[e]) * rbfhi(odw[e]);
                ow[e] = pg8::cvt_pk_bf16(mA, mB); }
            *(u32x4*)(merged + tok * D + col) = (u32x4){ow[0], ow[1], ow[2], ow[3]}; }
    }
    RET_BAR();
}
}

struct Args { const float* in[23]; float* out; unsigned char* ws; int ph_lo, ph_hi; };
#define LDS_WAIT() asm volatile("s_waitcnt lgkmcnt(0)" ::: "memory")
__device__ __forceinline__ float wsum(float v) {
#pragma unroll
    for (int o = 1; o < 64; o <<= 1) v += __shfl_xor(v, o);
    return v;
}
__device__ __forceinline__ unsigned pk2(float lo, float hi) { return pg8::cvt_pk_bf16(lo, hi); }
__device__ __forceinline__ float bflo(unsigned u) { return __builtin_bit_cast(float, u << 16); }
__device__ __forceinline__ float bfhi(unsigned u) { return __builtin_bit_cast(float, u & 0xffff0000u); }

template <bool F8>
__device__ __forceinline__ void transpose_item(const float* __restrict__ W, int K, int N, bf16* __restrict__ WT, LAS float* scr, int k0, int n0, int l0, int lane) {
    float wv[32];
#pragma unroll
    for (int i = 0; i < 32; ++i) wv[i] = __builtin_nontemporal_load(W + (size_t)(k0 + 2 * i + (lane >> 5)) * N + l0 + (lane & 31));
#pragma unroll
    for (int i = 0; i < 32; ++i) scr[(2 * i + (lane >> 5)) * 33 + (lane & 31)] = wv[i];
    LDS_WAIT(); asm volatile("" ::: "memory");
    const int c = lane & 7;
#pragma unroll
    for (int j = 0; j < 4; ++j) { const int n = (lane >> 3) + 8 * j; const LAS float* s = scr + (8 * c) * 33 + n;
        if constexpr (F8) { u32x2 o; o.x = pk4_fp8(s[0 * 33], s[1 * 33], s[2 * 33], s[3 * 33], (float)(1 << W_SH)); o.y = pk4_fp8(s[4 * 33], s[5 * 33], s[6 * 33], s[7 * 33], (float)(1 << W_SH));
            *(u32x2*)((unsigned char*)WT + (size_t)(n0 + n) * K + k0 + 8 * c) = o; }
        else { u32x4 o; o.x = pk2(s[0 * 33], s[1 * 33]); o.y = pk2(s[2 * 33], s[3 * 33]); o.z = pk2(s[4 * 33], s[5 * 33]); o.w = pk2(s[6 * 33], s[7 * 33]);
            *(u32x4*)(WT + (size_t)(n0 + n) * K + k0 + 8 * c) = o; } }
    LDS_WAIT(); asm volatile("" ::: "memory");
}

__device__ __forceinline__ void transpose_pair_f8(const float* __restrict__ Wa, const float* __restrict__ Wb, int K, int N, unsigned char* __restrict__ WTa, unsigned char* __restrict__ WTb, LAS float* scr,
                                                  int k0a, int n0a, int l0a, int k0b, int n0b, int l0b, int lane) {
    float wa[32], wb[32];
#pragma unroll
    for (int i = 0; i < 32; ++i) wa[i] = __builtin_nontemporal_load(Wa + (size_t)(k0a + 2 * i + (lane >> 5)) * N + l0a + (lane & 31));
#pragma unroll
    for (int i = 0; i < 32; ++i) wb[i] = __builtin_nontemporal_load(Wb + (size_t)(k0b + 2 * i + (lane >> 5)) * N + l0b + (lane & 31));
    const int c = lane & 7;
#pragma unroll
    for (int p = 0; p < 2; ++p) {
#pragma unroll
        for (int i = 0; i < 32; ++i) scr[(2 * i + (lane >> 5)) * 33 + (lane & 31)] = p ? wb[i] : wa[i];
        LDS_WAIT(); asm volatile("" ::: "memory");
        unsigned char* WT = p ? WTb : WTa; const int k0 = p ? k0b : k0a, n0 = p ? n0b : n0a;
#pragma unroll
        for (int j = 0; j < 4; ++j) { const int n = (lane >> 3) + 8 * j; const LAS float* s = scr + (8 * c) * 33 + n;
            u32x2 o; o.x = pk4_fp8(s[0 * 33], s[1 * 33], s[2 * 33], s[3 * 33], (float)(1 << W_SH)); o.y = pk4_fp8(s[4 * 33], s[5 * 33], s[6 * 33], s[7 * 33], (float)(1 << W_SH));
            __builtin_nontemporal_store(o, (u32x2*)(WT + (size_t)(n0 + n) * K + k0 + 8 * c)); }
        LDS_WAIT(); asm volatile("" ::: "memory");
    }
}

__device__ __forceinline__ void phase_prologue(const Args& args, unsigned char* ws, LAS unsigned char* lds, int vcu, int G) {
    const int tid = threadIdx.x, lane = tid & 63, wave = __builtin_amdgcn_readfirstlane(tid >> 6);
    const float* c = args.in[1]; const float* w_ada = args.in[2]; const float* b_ada = args.in[3]; float* mod = (float*)(ws + WS_MOD);
    for (int blk = vcu; blk < 96; blk += G) {
        LAS float* sc = (LAS float*)lds;
        LAS float* part = (LAS float*)(lds + 32768);
        for (int i = tid; i < NB * D; i += 512) { const float v = c[i]; sc[i] = v * fast_sigmoid(v); }
        __syncthreads();
        float acc[NB];
#pragma unroll
        for (int b = 0; b < NB; ++b) acc[b] = 0.f;
        const float* wp = w_ada + (size_t)(wave * 128) * 6144 + blk * 64 + lane;
        for (int k0 = 0; k0 < 128; k0 += 64) { float wv[64];
#pragma unroll
            for (int k = 0; k < 64; ++k) wv[k] = __builtin_nontemporal_load(wp + (size_t)(k0 + k) * 6144);
#pragma unroll
            for (int k = 0; k < 64; ++k)
#pragma unroll
                for (int b = 0; b < NB; ++b) acc[b] += sc[b * D + wave * 128 + k0 + k] * wv[k]; }
#pragma unroll
        for (int b = 0; b < NB; ++b) part[(wave * NB + b) * 64 + lane] = acc[b];
        __syncthreads();
        { const int b = tid >> 6; float s = b_ada[blk * 64 + lane];
#pragma unroll
            for (int w = 0; w < 8; ++w) s += part[(w * NB + b) * 64 + lane];
            mod[b * 6144 + blk * 64 + lane] = s; }
        asm volatile("s_waitcnt vmcnt(0)" ::: "memory");
        __syncthreads();
        if (tid == 0) { __builtin_amdgcn_fence(__ATOMIC_RELEASE, "agent"); asm volatile("s_waitcnt vmcnt(0)" ::: "memory");
            atomicAdd(&((unsigned*)(ws + WS_CTL))[CW_MOD], 1u); }
    }
    if (vcu == (96 % G)) {
        bf16* wrt = (bf16*)(ws + WS_WRT); const float* wr = args.in[17];
        for (int i = tid; i < NE * D; i += 512) { const int e = i >> 10, k = i & 1023; const float w = wr[(size_t)k * NE + e]; const bf16 hb_ = f2bf(w); wrt[i] = hb_; wrt[NE * D + i] = f2bf(w - bf2f(hb_)); }
    }
    LAS float* scr = (LAS float*)(lds + wave * 16384);
    const int gw = vcu * 8 + wave, NGW = G * 8;
    constexpr int I_IN = (D / 64) * (INW / 32), I_OUT = (D / 64) * (D / 32), I_W1 = (D / 64) * (2048 / 32), I_W2 = (FF / 64) * (D / 32);
    constexpr int I_IN8 = IN_GATE_F8 ? (D / 64) * (12 * 8) : 0;
    static_assert(MOE_W_IN_QUEUE == 1, "expert weights (and w_out) are transposed by items of the mixer work queue");
    constexpr int NV = I_IN8 + I_IN;
    const int ngem = G > 96 ? 96 : 0, own = ngem * 8;
    const int first = vcu < ngem ? vcu * 8 + wave : own + (vcu - ngem) * 8 + wave, step = vcu < ngem ? NV : (G - ngem) * 8;
    for (int v = first; v < NV; v += step) {
        if (v < I_IN8) { const int kb = v / 96, q = v % 96, tl = q >> 3, n0 = 256 * (tl < 8 ? 8 + tl : 20 + tl) + 32 * (q & 7);
            transpose_item<true>(args.in[5], D, INW, (bf16*)(ws + WS_WIN8), scr, 64 * kb, n0, in_p2l(n0), lane); }
        else { const int rr = v - I_IN8, nblk = INW / 32, kb = rr / nblk, nb = rr % nblk; transpose_item<FP8_IN != 0>(args.in[5], D, INW, (bf16*)(ws + WS_WIN), scr, 64 * kb, 32 * nb, in_p2l(32 * nb), lane); }
    }
    (void)gw; (void)NGW; (void)I_OUT; (void)I_W1; (void)I_W2;
}

__device__ __forceinline__ void wout_item(const Args& args, unsigned char* ws, LAS float* scr, int rr, int lane) {
    const int nblk = D / 32, kb = rr / nblk, nb = rr % nblk; transpose_item<FP8_OUT != 0>(args.in[15], D, D, (bf16*)(ws + WS_WOUT), scr, 64 * kb, 32 * nb, 32 * nb, lane);
}

__device__ __forceinline__ void moe_w_item(const Args& args, unsigned char* ws, LAS float* scr, int rr, int lane) {
    constexpr int I_W1 = (D / 64) * (2048 / 32), I_W2 = (FF / 64) * (D / 32);
    if (rr < NE * I_W1) { const int e = rr / I_W1, q = rr % I_W1, nblk = 2048 / 32, kb = q / nblk, nb = q % nblk;
        transpose_item<FP8_MOE != 0>(args.in[19] + (size_t)e * D * 2048, D, 2048, (bf16*)(ws + WS_W1 + (size_t)e * 2048 * D * (FP8_MOE ? 1 : 2)), scr, 64 * kb, 32 * nb, w1_p2l(32 * nb), lane); return; }
    rr -= NE * I_W1;
    { const int e = rr / I_W2, q = rr % I_W2, nblk = D / 32, kb = q / nblk, nb = q % nblk;
        transpose_item<FP8_MOE != 0>(args.in[21] + (size_t)e * FF * D, FF, D, (bf16*)(ws + WS_W2 + (size_t)e * D * FF * (FP8_MOE ? 1 : 2)), scr, 64 * kb, 32 * nb, 32 * nb, lane); }
}

__device__ __forceinline__ void moe_w_pair(const Args& args, unsigned char* ws, LAS float* scr, int pr, int lane) {
    constexpr int I_W1 = (D / 64) * (2048 / 32), I_W2 = (FF / 64) * (D / 32);
    int rr = 2 * pr;
    if (rr < NE * I_W1) { const int e = rr / I_W1, q = rr % I_W1, nblk = 2048 / 32, kb = q / nblk, nb = q % nblk; const float* W = args.in[19] + (size_t)e * D * 2048; unsigned char* WT = ws + WS_W1 + (size_t)e * 2048 * D;
        transpose_pair_f8(W, W, D, 2048, WT, WT, scr, 64 * kb, 32 * nb, w1_p2l(32 * nb), 64 * kb, 32 * (nb + 1), w1_p2l(32 * (nb + 1)), lane); return; }
    rr -= NE * I_W1;
    { const int e = rr / I_W2, q = rr % I_W2, nblk = D / 32, kb = q / nblk, nb = q % nblk; const float* W = args.in[21] + (size_t)e * FF * D; unsigned char* WT = ws + WS_W2 + (size_t)e * D * FF;
        transpose_pair_f8(W, W, FF, D, WT, WT, scr, 64 * kb, 32 * nb, 32 * nb, 64 * kb, 32 * (nb + 1), 32 * (nb + 1), lane); }
}

__device__ __forceinline__ void modnorm_row(const float* __restrict__ xrow, const float* __restrict__ g, const float* __restrict__ sc, const float* __restrict__ sh, bf16* __restrict__ orow, int lane, f32x4 (&v)[4]) {
    float ss = 0.f;
#pragma unroll
    for (int i = 0; i < 4; ++i) { v[i] = *(const f32x4*)(xrow + 4 * lane + 256 * i); ss += (v[i][0] * v[i][0] + v[i][1] * v[i][1]) + (v[i][2] * v[i][2] + v[i][3] * v[i][3]); }
    const float rs = __builtin_amdgcn_rsqf(wsum(ss) * (1.f / D) + EPS);
#pragma unroll
    for (int i = 0; i < 4; ++i) { const int cc = 4 * lane + 256 * i; const f32x4 gg = *(const f32x4*)(g + cc), s1 = *(const f32x4*)(sc + cc), s0 = *(const f32x4*)(sh + cc);
        v[i] = v[i] * rs * gg * (s1 + 1.f) + s0;
        u32x2 o; o.x = pk2(v[i][0], v[i][1]); o.y = pk2(v[i][2], v[i][3]); *(u32x2*)(orow + cc) = o; }
}
template <bool TILE, bool F8, bool XBF = false>
__device__ __forceinline__ void modnorm4(const float* __restrict__ xr, const float* __restrict__ g, const float* __restrict__ sc, const float* __restrict__ sh, bf16* __restrict__ orow, LAS unsigned char* tile, int rtp, int lane, unsigned char* __restrict__ orow8 = nullptr) {
    f32x4 v[4][4];
#pragma unroll
    for (int j = 0; j < 4; ++j)
#pragma unroll
        for (int i = 0; i < 4; ++i) { if constexpr (XBF) { const u32x2 w = *(const u32x2*)((const bf16*)xr + (size_t)j * D + 4 * lane + 256 * i); v[j][i] = (f32x4){bflo(w.x), bfhi(w.x), bflo(w.y), bfhi(w.y)}; }
            else v[j][i] = __builtin_nontemporal_load((const f32x4*)(xr + (size_t)j * D + 4 * lane + 256 * i)); }
    f32x4 gg[4], s1[4], s0[4];
#pragma unroll
    for (int i = 0; i < 4; ++i) { const int cc = 4 * lane + 256 * i; gg[i] = *(const f32x4*)(g + cc); s1[i] = *(const f32x4*)(sc + cc) + 1.f; s0[i] = *(const f32x4*)(sh + cc); gg[i] = gg[i] * s1[i]; }
#pragma unroll
    for (int j = 0; j < 4; ++j) { float ss = 0.f;
#pragma unroll
        for (int i = 0; i < 4; ++i) ss += (v[j][i][0] * v[j][i][0] + v[j][i][1] * v[j][i][1]) + (v[j][i][2] * v[j][i][2] + v[j][i][3] * v[j][i][3]);
        const float rs = __builtin_amdgcn_rsqf(wsum(ss) * (1.f / D) + EPS);
#pragma unroll
        for (int i = 0; i < 4; ++i) { const int cc = 4 * lane + 256 * i; const f32x4 o = v[j][i] * rs * gg[i] + s0[i];
            u32x2 pk; pk.x = pk2(o[0], o[1]); pk.y = pk2(o[2], o[3]);
            if constexpr (F8) *(unsigned*)((unsigned char*)orow + (size_t)j * D + cc) = pk4_fp8(o[0], o[1], o[2], o[3], (float)(1 << A_SH));
            else *(u32x2*)(orow + (size_t)j * D + cc) = pk;
            if (orow8) *(unsigned*)(orow8 + (size_t)j * D + cc) = pk4_fp8(o[0], o[1], o[2], o[3], (float)(1 << A_SH));
            if constexpr (TILE) *(LAS u32x2*)(tile + j * rtp + cc * 2) = pk; } }
}
__device__ __forceinline__ void phase_h1(const Args& args, unsigned char* ws, int vcu, int G) {
    const int lane = threadIdx.x & 63, wave = __builtin_amdgcn_readfirstlane(threadIdx.x >> 6); const float* mod = (const float*)(ws + WS_MOD); bf16* hb = (bf16*)(ws + WS_H);
    if (threadIdx.x == 0) { const unsigned* cnt = (const unsigned*)(ws + WS_CTL) + CW_MOD; unsigned sp = 0u;
        while (__hip_atomic_load(cnt, __ATOMIC_RELAXED, __HIP_MEMORY_SCOPE_AGENT) < 96u && ++sp < (1u << 22)) __builtin_amdgcn_s_sleep(4);
        __builtin_amdgcn_fence(__ATOMIC_ACQUIRE, "agent"); asm volatile("s_waitcnt vmcnt(0)" ::: "memory"); }
    __syncthreads();
    for (int t = (vcu * 8 + wave) * 4; t < T; t += G * 32) { const int b = t / S;
        modnorm4<false, FP8_IN != 0>(args.in[0] + (size_t)t * D, args.in[4], mod + b * 6144 + 1024, mod + b * 6144, (bf16*)((unsigned char*)hb + (size_t)t * D * (FP8_IN ? 1 : 2)), nullptr, 0, lane, IN_GATE_F8 ? ws + WS_H8 + (size_t)t * D : nullptr); }
}

__device__ __forceinline__ void phase_merge(const Args& args, unsigned char* ws, int vcu, int G) {
    const int lane = threadIdx.x & 63, wave = __builtin_amdgcn_readfirstlane(threadIdx.x >> 6);
    const bf16* proj = (const bf16*)(ws + WS_PROJ); const bf16* yret = (const bf16*)(ws + WS_YRET); const bf16* odiff = (const bf16*)(ws + WS_ODIFF); bf16* merged = (bf16*)(ws + WS_MRG);
    const float* ggn = args.in[6]; const float* bgn = args.in[7];
    f32x4 gg[4], bb[4];
#pragma unroll
    for (int i = 0; i < 4; ++i) { gg[i] = *(const f32x4*)(ggn + 4 * lane + 256 * i); bb[i] = *(const f32x4*)(bgn + 4 * lane + 256 * i); }
    constexpr int TB = 2;
    for (int t = (vcu * 8 + wave) * TB; t < T; t += G * 8 * TB) {
        u32x2 yy[TB][4], rg[TB][4], md[TB][4], od[TB][4];
#pragma unroll
        for (int j = 0; j < TB; ++j) { const bf16* prg = proj + PO_RG + (size_t)(t + j) * 1024; const bf16* pmg = proj + PO_MG + (size_t)(t + j) * 1024;
#pragma unroll
            for (int i = 0; i < 4; ++i) { const int cc = 4 * lane + 256 * i;
                yy[j][i] = *(const u32x2*)(yret + (size_t)(t + j) * D + cc); od[j][i] = *(const u32x2*)(odiff + (size_t)(t + j) * D + cc);
                rg[j][i] = *(const u32x2*)(prg + cc); md[j][i] = *(const u32x2*)(pmg + (size_t)T * 1024 + cc); } }
#pragma unroll
        for (int j = 0; j < TB; ++j)
#pragma unroll
            for (int i = 0; i < 4; ++i) { const int cc = 4 * lane + 256 * i;
                float y[4] = {bflo(yy[j][i].x), bfhi(yy[j][i].x), bflo(yy[j][i].y), bfhi(yy[j][i].y)};
                const float mu = wsum((y[0] + y[1]) + (y[2] + y[3])) * (1.f / 256);
                float vv = 0.f;
#pragma unroll
                for (int e = 0; e < 4; ++e) { y[e] -= mu; vv += y[e] * y[e]; }
                const float rs = __builtin_amdgcn_rsqf(wsum(vv) * (1.f / 256) + EPS);
                const float rgv[4] = {bflo(rg[j][i].x), bfhi(rg[j][i].x), bflo(rg[j][i].y), bfhi(rg[j][i].y)};
                const float mdv[4] = {bflo(md[j][i].x), bfhi(md[j][i].x), bflo(md[j][i].y), bfhi(md[j][i].y)}, odv[4] = {bflo(od[j][i].x), bfhi(od[j][i].x), bflo(od[j][i].y), bfhi(od[j][i].y)};
                float m[4];
#pragma unroll
                for (int e = 0; e < 4; ++e) m[e] = rgv[e] * (y[e] * rs * gg[i][e] + bb[i][e]) + mdv[e] * odv[e];
                if (FP8_OUT) *(unsigned*)((unsigned char*)merged + (size_t)(t + j) * D + cc) = pk4_fp8(m[0], m[1], m[2], m[3], (float)(1 << A_SH));
                else { u32x2 o; o.x = pk2(m[0], m[1]); o.y = pk2(m[2], m[3]); *(u32x2*)(merged + (size_t)(t + j) * D + cc) = o; } }
    }
}

constexpr int RT_PITCH = 2064;
constexpr int RT_H = 0, RT_P = 32 * RT_PITCH, RT_L = RT_P + 8 * 32 * 32 * 4, RT_CNT = RT_L + 128 * 33 * 4, RT_SEL = RT_CNT + 128;
static_assert(RT_SEL + 2048 <= LDS_STAGE_BYTES, "route LDS map");
__device__ __forceinline__ void phase_route(const Args& args, unsigned char* ws, LAS unsigned char* lds, int vcu, int G) {
    const int tid = threadIdx.x, lane = tid & 63, r = lane & 31, hi = lane >> 5, wave = __builtin_amdgcn_readfirstlane(tid >> 6);
    const float* mod = (const float*)(ws + WS_MOD); bf16* h2 = (bf16*)(ws + WS_H); unsigned* ctl = (unsigned*)(ws + WS_CTL);
    int* tok_e = (int*)(ws + WS_ROUTE); int* tok_pos = tok_e + T * 4; float* tok_w = (float*)(tok_pos + T * 4); int* list = (int*)(ws + WS_LIST);
    const bf16* wrt = (const bf16*)(ws + WS_WRT); const float* br = args.in[18];
    LAS unsigned* lcnt = (LAS unsigned*)(lds + RT_CNT); LAS unsigned* lsel = (LAS unsigned*)(lds + RT_SEL); LAS float* P = (LAS float*)(lds + RT_P); LAS float* L = (LAS float*)(lds + RT_L);
    bf16x8 bh[8], bl[8];
#pragma unroll
    for (int ks = 0; ks < 8; ++ks) { bh[ks] = *(const bf16x8*)(wrt + (size_t)r * D + 128 * wave + 16 * ks + 8 * hi); bl[ks] = *(const bf16x8*)(wrt + (size_t)(NE + r) * D + 128 * wave + 16 * ks + 8 * hi); }
    for (int t0 = vcu * 128; t0 < T; t0 += G * 128) {
        const int b = t0 / S;
        if (tid < NE) lcnt[tid] = 0u;
        const bf16* x1b = (const bf16*)(ws + WS_X1B); const float* sc2 = mod + b * 6144 + 4096; const float* sh2 = mod + b * 6144 + 3072;
        f32x4 gg[4], s0[4];
#pragma unroll
        for (int i = 0; i < 4; ++i) { const int cc = 4 * lane + 256 * i; gg[i] = *(const f32x4*)(args.in[16] + cc) * (*(const f32x4*)(sc2 + cc) + 1.f); s0[i] = *(const f32x4*)(sh2 + cc); }
        u32x2 xr[4][4];
#define RT_LOADX(sbi_) do { const size_t tr_ = (size_t)(t0 + 32 * (sbi_) + 4 * wave); _Pragma("unroll") for (int j = 0; j < 4; ++j) _Pragma("unroll") for (int i = 0; i < 4; ++i) \
            xr[j][i] = __builtin_nontemporal_load((const u32x2*)(x1b + (tr_ + j) * D + 4 * lane + 256 * i)); } while (0)
        RT_LOADX(0);
        for (int sbi = 0; sbi < 4; ++sbi) {
            { const int tl = 4 * wave; const size_t tr = (size_t)(t0 + 32 * sbi + tl);
#pragma unroll
                for (int j = 0; j < 4; ++j) { f32x4 v[4]; float ss = 0.f;
#pragma unroll
                    for (int i = 0; i < 4; ++i) { v[i] = (f32x4){bflo(xr[j][i].x), bfhi(xr[j][i].x), bflo(xr[j][i].y), bfhi(xr[j][i].y)};
                        ss += (v[i][0] * v[i][0] + v[i][1] * v[i][1]) + (v[i][2] * v[i][2] + v[i][3] * v[i][3]); }
                    const float rs = __builtin_amdgcn_rsqf(wsum(ss) * (1.f / D) + EPS);
#pragma unroll
                    for (int i = 0; i < 4; ++i) { const int cc = 4 * lane + 256 * i; const f32x4 o = v[i] * rs * gg[i] + s0[i];
                        u32x2 pk; pk.x = pk2(o[0], o[1]); pk.y = pk2(o[2], o[3]);
                        if (FP8_MOE) *(unsigned*)((unsigned char*)h2 + (tr + j) * D + cc) = pk4_fp8(o[0], o[1], o[2], o[3], (float)(1 << A_SH));
                        else *(u32x2*)(h2 + (tr + j) * D + cc) = pk;
                        *(LAS u32x2*)(lds + RT_H + (tl + j) * RT_PITCH + cc * 2) = pk; } } }
            if (sbi < 3) RT_LOADX(sbi + 1);
            __syncthreads();
            { f32x16 acc;
#pragma unroll
                for (int q = 0; q < 16; ++q) acc[q] = 0.f;
#pragma unroll
                for (int ks = 0; ks < 8; ++ks) { const bf16x8 a = *(const LAS bf16x8*)(lds + RT_H + r * RT_PITCH + (128 * wave + 16 * ks + 8 * hi) * 2);
                    acc = __builtin_amdgcn_mfma_f32_32x32x16_bf16(a, bh[ks], acc, 0, 0, 0); acc = __builtin_amdgcn_mfma_f32_32x32x16_bf16(a, bl[ks], acc, 0, 0, 0); }
#pragma unroll
                for (int q = 0; q < 16; ++q) P[(wave * 32 + crow(q, hi)) * 32 + r] = acc[q]; }
            __syncthreads();
#pragma unroll
            for (int u = 0; u < 2; ++u) { const int idx = tid + 512 * u, tk = idx >> 5, e = idx & 31; float s = br[e];
#pragma unroll
                for (int w = 0; w < 8; ++w) s += P[(w * 32 + tk) * 32 + e];
                L[(32 * sbi + tk) * 33 + e] = s; }
        }
#undef RT_LOADX
        __syncthreads();
        if (tid < 128) { const int t = t0 + tid;
            float lg[NE];
#pragma unroll
            for (int e = 0; e < NE; ++e) lg[e] = L[tid * 33 + e];
            unsigned used = 0u; float tv0 = 0.f, den = 0.f; float wv[TOPK]; int ev[TOPK];
#pragma unroll
            for (int k = 0; k < TOPK; ++k) { float best = -INFINITY; int bi = 0;
#pragma unroll
                for (int e = 0; e < NE; ++e) { const bool ok = !((used >> e) & 1u) && lg[e] > best; best = ok ? lg[e] : best; bi = ok ? e : bi; }
                used |= 1u << bi; if (k == 0) tv0 = best; wv[k] = __expf(best - tv0); den += wv[k]; ev[k] = bi; }
            const float rden = 1.f / den;
#pragma unroll
            for (int k = 0; k < TOPK; ++k) { const unsigned lp = atomicAdd((unsigned*)&lcnt[ev[k]], 1u);
                lsel[tid * 4 + k] = ((unsigned)ev[k] << 16) | lp; tok_e[t * 4 + k] = ev[k]; tok_w[t * 4 + k] = wv[k] * rden; } }
        __syncthreads();
        if (tid < NE) { const unsigned n = lcnt[tid]; lcnt[tid] = n ? atomicAdd(&ctl[CW_CNT + tid], n) : 0u; }
        __syncthreads();
        { const unsigned s = lsel[tid]; const int e = (int)(s >> 16); const int pos = (int)(lcnt[e] + (s & 0xffffu)); const int t = t0 + (tid >> 2);
            tok_pos[t * 4 + (tid & 3)] = pos; list[(size_t)e * T + pos] = t; }
        __syncthreads();
    }
}

__device__ __forceinline__ void phase_scan(unsigned char* ws, int vcu, int G) {
    const bf16* ubuf = (const bf16*)(ws + WS_H); bf16* rbbuf = (bf16*)(ws + WS_MERGED);
    for (int task = vcu * 512 + (int)threadIdx.x; task < 32 * 4096; task += G * 512) {
        const int bh = task >> 12, e8 = task & 4095, h = bh & 3;
        const float lg = __builtin_amdgcn_logf(1.f - __builtin_amdgcn_exp2f(-5.f - (float)h));
        const float gam = __builtin_amdgcn_exp2f(lg), gC = __builtin_amdgcn_exp2f(lg * 128.f), gC1 = __builtin_amdgcn_exp2f(lg * 127.f);
        const bf16* up = ubuf + (size_t)bh * 32 * 32768 + e8 * 8; bf16* rp = rbbuf + (size_t)bh * 32 * 32768 + e8 * 8;
        float R[8];
#pragma unroll
        for (int i = 0; i < 8; ++i) R[i] = 0.f;
        for (int j0 = 0; j0 < 32; j0 += 8) {
            u32x4 uv[8];
#pragma unroll
            for (int jj = 0; jj < 8; ++jj) uv[jj] = __builtin_nontemporal_load((const u32x4*)(up + (size_t)(j0 + jj) * 32768));
#pragma unroll
            for (int jj = 0; jj < 8; ++jj) {
                u32x4 o; o.x = pk2(R[0] * gam, R[1] * gam); o.y = pk2(R[2] * gam, R[3] * gam); o.z = pk2(R[4] * gam, R[5] * gam); o.w = pk2(R[6] * gam, R[7] * gam);
                *(u32x4*)(rp + (size_t)(j0 + jj) * 32768) = o;
#pragma unroll
                for (int q = 0; q < 4; ++q) { R[2 * q] = gC * R[2 * q] + gC1 * bflo(uv[jj][q]); R[2 * q + 1] = gC * R[2 * q + 1] + gC1 * bfhi(uv[jj][q]); } }
        }
    }
}

__device__ __forceinline__ int build_expert_tables(const unsigned* ctl, LAS unsigned* rbtab, LAS unsigned* rbfirst) {
    if (threadIdx.x < 64) {
        const int e = threadIdx.x & 31; const unsigned c = __hip_atomic_load(&ctl[CW_CNT + e], __ATOMIC_RELAXED, __HIP_MEMORY_SCOPE_AGENT), nb = (c + 255u) >> 8;
        unsigned inc = nb;
#pragma unroll
        for (int o = 1; o < 32; o <<= 1) { const unsigned t = __shfl_up(inc, o, 32); inc += (e >= o) ? t : 0u; }
        const unsigned rb = inc - nb;
        if (threadIdx.x < 32) { rbfirst[e] = rb; if (e == NE - 1) rbfirst[NE] = inc; for (unsigned i = 0; i < nb; ++i) rbtab[rb + i] = (unsigned)e; } }
    __syncthreads();
    return __builtin_amdgcn_readfirstlane((int)rbfirst[NE]);
}

__device__ __forceinline__ void phase_combine(const Args& args, unsigned char* ws, const LAS unsigned* rbfirst, int vcu, int G) {
    const int lane = threadIdx.x & 63, wave = __builtin_amdgcn_readfirstlane(threadIdx.x >> 6);
    const float* mod = (const float*)(ws + WS_MOD); const unsigned char* eo = ws + WS_EO; const bf16* x1b = (const bf16*)(ws + WS_X1B);
    const int* tok_e = (const int*)(ws + WS_ROUTE); const int* tok_pos = tok_e + T * 4; const float* tok_w = (const float*)(tok_pos + T * 4);
    constexpr int TB = 2; constexpr float ESC = 1.f / (float)(1 << E_SH);
    typedef float f32x2_t __attribute__((ext_vector_type(2)));
    for (int t = (vcu * 8 + wave) * TB; t < T; t += G * 8 * TB) { const int b = t / S;
        const unsigned char* rp[TB][TOPK]; float w[TB][TOPK];
#pragma unroll
        for (int j = 0; j < TB; ++j)
#pragma unroll
            for (int k = 0; k < TOPK; ++k) { const int e = tok_e[(t + j) * 4 + k]; rp[j][k] = eo + ((size_t)rbfirst[e] * 256 + tok_pos[(t + j) * 4 + k]) * D; w[j][k] = tok_w[(t + j) * 4 + k] * ESC; }
        unsigned ev[TB][TOPK][4]; u32x2 xv[TB][4];
#pragma unroll
        for (int j = 0; j < TB; ++j)
#pragma unroll
            for (int i = 0; i < 4; ++i) { const int cc = 4 * lane + 256 * i; xv[j][i] = __builtin_nontemporal_load((const u32x2*)(x1b + (size_t)(t + j) * D + cc));
#pragma unroll
                for (int k = 0; k < TOPK; ++k) ev[j][k][i] = __builtin_nontemporal_load((const unsigned*)(rp[j][k] + cc)); }
#pragma unroll
        for (int i = 0; i < 4; ++i) { const int cc = 4 * lane + 256 * i; const f32x4 gt = *(const f32x4*)(mod + b * 6144 + 5120 + cc);
#pragma unroll
            for (int j = 0; j < TB; ++j) { f32x4 y = {0.f, 0.f, 0.f, 0.f};
#pragma unroll
                for (int k = 0; k < TOPK; ++k) { const f32x2_t lo = __builtin_amdgcn_cvt_pk_f32_fp8((int)ev[j][k][i], false), hi2 = __builtin_amdgcn_cvt_pk_f32_fp8((int)ev[j][k][i], true);
                    y[0] += w[j][k] * lo[0]; y[1] += w[j][k] * lo[1]; y[2] += w[j][k] * hi2[0]; y[3] += w[j][k] * hi2[1]; }
                const f32x4 x1 = (f32x4){bflo(xv[j][i].x), bfhi(xv[j][i].x), bflo(xv[j][i].y), bfhi(xv[j][i].y)};
                __builtin_nontemporal_store(x1 + gt * y, (f32x4*)(args.out + (size_t)(t + j) * D + cc)); } }
    }
}

enum Phase { PH_PRO = 0, PH_H1 = 1, PH_INPROJ = 2, PH_MIX = 3, PH_MERGE = 4, PH_OUTPROJ = 5, PH_ROUTE = 6, PH_MOE1 = 7, PH_MOE2 = 8, PH_COMB = 9, PH_END = 10 };
constexpr int CW_BAR = 4096;
__global__ void __launch_bounds__(512, 2) mk_fwd(Args args) {
    extern __shared__ __attribute__((aligned(16))) unsigned char lds_raw[];
    LAS unsigned char* lds = (LAS unsigned char*)lds_raw;
    volatile LAS unsigned* MISC = (volatile LAS unsigned*)(lds + LDS_MISC);
    const int tid = threadIdx.x, G = gridDim.x;
    const int vcu = (G % 8 == 0) ? ((int)blockIdx.x % 8) * (G / 8) + (int)blockIdx.x / 8 : (int)blockIdx.x;
    unsigned char* ws = args.ws; unsigned* ctl = (unsigned*)(ws + WS_CTL);
    const float* mod = (const float*)(ws + WS_MOD);
    bf16* hb = (bf16*)(ws + WS_H); bf16* proj = (bf16*)(ws + WS_PROJ); bf16* merged = (bf16*)(ws + WS_MRG);
    bf16* win_t = (bf16*)(ws + WS_WIN); bf16* wout_t = (bf16*)(ws + WS_WOUT); bf16* w1t = (bf16*)(ws + WS_W1); bf16* w2t = (bf16*)(ws + WS_W2);
    bf16* act = (bf16*)(ws + WS_ACT); bf16* eo = (bf16*)(ws + WS_EO); const int* list = (const int*)(ws + WS_LIST);
    for (int u = tid; u < 64; u += 512) MISC[u] = 0u;
    __syncthreads();
    const int lo = args.ph_lo, hi = args.ph_hi;
    XcdBarrier bar = xcd_barrier_post(ctl + CW_BAR, MISC + 8);
#define IN(k) (lo <= (k) && (k) < hi)
#define SEAM(k) do { if (IN(k) && IN((k) + 1)) xcd_barrier(bar); } while (0)
    auto conv_step = [&]() -> bool {
        if (tid == 0) MISC[30] = atomicAdd(&ctl[CW_CONV], 1u);
        __syncthreads();
        const unsigned idx = MISC[30];
        if (idx >= 3072u) return false;
        moe_w_pair(args, ws, (LAS float*)(lds + (tid >> 6) * 12288), (int)((3071u - idx) * 8u + (unsigned)(tid >> 6)), tid & 63);
        __syncthreads();
        return true; };
#define SEAM_WORK(k) do { if (IN(k) && IN((k) + 1)) xcd_barrier_work(bar, conv_step); } while (0)
    LAS unsigned* gtab = (LAS unsigned*)(lds + LDS_GTAB); LAS unsigned* rbtab = (LAS unsigned*)(lds + LDS_RB2E); LAS float* gqk = (LAS float*)(lds + LDS_GQK); LAS unsigned* rbfirst = (LAS unsigned*)(lds + LDS_RBF);

    if (IN(PH_PRO)) { phase_prologue(args, ws, lds, vcu, G); __syncthreads(); }
    if (!(IN(PH_PRO) && IN(PH_H1))) SEAM(PH_PRO);
    if (IN(PH_H1)) phase_h1(args, ws, vcu, G);
    SEAM_WORK(PH_H1);
    if (IN(PH_INPROJ)) {
        if (tid < 64) gqk[tid] = args.in[8][tid] * C2; else if (tid < 128) gqk[tid] = args.in[9][tid - 64];
        __syncthreads();
        EpiIn E{proj, gqk};
        if (IN_GATE_F8) {
            struct MapOrder { pg8::StaticOrder s; int split, add0, add1;
                __device__ bool next(int i, pg8::GUnit& u) const { const bool r = s.next(i, u); u.pn += u.pn < split ? add0 : add1; return r; } };
            MapOrder Sa; Sa.s.init(T / 256, 20, G, (int)blockIdx.x, nullptr, nullptr); Sa.split = 8; Sa.add0 = 0; Sa.add1 = 8;
            pg8::gemm_phase<EpiIn, MapOrder, false, false>(lds + LDS_STAGE, hb, win_t, 0, D, Sa, E, nullptr, gtab, 127 - A_SH, 127 - W_SH);
            MapOrder Sb; Sb.s.init(T / 256, 12, G, (int)blockIdx.x, nullptr, nullptr); Sb.split = 8; Sb.add0 = 8; Sb.add1 = 20;
            pg8::gemm_phase<EpiIn, MapOrder, false, true>(lds + LDS_STAGE, ws + WS_H8, ws + WS_WIN8, 0, D, Sb, E, nullptr, gtab, 127 - A_SH, 127 - W_SH);
        } else {
        pg8::StaticOrder So; So.init(T / 256, INW / 256, G, (int)blockIdx.x, nullptr, nullptr);
        pg8::gemm_phase<EpiIn, pg8::StaticOrder, false, FP8_IN != 0>(lds + LDS_STAGE, hb, win_t, 0, D, So, E, nullptr, gtab, 127 - A_SH, 127 - W_SH);
        }
    }
    SEAM_WORK(PH_INPROJ);
    if (IN(PH_MIX)) {
        float a1 = 0.f, a2 = 0.f, gm = 0.f;
        for (int d = 0; d < 64; ++d) { a1 += args.in[10][d] * args.in[11][d]; a2 += args.in[12][d] * args.in[13][d]; gm = fmaxf(gm, fabsf(args.in[8][d] * args.in[9][d])); }
        const float lam = __expf(a1) - __expf(a2) + LAMBDA_INIT;
        bf16* odiff = (bf16*)(ws + WS_ODIFF);
        const float w2 = 2.f * 8.f * gm * LOG2E * 1.03f + 32.f;
        LAS unsigned* cost = (LAS unsigned*)(lds + LDS_RB2E); LAS unsigned* order = cost + 256;
        if (tid >= 256 && tid < 384) ((LAS float*)(lds + att::LDS_GSUB))[tid - 256] = args.in[14][tid - 256];
        if (tid < 256) { const int h = tid >> 5, qb = tid & 31; const float slope2 = __builtin_amdgcn_exp2f(-(float)(h + 1)) * LOG2E;
            const float x = (float)(128 * qb - 63) - w2 / slope2; const int t_lo = x <= 0.f ? 0 : (int)ceilf(x * (1.f / 64.f));
            cost[tid] = (unsigned)(2 * qb + 2 - t_lo) | ((unsigned)t_lo << 16); }
        __syncthreads();
        if (tid < 256) { const unsigned mine = cost[tid] & 0xffffu; int rank = 0;
            for (int k = 0; k < 256; ++k) { const unsigned ck = cost[k] & 0xffffu; rank += (ck > mine || (ck == mine && k < tid)) ? 1 : 0; }
            order[rank] = (unsigned)tid | (cost[tid] & 0xffff0000u); }
        __syncthreads();
        static_assert(MOE_W_IN_QUEUE == 1, "the mixer queue carries the expert-weight items");
        constexpr unsigned NR1 = 1024u, NITEMS = NR1 + 2048u;
#ifndef MIX_REPS
#define MIX_REPS 1
#endif
        { constexpr int rep = 0;
        if (tid == 0) { const unsigned ctk = __hip_atomic_load(&ctl[CW_CONV], __ATOMIC_RELAXED, __HIP_MEMORY_SCOPE_AGENT);
            MISC[29] = 3072u - (ctk < 3072u ? ctk : 3072u); }
        unsigned* qhead = &ctl[CW_Q + 64 * rep];
        unsigned n1 = 0u, n2 = 0u; bool prev_att = false; bf16x8 qn0 = {}, qn1 = {}, qn2 = {}, qn3 = {};
        if (tid == 0) { n1 = atomicAdd(qhead, 1u); n2 = atomicAdd(qhead, 1u); }
        for (;;) {
            if (tid == 0) { MISC[16] = n1; MISC[17] = n2; }
            __syncthreads();
            const unsigned item = MISC[16], nitem = MISC[17];
            if (item >= NITEMS) break;
            if (tid == 0) { n1 = n2; n2 = atomicAdd(qhead, 1u); }
            if (item < NR1) { ret::r1_unit((int)(item >> 7), (int)((item >> 5) & 3u), (int)(item & 31u), proj, (bf16*)(ws + WS_H), lds); prev_att = false; qn0 = (bf16x8){}; qn1 = (bf16x8){}; qn2 = (bf16x8){}; qn3 = (bf16x8){}; }
            else { const unsigned u = item - NR1, c0 = 3u * (u >> 1) + (u & 1u), nc = 1u + (u & 1u);
                int t2 = tid; asm volatile("" : "+v"(t2));
                if (u < 64u) wout_item(args, ws, (LAS float*)(lds + (t2 >> 6) * 12288), (int)(u * 8u + (unsigned)(t2 >> 6)), t2 & 63);
                for (unsigned k = 0; k < nc; ++k) if (c0 + k < MISC[29]) moe_w_pair(args, ws, (LAS float*)(lds + (t2 >> 6) * 12288), (int)((c0 + k) * 8u + (unsigned)(t2 >> 6)), t2 & 63);
                __syncthreads();
                const unsigned oc = order[u >> 3]; const int cls = (int)(oc & 0xffffu);
                const bool nvalid = nitem >= NR1 && nitem < NITEMS; const unsigned nu = nvalid ? nitem - NR1 : 0u; const int ncls = (int)(order[nu >> 3] & 0xffffu);
                att::unit((int)(u & 7u), cls >> 5, cls & 31, (int)(oc >> 16), proj, odiff, lds, lam, args.in[14], prev_att, nvalid, (int)(nu & 7u), ncls >> 5, ncls & 31, qn0, qn1, qn2, qn3);
                prev_att = nvalid; }
        }
        __syncthreads();
        xcd_barrier(bar);
        phase_scan(ws, vcu, G);
        xcd_barrier(bar);
        if (FUSE_MERGE) {
            for (int u = vcu * 4; u < 1024; u += G * 4)
                for (int k = 0; k < 4; ++k) { const int id = u + k; ret::r3m_unit(id >> 7, (id >> 5) & 3, id & 31, proj, (const bf16*)(ws + WS_MERGED), odiff, (bf16*)(ws + WS_MRG), args.in[6], args.in[7], lds); }
        } else
        for (int u = vcu * 8; u < 2048; u += G * 8)
            for (int k = 0; k < 8; ++k) { const int id = u + k; ret::r3_unit(id >> 8, (id >> 6) & 3, (id >> 1) & 31, id & 1, proj, (const bf16*)(ws + WS_MERGED), (bf16*)(ws + WS_YRET), lds); }
        }
    }
    SEAM(PH_MIX);
    if (!FUSE_MERGE) { if (IN(PH_MERGE)) phase_merge(args, ws, vcu, G);
        SEAM(PH_MERGE); }
    if (IN(PH_OUTPROJ)) {
        pg8::StaticOrder So; So.init(T / 256, D / 256, G, (int)blockIdx.x, nullptr, nullptr);
        EpiOutF E{args.in[0], mod, (bf16*)(ws + WS_X1B)};
        pg8::gemm_phase<EpiOutF, pg8::StaticOrder, false, FP8_OUT != 0>(lds + LDS_STAGE, merged, wout_t, 0, D, So, E, nullptr, gtab, 127 - A_SH, 127 - W_SH);
    }
    SEAM(PH_OUTPROJ);
    if (IN(PH_ROUTE)) { phase_route(args, ws, lds, vcu, G); }
    SEAM(PH_ROUTE);
    if (IN(PH_MOE1)) {
        const int nrb = build_expert_tables(ctl, rbtab, rbfirst);
        pg8::StaticOrder So; So.init(nrb, 2048 / 256, G, (int)blockIdx.x, rbtab, rbfirst);
        LAS float* btab = (LAS float*)(lds + LDS_BTAB);
        EpiActF E{btab, act};
        pg8::gemm_phase<EpiActF, pg8::StaticOrder, true, FP8_MOE != 0, 1>(lds + LDS_STAGE, hb, w1t, (size_t)2048 * D * (FP8_MOE ? 1 : 2), D, So, E, list, gtab, 127 - A_SH, 127 - W_SH, args.in[20], btab);
    }
    SEAM(PH_MOE1);
    if (IN(PH_MOE2)) {
        const int nrb = build_expert_tables(ctl, rbtab, rbfirst);
        pg8::StaticOrder So; So.init(nrb, D / 256, G, (int)blockIdx.x, rbtab, rbfirst);
        LAS float* btab = (LAS float*)(lds + LDS_BTAB);
        EpiEOF E{btab, eo};
        pg8::gemm_phase<EpiEOF, pg8::StaticOrder, false, FP8_MOE != 0, 2, 1>(lds + LDS_STAGE, act, w2t, (size_t)D * FF * (FP8_MOE ? 1 : 2), FF, So, E, nullptr, gtab, 127 - A_SH, 127 - W_SH, args.in[22], btab);
    }
    SEAM(PH_MOE2);
    if (IN(PH_COMB)) { (void)build_expert_tables(ctl, rbtab, rbfirst); phase_combine(args, ws, rbfirst, vcu, G); }
#undef IN
#undef SEAM
}

static int g_grid = 0;
static void launch_phases(Args a, int lo, int hi, hipStream_t stream) {
    a.ph_lo = lo; a.ph_hi = hi;
    hipLaunchKernelGGL(mk_fwd, dim3(g_grid), dim3(512), LDS_BYTES, stream, a);
}
extern "C" void kernel_launch(void* const* d_in, const int* in_sizes, int n_in, void* d_out, int out_size, void* d_ws, size_t ws_size, hipStream_t stream) {
    if (n_in != 23 || ws_size < WS_END) { fprintf(stderr, "kernel_launch: unexpected inputs/workspace (%d, %zu)\n", n_in, ws_size); }
    unsigned char* ws = (unsigned char*)d_ws; float* out = (float*)d_out;

    if (g_grid == 0) {
        int dev = 0, cus = 0;
        if (hipGetDevice(&dev) != hipSuccess || hipDeviceGetAttribute(&cus, hipDeviceAttributeMultiprocessorCount, dev) != hipSuccess) { fprintf(stderr, "kernel_launch: device query failed\n"); g_grid = -1; return; }
        if (hipFuncSetAttribute((const void*)mk_fwd, hipFuncAttributeMaxDynamicSharedMemorySize, LDS_BYTES) != hipSuccess) { fprintf(stderr, "kernel_launch: hipFuncSetAttribute failed\n"); g_grid = -1; return; }
        g_grid = cus;
    }
    if (g_grid < 0) return;
    Args a{};
    for (int i = 0; i < 23; ++i) a.in[i] = (const float*)d_in[i];
    a.out = out; a.ws = ws;
    (void)hipMemsetAsync(ws, 0, 64 * 1024, stream);
    launch_phases(a, 0, PH_END, stream);
}
```
